# Optimizing an MI355X kernel written in HIP

```python
import jax, jax.numpy as jnp
from jax import lax
import numpy as np

D_MODEL = 4096
BATCH = 2
SEQ = 4096
DEPTH = 2

RET_HEAD_DIM = 256
RET_WIDTH = D_MODEL // 2
RET_HEADS = RET_WIDTH // RET_HEAD_DIM
RET_CHUNK = 128
HGRN_HEAD_DIM = 128
HGRN_WIDTH = D_MODEL // 4
HGRN_HEADS = HGRN_WIDTH // HGRN_HEAD_DIM
HGRN_CHUNK = 64
FOURIER_GROUP_DIM = 128
FOURIER_WIDTH = D_MODEL - RET_WIDTH - HGRN_WIDTH
FOURIER_GROUPS = FOURIER_WIDTH // FOURIER_GROUP_DIM
MIX_WIDTH = RET_WIDTH + HGRN_WIDTH + FOURIER_WIDTH
IN_PROJ_WIDTH = 4 * RET_WIDTH + 5 * HGRN_WIDTH + FOURIER_WIDTH
XATTN_HEADS = 4
XATTN_HEAD_DIM = 256
XATTN_WIDTH = XATTN_HEADS * XATTN_HEAD_DIM
MEM_TOKENS = 256
FFN_HIDDEN = ((8 * D_MODEL // 3 + 255) // 256) * 256
ROPE_BASE = 10000.0
RMS_EPS = 1e-6
GN_EPS = 1e-5

kernel_name = "hybrid_retention_hgrn2_fnet_encoder"


def _rms_norm(x, g, eps=RMS_EPS):
    xf = x.astype(jnp.float32)
    y = xf * lax.rsqrt(jnp.mean(xf * xf, axis=-1, keepdims=True) + eps)
    return (y * g.astype(jnp.float32)).astype(x.dtype)


def _to_heads(t, n_heads):
    b, s, w = t.shape
    return t.reshape(b, s, n_heads, w // n_heads).transpose(0, 2, 1, 3)


def _from_heads(t):
    b, h, s, d = t.shape
    return t.transpose(0, 2, 1, 3).reshape(b, s, h * d)


def _to_chunks(t, c):
    b, h, s, d = t.shape
    return jnp.moveaxis(t.reshape(b, h, s // c, c, d), 2, 0)


def _from_chunks(o):
    n, b, h, c, d = o.shape
    return jnp.moveaxis(o, 0, 2).reshape(b, h, n * c, d)


def _rotary(t):
    s, d = t.shape[2], t.shape[3]
    half = d // 2
    inv = jnp.power(ROPE_BASE, -jnp.arange(half, dtype=jnp.float32) / half)
    ang = jnp.arange(s, dtype=jnp.float32)[:, None] * inv[None, :]
    cos, sin = jnp.cos(ang), jnp.sin(ang)
    t1, t2 = t[..., :half], t[..., half:]
    return jnp.concatenate([t1 * cos - t2 * sin, t1 * sin + t2 * cos], axis=-1)


def _retention_one_dir(q, k, v, gamma, inclusive):
    b, h, s, d = q.shape
    dv = v.shape[-1]
    c = RET_CHUNK
    log_g = jnp.log(gamma)
    idx = jnp.arange(c, dtype=jnp.float32)
    rel = idx[:, None] - idx[None, :]
    mask = (rel >= 0) if inclusive else (rel > 0)
    decay = jnp.where(mask[None], jnp.exp(jnp.where(mask, rel, 0.0)[None] * log_g[:, None, None]), 0.0)
    q_dec = jnp.exp((idx + 1.0)[None, :] * log_g[:, None])[None, :, :, None]
    k_dec = jnp.exp((c - 1.0 - idx)[None, :] * log_g[:, None])[None, :, :, None]
    chunk_dec = jnp.exp(c * log_g)[None, :, None, None]

    def step(state, inp):
        qc, kc, vc = inp
        scores = jnp.einsum('bhid,bhjd->bhij', qc, kc) * decay[None]
        o = (jnp.einsum('bhij,bhje->bhie', scores, vc)
             + jnp.einsum('bhid,bhde->bhie', qc * q_dec, state))
        state = chunk_dec * state + jnp.einsum('bhjd,bhje->bhde', kc * k_dec, vc)
        return state, o

    state0 = jnp.zeros((b, h, d, dv), jnp.float32)
    _, o = lax.scan(step, state0, (_to_chunks(q, c), _to_chunks(k, c), _to_chunks(v, c)))
    return _from_chunks(o)


def _retention_mixer(rq, rk, rv, rg, norm_g):
    f32 = jnp.float32
    q = _rotary(_to_heads(rq, RET_HEADS).astype(f32)) * (RET_HEAD_DIM ** -0.5)
    k = _rotary(_to_heads(rk, RET_HEADS).astype(f32))
    v = _to_heads(rv, RET_HEADS).astype(f32)
    gamma_fwd = 1.0 - jnp.power(2.0, -5.0 - jnp.arange(RET_HEADS, dtype=f32))
    gamma_bwd = gamma_fwd[::-1]
    o_fwd = _retention_one_dir(q, k, v, gamma_fwd, True)
    o_bwd = jnp.flip(_retention_one_dir(jnp.flip(q, 2), jnp.flip(k, 2), jnp.flip(v, 2), gamma_bwd, False), 2)
    o = o_fwd + o_bwd
    mu = jnp.mean(o, axis=-1, keepdims=True)
    var = jnp.mean(jnp.square(o - mu), axis=-1, keepdims=True)
    o = _from_heads((o - mu) * lax.rsqrt(var + GN_EPS)) * norm_g.astype(f32)
    return (jax.nn.silu(rg.astype(f32)) * o).astype(rq.dtype)


def _gla_one_dir(q, k, v, log_f):
    b, h, s, dk = q.shape
    dv = v.shape[-1]
    c = HGRN_CHUNK
    tri = jnp.tril(jnp.ones((c, c), dtype=bool))

    def step(state, inp):
        qc, kc, vc, gc = inp
        cum = jnp.cumsum(gc, axis=2)
        rel = cum[:, :, :, None, :] - cum[:, :, None, :, :]
        w = jnp.exp(jnp.where(tri[None, None, :, :, None], rel, -jnp.inf))
        scores = jnp.einsum('bhtd,bhsd,bhtsd->bhts', qc, kc, w)
        last = cum[:, :, -1, :]
        o = (jnp.einsum('bhts,bhse->bhte', scores, vc)
             + jnp.einsum('bhtd,bhde->bhte', qc * jnp.exp(cum), state))
        state = (jnp.exp(last)[..., None] * state
                 + jnp.einsum('bhsd,bhse->bhde', kc * jnp.exp(last[:, :, None, :] - cum), vc))
        return state, o

    state0 = jnp.zeros((b, h, dk, dv), jnp.float32)
    _, o = lax.scan(step, state0, (_to_chunks(q, c), _to_chunks(k, c), _to_chunks(v, c), _to_chunks(log_f, c)))
    return _from_chunks(o)


def _hgrn2_mixer(hq, hf_fwd, hf_bwd, hi, hg, lb, norm_g):
    f32 = jnp.float32
    q = _to_heads(hq, HGRN_HEADS).astype(f32) * (HGRN_HEAD_DIM ** -0.5)
    i = _to_heads(hi, HGRN_HEADS).astype(f32)

    def gates(z, lb_dir):
        lb_h = lb_dir.reshape(HGRN_HEADS, 1, HGRN_HEAD_DIM)
        f = lb_h + (1.0 - lb_h) * jax.nn.sigmoid(_to_heads(z, HGRN_HEADS).astype(f32))
        return 1.0 - f, jnp.log(f)

    k_f, logf_f = gates(hf_fwd, lb[0])
    k_b, logf_b = gates(hf_bwd, lb[1])
    o_fwd = _gla_one_dir(q, k_f, i, logf_f)
    o_bwd = jnp.flip(_gla_one_dir(jnp.flip(q, 2), jnp.flip(k_b, 2), jnp.flip(i, 2), jnp.flip(logf_b, 2)), 2)
    o = o_fwd + o_bwd
    o = o * lax.rsqrt(jnp.mean(o * o, axis=-1, keepdims=True) + RMS_EPS)
    o = _from_heads(o) * norm_g.astype(f32)
    return (jax.nn.silu(hg.astype(f32)) * o).astype(hq.dtype)


def _fourier_mixer(z, w, bias):
    b, s, _ = z.shape
    zg = z.astype(jnp.float32).reshape(b, s, FOURIER_GROUPS, FOURIER_GROUP_DIM)
    spec = jnp.real(jnp.fft.fft2(zg, axes=(1, 3), norm='ortho'))
    y = jnp.einsum('bsgc,gcd->bsgd', spec, w.astype(jnp.float32)) + bias.astype(jnp.float32)
    return y.reshape(b, s, FOURIER_WIDTH).astype(z.dtype)


def _cross_attention(c, mem_n, wq, wk, wv, wo):
    f32 = jnp.float32
    q = _to_heads(c @ wq, XATTN_HEADS).astype(f32) * (XATTN_HEAD_DIM ** -0.5)
    k = _to_heads(mem_n @ wk, XATTN_HEADS).astype(f32)
    v = _to_heads(mem_n @ wv, XATTN_HEADS).astype(f32)
    p = jax.nn.softmax(jnp.einsum('bhsd,bhmd->bhsm', q, k), axis=-1)
    o = jnp.einsum('bhsm,bhmd->bhsd', p, v)
    return _from_heads(o).astype(c.dtype) @ wo


def setup_inputs(seed: int = 0) -> dict:
    key = jax.random.key(seed)
    ks = jax.random.split(key, 24)
    L, D = DEPTH, D_MODEL
    f32 = jnp.float32

    def nrm(k, shape, scale):
        return jax.random.normal(k, shape, f32) * scale

    def gain(k, shape):
        return 1.0 + 0.05 * jax.random.normal(k, shape, f32)

    return {
        "x": jax.random.normal(ks[0], (BATCH, SEQ, D), f32),
        "mem": jax.random.normal(ks[1], (BATCH, MEM_TOKENS, D), f32),
        "mem_norm_g": gain(ks[2], (D,)),
        "pre_mix_g": gain(ks[3], (L, D)),
        "w_in": nrm(ks[4], (L, D, IN_PROJ_WIDTH), D ** -0.5),
        "ret_norm_g": gain(ks[5], (L, RET_WIDTH)),
        "hgrn_lb_logits": 1.0 + 0.1 * jax.random.normal(ks[6], (L, 2, HGRN_WIDTH), f32),
        "hgrn_norm_g": gain(ks[7], (L, HGRN_WIDTH)),
        "fourier_w": nrm(ks[8], (L, FOURIER_GROUPS, FOURIER_GROUP_DIM, FOURIER_GROUP_DIM), FOURIER_GROUP_DIM ** -0.5),
        "fourier_b": nrm(ks[9], (L, FOURIER_GROUPS, FOURIER_GROUP_DIM), 0.02),
        "w_out": nrm(ks[10], (L, MIX_WIDTH, D), MIX_WIDTH ** -0.5),
        "post_mix_g": gain(ks[11], (L, D)),
        "pre_xattn_g": gain(ks[12], (L, D)),
        "xattn_wq": nrm(ks[13], (L, D, XATTN_WIDTH), D ** -0.5),
        "xattn_wk": nrm(ks[14], (L, D, XATTN_WIDTH), D ** -0.5),
        "xattn_wv": nrm(ks[15], (L, D, XATTN_WIDTH), D ** -0.5),
        "xattn_wo": nrm(ks[16], (L, XATTN_WIDTH, D), XATTN_WIDTH ** -0.5),
        "post_xattn_g": gain(ks[17], (L, D)),
        "pre_ffn_g": gain(ks[18], (L, D)),
        "ffn_w_gate": nrm(ks[19], (L, D, FFN_HIDDEN), D ** -0.5),
        "ffn_w_up": nrm(ks[20], (L, D, FFN_HIDDEN), D ** -0.5),
        "ffn_w_down": nrm(ks[21], (L, FFN_HIDDEN, D), FFN_HIDDEN ** -0.5),
        "post_ffn_g": gain(ks[22], (L, D)),
    }


def reference(x, mem, mem_norm_g, pre_mix_g, w_in, ret_norm_g, hgrn_lb_logits, hgrn_norm_g,
              fourier_w, fourier_b, w_out, post_mix_g, pre_xattn_g, xattn_wq, xattn_wk, xattn_wv,
              xattn_wo, post_xattn_g, pre_ffn_g, ffn_w_gate, ffn_w_up, ffn_w_down, post_ffn_g):
    sizes = [RET_WIDTH] * 4 + [HGRN_WIDTH] * 5 + [FOURIER_WIDTH]
    splits = [int(v) for v in np.cumsum(sizes)[:-1]]
    p = jax.nn.softmax(hgrn_lb_logits.astype(jnp.float32), axis=0)
    lower_bounds = jnp.cumsum(p, axis=0) - p[0:1]
    mem_n = _rms_norm(mem, mem_norm_g)

    h = x
    for l in range(DEPTH):
        a = _rms_norm(h, pre_mix_g[l])
        proj = a @ w_in[l]
        rq, rk, rv, rg, hq, hff, hfb, hi, hg, fz = jnp.split(proj, splits, axis=-1)
        y_ret = _retention_mixer(rq, rk, rv, rg, ret_norm_g[l])
        y_hgrn = _hgrn2_mixer(hq, hff, hfb, hi, hg, lower_bounds[l], hgrn_norm_g[l])
        y_fft = _fourier_mixer(fz, fourier_w[l], fourier_b[l])
        mixed = jnp.concatenate([y_ret, y_hgrn, y_fft], axis=-1).astype(h.dtype) @ w_out[l]
        h = h + _rms_norm(mixed, post_mix_g[l])
        c = _rms_norm(h, pre_xattn_g[l])
        xa = _cross_attention(c, mem_n, xattn_wq[l], xattn_wk[l], xattn_wv[l], xattn_wo[l])
        h = h + _rms_norm(xa, post_xattn_g[l])
        f = _rms_norm(h, pre_ffn_g[l])
        ff = (jax.nn.silu(f @ ffn_w_gate[l]) * (f @ ffn_w_up[l])) @ ffn_w_down[l]
        h = h + _rms_norm(ff, post_ffn_g[l])
    return h
```

```cpp
#include <hip/hip_runtime.h>
#include <cstdio>
#include <cstdint>

#ifndef ONE_LAUNCH
#define ONE_LAUNCH 1
#endif

#define LAS __attribute__((address_space(3)))
#define GAS __attribute__((address_space(1)))
typedef unsigned short bf16;
typedef short bf16x8 __attribute__((ext_vector_type(8)));
typedef float f32x4 __attribute__((ext_vector_type(4)));
typedef float f32x2 __attribute__((ext_vector_type(2)));
typedef unsigned u32x4 __attribute__((ext_vector_type(4)));
typedef unsigned u32x2 __attribute__((ext_vector_type(2)));

constexpr int D = 4096, NB = 2, SEQ = 4096, NL = 2, M = NB * SEQ;
constexpr int RW = 2048, RH = 8, RD = 256;
constexpr int HW = 1024, HH = 8, HD = 128;
constexpr int FW = 1024, FG = 8, FD = 128;
constexpr int NPROJ = 14336;
constexpr int XW = 1024, XH = 4, XD = 256, MEMT = 256;
constexpr int FFH = 11008;
constexpr int C_RQ = 0, C_RK = 2048, C_RV = 4096, C_RG = 6144, C_HQ = 8192, C_HFF = 9216, C_HFB = 10240, C_HI = 11264, C_HG = 12288, C_FZ = 13312;
constexpr float RMS_EPS = 1e-6f, GN_EPS = 1e-5f;

constexpr size_t MiB = 1u << 20;
constexpr size_t WS_CTL = 0, CTL_ZERO_BYTES = 1 * MiB;
constexpr size_t WS_WIN = 1 * MiB;
constexpr size_t WS_WOUT = 113 * MiB;
constexpr size_t WS_WQ = 145 * MiB;
constexpr size_t WS_WKV = 153 * MiB;
constexpr size_t WS_WO = 169 * MiB;
constexpr size_t WS_WGU = 177 * MiB;
constexpr size_t WS_WDN = 349 * MiB;
constexpr size_t WS_ANORM = 435 * MiB;
constexpr size_t WS_PROJ = 499 * MiB;
constexpr size_t WS_GATEZ = 723 * MiB;
constexpr size_t WS_MIXIN = 787 * MiB;
constexpr size_t WS_TMP = 851 * MiB;
constexpr size_t WS_SCR = 979 * MiB;
constexpr size_t WS_DFT = 1171 * MiB;
constexpr size_t WS_UT = 1235 * MiB;
constexpr size_t WS_XQ = 1267 * MiB;
constexpr size_t WS_XO = 1283 * MiB;
constexpr size_t WS_KVMEM = 1299 * MiB;
constexpr size_t WS_MEMN = 1301 * MiB;
constexpr size_t WS_ROPE = 1305 * MiB;
constexpr size_t WS_FWT = 1309 * MiB;
constexpr size_t WS_END = 1310 * MiB;
constexpr int CW_BAR = 4096;

constexpr int LDS_BYTES = 147456;
constexpr int LDSCTL_OFF = LDS_BYTES - 512, MISC_OFF = LDSCTL_OFF + 320;
constexpr int NWAVES = 8;

typedef __bf16 bf16x2_t __attribute__((ext_vector_type(2)));
__device__ __forceinline__ unsigned cvt_pk_bf16(float lo, float hi) { const f32x2 v = {lo, hi}; return __builtin_bit_cast(unsigned, __builtin_convertvector(v, bf16x2_t)); }
__device__ __forceinline__ float bf2f(unsigned b) { return __uint_as_float(b << 16); }
__device__ __forceinline__ float bflo(unsigned w) { return __uint_as_float(w << 16); }
__device__ __forceinline__ float bfhi(unsigned w) { return __uint_as_float(w & 0xffff0000u); }
__device__ __forceinline__ float wave_sum(float v) {
#pragma unroll
    for (int o = 1; o < 64; o <<= 1) v += __shfl_xor(v, o);
    return v;
}
__device__ __forceinline__ float fast_sigmoid(float x) { return __builtin_amdgcn_rcpf(1.0f + __expf(-x)); }
__device__ __forceinline__ float silu_f(float x) { return x * fast_sigmoid(x); }
#define LDS_WAIT() asm volatile("s_waitcnt lgkmcnt(0)" ::: "memory")
#define VM_WAIT() asm volatile("s_waitcnt vmcnt(0)" ::: "memory")

namespace pg8 {
constexpr int BM = 256, BK = 64, HALF = 128, HTB = HALF * BK * 2, STAGE_BYTES = 8 * HTB, NXCD = 8, WGM = 8;
__host__ __device__ __forceinline__ int lds_byte(int r, int c) { const int st = (r >> 4) * 2 + (c >> 5), rr = r & 15, cc = c & 31, ob = rr * 64 + cc * 2; return st * 1024 + (ob ^ (((ob >> 9) & 1) << 5)); }
__host__ __device__ __forceinline__ void stage_rc(int b, int& R, int& C) { const int st = b / 1024, sb = b % 1024, swz = sb ^ (((sb >> 9) & 1) << 5); R = (st >> 1) * 16 + swz / 64; C = (st & 1) * 32 + (swz % 64) / 2; }
__host__ __device__ __forceinline__ int perm32(int rho) { const int n = rho >> 4, i = rho & 15; return 8 * (i >> 2) + 4 * n + (i & 3); }
struct Unit { int pm, pn; };
struct Gemm { const bf16* A; const bf16* Bt; int M, N, K; };
struct StaticOrder {
    int nM, nN, nwg, G, c;
    __host__ __device__ void init(int M_, int N_, int G_, int c_) { nM = M_ / BM; nN = N_ / BM; nwg = nM * nN; G = G_; c = c_; }
    __host__ __device__ bool next(int i, Unit& u) const {
        if (c < 0) return false;
        const long Lx = (long)i * G + c; if (Lx >= nwg) return false;
        int wgid = (int)Lx; { const int q = nwg / NXCD, r = nwg % NXCD, xcd = wgid % NXCD, off = wgid / NXCD; wgid = (xcd < r ? xcd * (q + 1) : r * (q + 1) + (xcd - r) * q) + off; }
        const int nig = WGM * nN, gid = wgid / nig, fm = gid * WGM, gsz = (nM - fm) < WGM ? (nM - fm) : WGM;
        u.pm = fm + ((wgid % nig) % gsz); u.pn = (wgid % nig) / gsz; return true;
    }
    __device__ __forceinline__ void a_ready(const Unit&) const {}
    __device__ __forceinline__ void done(const Unit&) const {}
};

struct EpiF32 {
    static constexpr bool PERM = false;
    float* C; int ldc;
    __device__ __forceinline__ void operator()(const f32x4 (&acc)[2][2][4][2], const Unit& u, int wr, int wc, int fr, int fq) const {
        const int row0 = u.pm * BM + wr * 64 + fr, col0 = u.pn * BM + wc * 32 + 4 * fq;
#pragma unroll
        for (int ai = 0; ai < 2; ++ai)
#pragma unroll
            for (int m = 0; m < 4; ++m) { float* rowp = C + (size_t)(row0 + ai * HALF + m * 16) * ldc + col0;
#pragma unroll
                for (int bj = 0; bj < 2; ++bj)
#pragma unroll
                    for (int n = 0; n < 2; ++n) *(f32x4*)(rowp + bj * HALF + n * 16) = acc[ai][bj][m][n]; }
    }
};
struct EpiBf16 {
    static constexpr bool PERM = true;
    bf16* O; int ldc; float scale;
    __device__ __forceinline__ void operator()(const f32x4 (&acc)[2][2][4][2], const Unit& u, int wr, int wc, int fr, int fq) const {
        const int row0 = u.pm * BM + wr * 64 + fr, col0 = u.pn * BM + wc * 32 + 8 * fq;
#pragma unroll
        for (int ai = 0; ai < 2; ++ai)
#pragma unroll
            for (int m = 0; m < 4; ++m) { bf16* rowp = O + (size_t)(row0 + ai * HALF + m * 16) * ldc + col0;
#pragma unroll
                for (int bj = 0; bj < 2; ++bj) { const f32x4 v0 = acc[ai][bj][m][0] * scale, v1 = acc[ai][bj][m][1] * scale;
                    u32x4 w; w.x = cvt_pk_bf16(v0[0], v0[1]); w.y = cvt_pk_bf16(v0[2], v0[3]); w.z = cvt_pk_bf16(v1[0], v1[1]); w.w = cvt_pk_bf16(v1[2], v1[3]);
                    *(u32x4*)(rowp + bj * HALF) = w; } }
    }
};
struct EpiInProj {
    static constexpr bool PERM = true;
    bf16* proj; float* gatez; const float* ropec; const float* ropes;
    __device__ __forceinline__ void operator()(const f32x4 (&acc)[2][2][4][2], const Unit& u, int wr, int wc, int fr, int fq) const {
        const int row0 = u.pm * BM + wr * 64 + fr, colw = wc * 32 + 8 * fq;
        if (u.pn < 16) {
            const float sc = u.pn < 8 ? 0.0625f : 1.0f;
#pragma unroll
            for (int ai = 0; ai < 2; ++ai)
#pragma unroll
                for (int m = 0; m < 4; ++m) { const int r = row0 + ai * HALF + m * 16; const int pos = r & (SEQ - 1);
                    const f32x4 c0 = *(const f32x4*)(ropec + pos * 128 + colw), c1 = *(const f32x4*)(ropec + pos * 128 + colw + 4);
                    const f32x4 s0 = *(const f32x4*)(ropes + pos * 128 + colw), s1 = *(const f32x4*)(ropes + pos * 128 + colw + 4);
                    const f32x4 a0 = acc[ai][0][m][0], a1 = acc[ai][0][m][1], b0 = acc[ai][1][m][0], b1 = acc[ai][1][m][1];
                    const f32x4 o10 = (a0 * c0 - b0 * s0) * sc, o11 = (a1 * c1 - b1 * s1) * sc, o20 = (a0 * s0 + b0 * c0) * sc, o21 = (a1 * s1 + b1 * c1) * sc;
                    bf16* rowp = proj + (size_t)r * NPROJ + u.pn * BM + colw;
                    u32x4 w; w.x = cvt_pk_bf16(o10[0], o10[1]); w.y = cvt_pk_bf16(o10[2], o10[3]); w.z = cvt_pk_bf16(o11[0], o11[1]); w.w = cvt_pk_bf16(o11[2], o11[3]);
                    *(u32x4*)(rowp) = w;
                    w.x = cvt_pk_bf16(o20[0], o20[1]); w.y = cvt_pk_bf16(o20[2], o20[3]); w.z = cvt_pk_bf16(o21[0], o21[1]); w.w = cvt_pk_bf16(o21[2], o21[3]);
                    *(u32x4*)(rowp + HALF) = w; }
        } else if (u.pn >= 36 && u.pn < 44) {
#pragma unroll
            for (int ai = 0; ai < 2; ++ai)
#pragma unroll
                for (int m = 0; m < 4; ++m) { float* rowp = gatez + (size_t)(row0 + ai * HALF + m * 16) * 2048 + (u.pn - 36) * BM + colw;
#pragma unroll
                    for (int bj = 0; bj < 2; ++bj) { *(f32x4*)(rowp + bj * HALF) = acc[ai][bj][m][0]; *(f32x4*)(rowp + bj * HALF + 4) = acc[ai][bj][m][1]; } }
        } else {
#pragma unroll
            for (int ai = 0; ai < 2; ++ai)
#pragma unroll
                for (int m = 0; m < 4; ++m) { bf16* rowp = proj + (size_t)(row0 + ai * HALF + m * 16) * NPROJ + u.pn * BM + colw;
#pragma unroll
                    for (int bj = 0; bj < 2; ++bj) { const f32x4 v0 = acc[ai][bj][m][0], v1 = acc[ai][bj][m][1];
                        u32x4 w; w.x = cvt_pk_bf16(v0[0], v0[1]); w.y = cvt_pk_bf16(v0[2], v0[3]); w.z = cvt_pk_bf16(v1[0], v1[1]); w.w = cvt_pk_bf16(v1[2], v1[3]);
                        *(u32x4*)(rowp + bj * HALF) = w; } }
        }
    }
};
struct EpiSwiGlu {
    static constexpr bool PERM = true;
    bf16* H; int ldc;
    __device__ __forceinline__ void operator()(const f32x4 (&acc)[2][2][4][2], const Unit& u, int wr, int wc, int fr, int fq) const {
        const int row0 = u.pm * BM + wr * 64 + fr, col0 = u.pn * HALF + wc * 32 + 8 * fq;
#pragma unroll
        for (int ai = 0; ai < 2; ++ai)
#pragma unroll
            for (int m = 0; m < 4; ++m) { bf16* rowp = H + (size_t)(row0 + ai * HALF + m * 16) * ldc + col0;
                f32x4 v0, v1;
#pragma unroll
                for (int j = 0; j < 4; ++j) { v0[j] = silu_f(acc[ai][0][m][0][j]) * acc[ai][1][m][0][j]; v1[j] = silu_f(acc[ai][0][m][1][j]) * acc[ai][1][m][1][j]; }
                u32x4 w; w.x = cvt_pk_bf16(v0[0], v0[1]); w.y = cvt_pk_bf16(v0[2], v0[3]); w.z = cvt_pk_bf16(v1[0], v1[1]); w.w = cvt_pk_bf16(v1[2], v1[3]);
                *(u32x4*)(rowp) = w; }
    }
};
struct EpiFourier {
    static constexpr bool PERM = true;
    bf16* O; const float* bias;
    __device__ __forceinline__ void operator()(const f32x4 (&acc)[2][2][4][2], const Unit& u, int wr, int wc, int fr, int fq) const {
        const int row0 = u.pm * BM + wr * 64 + fr, b = u.pn >> 2, colt = (u.pn & 3) * BM + wc * 32 + 8 * fq;
#pragma unroll
        for (int ai = 0; ai < 2; ++ai)
#pragma unroll
            for (int m = 0; m < 4; ++m) { bf16* rowp = O + (size_t)(b * SEQ + row0 + ai * HALF + m * 16) * D + 3072 + colt;
#pragma unroll
                for (int bj = 0; bj < 2; ++bj) { const f32x4 bb0 = *(const f32x4*)(bias + colt + bj * HALF), bb1 = *(const f32x4*)(bias + colt + bj * HALF + 4);
                    const f32x4 v0 = acc[ai][bj][m][0] + bb0, v1 = acc[ai][bj][m][1] + bb1;
                    u32x4 w; w.x = cvt_pk_bf16(v0[0], v0[1]); w.y = cvt_pk_bf16(v0[2], v0[3]); w.z = cvt_pk_bf16(v1[0], v1[1]); w.w = cvt_pk_bf16(v1[2], v1[3]);
                    *(u32x4*)(rowp + bj * HALF) = w; } }
    }
};

template <class Epi, class Sched, bool ALIGN_EPI = false, bool SP2 = false>
__device__ __forceinline__ void gemm_phase(LAS unsigned char* lds, const Gemm g, const Sched& S, const Epi& E) {
    int tid_ = threadIdx.x; asm volatile("" : "+v"(tid_));
    const int tid = tid_, wid = __builtin_amdgcn_readfirstlane(tid >> 6), lane = tid & 63, wr = wid >> 2, wc = wid & 3, fr = lane & 15, fq = lane >> 4;
    const int K = g.K, nt = K / BK;
    unsigned voffA[2], voffB[2];
#pragma unroll
    for (int i = 0; i < 2; ++i) { int R, C; stage_rc(tid * 16 + i * 8192, R, C); const int Rb = Epi::PERM ? ((R & ~31) + perm32(R & 31)) : R;
        voffA[i] = (unsigned)(R * K + C) * 2u; voffB[i] = (unsigned)(Rb * K + C) * 2u; }
    const size_t kstep = (size_t)(BK * 2);
    const size_t hstep = (size_t)HALF * K * 2;
    const size_t tstep = 2 * hstep;
    const unsigned ldsw = (unsigned)wid * 1024u;
    const int aoff = lds_byte(wr * 64 + fr, fq * 8), boff = lds_byte(wc * 32 + fr, fq * 8);
#define PG8_SA(b, h) (((b) * 2 + (h)) * HTB)
#define PG8_SB(b, h) ((4 + (b) * 2 + (h)) * HTB)
#define PG8_STAGE(bufoff, gbase, voff) do { _Pragma("unroll") for (int _i = 0; _i < 2; ++_i) \
        __builtin_amdgcn_global_load_lds((const unsigned*)((const char*)(gbase) + (voff)[_i]), (LAS unsigned*)(lds + (bufoff) + ldsw + _i * 8192), 16, 0, 0); } while (0)
#define PG8_LDA(dst, b, h) do { _Pragma("unroll") for (int m = 0; m < 4; ++m) _Pragma("unroll") for (int k = 0; k < 2; ++k) dst[m][k] = *(const LAS bf16x8*)(lds + PG8_SA(b, h) + aoff + m * 2048 + k * 1024); } while (0)
#define PG8_LDB(dst, b, h) do { _Pragma("unroll") for (int n = 0; n < 2; ++n) _Pragma("unroll") for (int k = 0; k < 2; ++k) dst[n][k] = *(const LAS bf16x8*)(lds + PG8_SB(b, h) + boff + n * 2048 + k * 1024); } while (0)
#define PG8_MMA(ai, bj, At, Bt) do { __builtin_amdgcn_s_setprio(1); _Pragma("unroll") for (int m = 0; m < 4; ++m) _Pragma("unroll") for (int n = 0; n < 2; ++n) _Pragma("unroll") for (int k = 0; k < 2; ++k) \
        acc[ai][bj][m][n] = __builtin_amdgcn_mfma_f32_16x16x32_bf16(Bt[n][k], At[m][k], acc[ai][bj][m][n], 0, 0, 0); __builtin_amdgcn_s_setprio(0); } while (0)
#define PG8_WAIT_V(n) asm volatile("s_waitcnt vmcnt(" #n ")" ::: "memory")
#define PG8_WAIT_L(n) asm volatile("s_waitcnt lgkmcnt(" #n ")" ::: "memory")
#define PG8_BAR __builtin_amdgcn_s_barrier()
#define PG8_SCHED __builtin_amdgcn_sched_barrier(0)
    Unit cur, nxt; int ui = 0;
    if (!S.next(0, cur)) return;
    f32x4 acc[2][2][4][2];
#pragma unroll
    for (int a = 0; a < 2; ++a)
#pragma unroll
        for (int b = 0; b < 2; ++b)
#pragma unroll
            for (int m = 0; m < 4; ++m)
#pragma unroll
                for (int n = 0; n < 2; ++n) acc[a][b][m][n] = (f32x4){0.f, 0.f, 0.f, 0.f};
    bf16x8 At[4][2], B0[2][2], B1[2][2];
    const char* cA = (const char*)g.A + (size_t)cur.pm * tstep; const char* cB = (const char*)g.Bt + (size_t)cur.pn * tstep;
    S.a_ready(cur);
    if constexpr (SP2) {
        PG8_STAGE(PG8_SB(0, 0), cB, voffB); PG8_STAGE(PG8_SB(0, 1), cB + hstep, voffB); PG8_STAGE(PG8_SA(0, 0), cA, voffA); PG8_STAGE(PG8_SA(0, 1), cA + hstep, voffA);
        if (wr == 1) PG8_BAR;
        PG8_WAIT_V(2); PG8_BAR;
        PG8_STAGE(PG8_SB(1, 0), cB + kstep, voffB); PG8_STAGE(PG8_SA(1, 0), cA + kstep, voffA); PG8_STAGE(PG8_SB(1, 1), cB + hstep + kstep, voffB);
        PG8_WAIT_V(6); PG8_BAR;
    } else {
        PG8_STAGE(PG8_SB(0, 0), cB, voffB); PG8_STAGE(PG8_SA(0, 0), cA, voffA); PG8_STAGE(PG8_SB(0, 1), cB + hstep, voffB); PG8_STAGE(PG8_SA(0, 1), cA + hstep, voffA);
        if (wr == 1) PG8_BAR;
        PG8_WAIT_V(4); PG8_BAR;
        PG8_STAGE(PG8_SB(1, 0), cB + kstep, voffB); PG8_STAGE(PG8_SA(1, 0), cA + kstep, voffA); PG8_STAGE(PG8_SB(1, 1), cB + hstep + kstep, voffB);
        PG8_WAIT_V(6); PG8_BAR;
    }
    for (;;) {
        const bool has_next = S.next(ui + 1, nxt);
        const char* nA = has_next ? (const char*)g.A + (size_t)nxt.pm * tstep : cA; const char* nB = has_next ? (const char*)g.Bt + (size_t)nxt.pn * tstep : cB;
        for (int t = 0; t < nt; t += 2) {
            const bool last = (t == nt - 2);
            const char* a1 = cA + (size_t)(t + 1) * kstep;
            const char* a2 = last ? nA : cA + (size_t)(t + 2) * kstep; const char* b2 = last ? nB : cB + (size_t)(t + 2) * kstep;
            const char* a3 = a2 + kstep; const char* b3 = b2 + kstep;
            if (last && has_next) S.a_ready(nxt);
            if constexpr (SP2) {
            PG8_LDB(B0, 0, 0); PG8_LDB(B1, 0, 1); PG8_SCHED; PG8_LDA(At, 0, 0); PG8_STAGE(PG8_SA(1, 1), a1 + hstep, voffA);
            PG8_WAIT_V(8); PG8_WAIT_L(0); PG8_BAR; PG8_MMA(0, 0, At, B0); PG8_MMA(0, 1, At, B1); PG8_BAR; PG8_SCHED;
            PG8_LDA(At, 0, 1); PG8_STAGE(PG8_SB(0, 0), b2, voffB); PG8_STAGE(PG8_SB(0, 1), b2 + hstep, voffB); PG8_STAGE(PG8_SA(0, 0), a2, voffA);
            PG8_WAIT_V(8); PG8_WAIT_L(0); PG8_BAR; PG8_MMA(1, 0, At, B0); PG8_MMA(1, 1, At, B1); PG8_BAR; PG8_SCHED;
            PG8_LDB(B0, 1, 0); PG8_LDB(B1, 1, 1); PG8_SCHED; PG8_LDA(At, 1, 0); PG8_STAGE(PG8_SA(0, 1), a2 + hstep, voffA);
            PG8_WAIT_V(8); PG8_WAIT_L(0); PG8_BAR; PG8_MMA(0, 0, At, B0); PG8_MMA(0, 1, At, B1); PG8_BAR; PG8_SCHED;
            PG8_LDA(At, 1, 1); PG8_STAGE(PG8_SB(1, 0), b3, voffB); PG8_STAGE(PG8_SB(1, 1), b3 + hstep, voffB); PG8_STAGE(PG8_SA(1, 0), a3, voffA);
            PG8_WAIT_V(8); PG8_WAIT_L(0); PG8_BAR; PG8_MMA(1, 0, At, B0); PG8_MMA(1, 1, At, B1); PG8_BAR; PG8_SCHED;
            } else {
            PG8_LDB(B0, 0, 0); PG8_SCHED; PG8_LDA(At, 0, 0); PG8_STAGE(PG8_SA(1, 1), a1 + hstep, voffA);
            PG8_WAIT_L(8); PG8_BAR; PG8_WAIT_L(0); PG8_MMA(0, 0, At, B0); PG8_BAR; PG8_SCHED;
            PG8_LDB(B1, 0, 1); PG8_STAGE(PG8_SB(0, 0), b2, voffB);
            PG8_BAR; PG8_WAIT_L(0); PG8_MMA(0, 1, At, B1); PG8_BAR;
            PG8_LDA(At, 0, 1); PG8_STAGE(PG8_SA(0, 0), a2, voffA);
            PG8_BAR; PG8_WAIT_L(0); PG8_MMA(1, 0, At, B0); PG8_BAR; PG8_SCHED;
            PG8_STAGE(PG8_SB(0, 1), b2 + hstep, voffB);
            PG8_WAIT_V(6); PG8_BAR; PG8_MMA(1, 1, At, B1); PG8_BAR;
            PG8_LDB(B0, 1, 0); PG8_SCHED; PG8_LDA(At, 1, 0); PG8_STAGE(PG8_SA(0, 1), a2 + hstep, voffA);
            PG8_WAIT_L(8); PG8_BAR; PG8_WAIT_L(0); PG8_MMA(0, 0, At, B0); PG8_BAR; PG8_SCHED;
            PG8_LDB(B1, 1, 1); PG8_STAGE(PG8_SB(1, 0), b3, voffB);
            PG8_BAR; PG8_WAIT_L(0); PG8_MMA(0, 1, At, B1); PG8_BAR;
            PG8_LDA(At, 1, 1); PG8_STAGE(PG8_SA(1, 0), a3, voffA);
            PG8_BAR; PG8_WAIT_L(0); PG8_MMA(1, 0, At, B0); PG8_BAR; PG8_SCHED;
            PG8_STAGE(PG8_SB(1, 1), b3 + hstep, voffB);
            PG8_WAIT_V(6); PG8_BAR; PG8_MMA(1, 1, At, B1); PG8_BAR;
            }
        }
        if constexpr (ALIGN_EPI) { if (wr == 0) PG8_BAR; }
        E(acc, cur, wr, wc, fr, fq); S.done(cur);
        if (!has_next) break;
#pragma unroll
        for (int a = 0; a < 2; ++a)
#pragma unroll
            for (int b = 0; b < 2; ++b)
#pragma unroll
                for (int m = 0; m < 4; ++m)
#pragma unroll
                    for (int n = 0; n < 2; ++n) acc[a][b][m][n] = (f32x4){0.f, 0.f, 0.f, 0.f};
        cur = nxt; cA = nA; cB = nB; ++ui;
        if constexpr (ALIGN_EPI) { if (wr == 1) PG8_BAR; }
    }
    PG8_WAIT_V(0);
    if constexpr (!ALIGN_EPI) { if (wr == 0) PG8_BAR; }
    PG8_BAR;
#undef PG8_SA
#undef PG8_SB
#undef PG8_STAGE
#undef PG8_LDA
#undef PG8_LDB
#undef PG8_MMA
#undef PG8_WAIT_V
#undef PG8_WAIT_L
#undef PG8_BAR
#undef PG8_SCHED
}
}
#define PG8_SP2 true
#define PG8_ALIGN true

#define XB_TMO      128
#define XB_XCNT(j)  (256  + 64 * (j))
#define XB_XSUB(j)  (1280 + 64 * (j))
#define XB_XGEN(j)  (2304 + 64 * (j))
#define XB_TOP      3328
#define XB_TOPGEN   3392
#define XCD_BAR_WORDS 3456
#define XB_SPIN_CAP (1u << 18)
__device__ __forceinline__ unsigned xb_ld(unsigned* p)              { return __hip_atomic_load(p, __ATOMIC_RELAXED, __HIP_MEMORY_SCOPE_AGENT); }
__device__ __forceinline__ unsigned xb_add(unsigned* p, unsigned v) { return __hip_atomic_fetch_add(p, v, __ATOMIC_RELAXED, __HIP_MEMORY_SCOPE_AGENT); }
__device__ __forceinline__ unsigned xb_xcc_id() { return (unsigned)__builtin_amdgcn_s_getreg((3 << 11) | 20) & 0xFu; }
#define XB_SPIN(cond, bar) do { unsigned _sp = 0; while (cond) { __builtin_amdgcn_s_sleep(1); \
    if ((++_sp & 255u) == 0u) { if (xb_ld(&(bar)[XB_TMO])) break; if (_sp > XB_SPIN_CAP) { atomicAdd(&(bar)[XB_TMO], 1u); break; } } } } while (0)
struct XcdBarrier { unsigned* bar; unsigned x; volatile LAS unsigned* st; };
__device__ __forceinline__ XcdBarrier xcd_barrier_post(unsigned* bar, volatile LAS unsigned* st) {
    XcdBarrier b; b.bar = bar; b.x = xb_xcc_id(); b.st = st;
    if (threadIdx.x == 0) (void)xb_add(&bar[XB_XCNT(b.x)], 1u);
    return b;
}
__device__ __forceinline__ void xcd_barrier_complete(unsigned* bar, unsigned x, unsigned& nloc, unsigned& nx) {
    const unsigned G = gridDim.x * gridDim.y * gridDim.z;
    unsigned sum, cnt, mine, sp = 0u;
    for (;;) {
        sum = 0u; cnt = 0u; mine = 0u;
#pragma unroll
        for (unsigned j = 0; j < 16; ++j) { const unsigned c = xb_ld(&bar[XB_XCNT(j)]); sum += c; cnt += (c > 0u) ? 1u : 0u; mine = (j == x) ? c : mine; }
        if (sum == G) break;
        __builtin_amdgcn_s_sleep(1);
        if ((++sp & 255u) == 0u) { if (xb_ld(&bar[XB_TMO])) break; if (sp > XB_SPIN_CAP) { atomicAdd(&bar[XB_TMO], 1u); break; } }
    }
    nloc = mine > 0u ? mine : 1u; nx = cnt > 0u ? cnt : 1u;
}
__device__ __forceinline__ void xcd_barrier(const XcdBarrier& b) {
    asm volatile("s_waitcnt vmcnt(0)" ::: "memory");
    __syncthreads();
    if (threadIdx.x == 0) {
        unsigned* bar = b.bar;
        __builtin_amdgcn_s_waitcnt(0);
        unsigned nloc = b.st[0], nx = b.st[1];
        if (nloc == 0u) { xcd_barrier_complete(bar, b.x, nloc, nx); b.st[0] = nloc; b.st[1] = nx; }
        const unsigned old = xb_add(&bar[XB_XSUB(b.x)], 1u);
        const unsigned gen = old / nloc;
        if (old + 1u == (gen + 1u) * nloc) {
            __builtin_amdgcn_fence(__ATOMIC_RELEASE, "agent");
            asm volatile("s_waitcnt vmcnt(0)" ::: "memory");
            const unsigned og = xb_add(&bar[XB_TOP], 1u);
            const unsigned tg = og / nx;
            if (og + 1u == (tg + 1u) * nx) xb_add(&bar[XB_TOPGEN], 1u);
            else XB_SPIN(xb_ld(&bar[XB_TOPGEN]) == tg, bar);
            __builtin_amdgcn_fence(__ATOMIC_ACQUIRE, "agent");
            xb_add(&bar[XB_XGEN(b.x)], 1u);
            asm volatile("s_waitcnt vmcnt(0)" ::: "memory");
        } else {
            XB_SPIN(xb_ld(&bar[XB_XGEN(b.x)]) == gen, bar);
            __builtin_amdgcn_fence(__ATOMIC_ACQUIRE, "agent");
            asm volatile("s_waitcnt vmcnt(0)" ::: "memory");
        }
    }
    __syncthreads();
}

struct Args { const float* in[23]; float* out; unsigned char* ws; int layer_lo, layer_hi, ph_lo, ph_hi, single, pad; };
struct Frame {
    LAS unsigned char* lds;
    int tid, lane, wave, vcu, G, gw, NGW;
    unsigned char* ws;
};
enum { PH_PRE = 0, PH_CONV, PH_INPROJ, PH_MIXA, PH_MIXB, PH_WOUT, PH_NORM1, PH_XQ, PH_XATT, PH_XWO, PH_NORM2, PH_FFN1, PH_FFN2, PH_NORM3, PH_COUNT };

__device__ __forceinline__ void transpose_item(const float* W, int K, int N, bf16* WT, int drow0, int k0, int n0, LAS float* scr, int lane) {
#pragma unroll 8
    for (int i = 0; i < 32; ++i) { const int kk = 2 * i + (lane >> 5); scr[kk * 33 + (lane & 31)] = W[(size_t)(k0 + kk) * N + n0 + (lane & 31)]; }
    LDS_WAIT(); asm volatile("" ::: "memory");
    const int c = lane & 7;
#pragma unroll
    for (int j = 0; j < 4; ++j) { const int n = (lane >> 3) + 8 * j; const LAS float* s = scr + (8 * c) * 33 + n;
        u32x4 o; o.x = cvt_pk_bf16(s[0 * 33], s[1 * 33]); o.y = cvt_pk_bf16(s[2 * 33], s[3 * 33]); o.z = cvt_pk_bf16(s[4 * 33], s[5 * 33]); o.w = cvt_pk_bf16(s[6 * 33], s[7 * 33]);
        *(GAS u32x4*)(WT + (size_t)(drow0 + n) * K + k0 + 8 * c) = o; }
    LDS_WAIT(); asm volatile("" ::: "memory");
}
__device__ __forceinline__ void convert_matrix(Frame& F, const float* W, int K, int N, bf16* WT, int row_off, int mode, LAS float* scr) {
    const int nblk = N / 32, items = (K / 64) * nblk;
    for (int it = F.gw; it < items; it += F.NGW) {
        const int kb = it / nblk, nb = it % nblk, n0 = 32 * nb;
        const int drow0 = mode == 0 ? row_off + n0 : ((n0 >> 7) * 256 + (mode == 2 ? 128 : 0) + (n0 & 127));
        transpose_item(W, K, N, WT, drow0, 64 * kb, n0, scr, F.lane);
    }
}

__device__ __forceinline__ void rms_row_to_bf16(const float* xrow, const float* g, bf16* orow, int lane) {
    const f32x4* xr = (const f32x4*)xrow + lane; const f32x4* gr = (const f32x4*)g + lane;
    f32x4 v[16]; float s = 0.f;
#pragma unroll
    for (int j = 0; j < 16; ++j) { v[j] = xr[64 * j]; s += (v[j].x * v[j].x + v[j].y * v[j].y) + (v[j].z * v[j].z + v[j].w * v[j].w); }
    const float r = 1.0f / sqrtf(wave_sum(s) * (1.0f / D) + RMS_EPS);
    u32x2* o8 = (u32x2*)orow + lane;
#pragma unroll
    for (int j = 0; j < 16; ++j) { const f32x4 gg = gr[64 * j]; u32x2 w; w.x = cvt_pk_bf16(v[j].x * r * gg.x, v[j].y * r * gg.y); w.y = cvt_pk_bf16(v[j].z * r * gg.z, v[j].w * r * gg.w); o8[64 * j] = w; }
}
__device__ __forceinline__ void norm_phase(Frame& F, const float* tmp, const float* hin, float* hout, const float* gpost, const float* gnext, bf16* aout) {
    for (int row = F.gw; row < M; row += F.NGW) {
        const f32x4* tr = (const f32x4*)(tmp + (size_t)row * D) + F.lane; const f32x4* hr = (const f32x4*)(hin + (size_t)row * D) + F.lane;
        const f32x4* gp = (const f32x4*)gpost + F.lane;
        f32x4 v[16]; float s = 0.f;
#pragma unroll
        for (int j = 0; j < 16; ++j) { v[j] = tr[64 * j]; s += (v[j].x * v[j].x + v[j].y * v[j].y) + (v[j].z * v[j].z + v[j].w * v[j].w); }
        const float r = 1.0f / sqrtf(wave_sum(s) * (1.0f / D) + RMS_EPS);
        f32x4* ho = (f32x4*)(hout + (size_t)row * D) + F.lane; float s2 = 0.f;
#pragma unroll
        for (int j = 0; j < 16; ++j) { const f32x4 hh = hr[64 * j], gg = gp[64 * j]; v[j] = hh + v[j] * r * gg; ho[64 * j] = v[j]; s2 += (v[j].x * v[j].x + v[j].y * v[j].y) + (v[j].z * v[j].z + v[j].w * v[j].w); }
        if (gnext) {
            const float r2 = 1.0f / sqrtf(wave_sum(s2) * (1.0f / D) + RMS_EPS);
            const f32x4* gn = (const f32x4*)gnext + F.lane; u32x2* o8 = (u32x2*)(aout + (size_t)row * D) + F.lane;
#pragma unroll
            for (int j = 0; j < 16; ++j) { const f32x4 gg = gn[64 * j]; u32x2 w; w.x = cvt_pk_bf16(v[j].x * r2 * gg.x, v[j].y * r2 * gg.y); w.y = cvt_pk_bf16(v[j].z * r2 * gg.z, v[j].w * r2 * gg.w); o8[64 * j] = w; }
        }
    }
}

__device__ __forceinline__ void retention_naive(Frame& F, const bf16* proj, float* rof, float* rob) {
    LAS float* qs = (LAS float*)F.lds;
    LAS float* ks = qs + 32 * 256;
    LAS float* vs = ks + 32 * 256;
    LAS float* os = vs + 32 * 32;
    for (int item = F.vcu; item < 16 * 2 * 8; item += F.G) {
        const int es = item & 7, dir = (item >> 3) & 1, bh = item >> 4, b = bh >> 3, h = bh & 7;
        const int hg = dir ? (7 - h) : h; const float gam = 1.0f - exp2f(-5.0f - (float)hg);
        const int e0 = es * 32, dg = F.lane & 15, el = 4 * F.wave + (F.lane >> 4);
        float* outp = dir ? rob : rof;
        float St[16];
#pragma unroll
        for (int i = 0; i < 16; ++i) St[i] = 0.f;
        for (int blk = 0; blk < SEQ / 32; ++blk) {
            __syncthreads();
            { const int s = F.tid >> 4, ch = F.tid & 15; const int t = dir ? (SEQ - 1 - (blk * 32 + s)) : (blk * 32 + s);
              const bf16* qp = proj + (size_t)(b * SEQ + t) * NPROJ + C_RQ + h * RD + ch * 16; const bf16* kp = proj + (size_t)(b * SEQ + t) * NPROJ + C_RK + h * RD + ch * 16;
              const u32x4 q0 = *(const u32x4*)qp, q1 = *(const u32x4*)(qp + 8), k0 = *(const u32x4*)kp, k1 = *(const u32x4*)(kp + 8);
              LAS f32x4* qd = (LAS f32x4*)(qs + s * 256 + ch * 16); LAS f32x4* kd = (LAS f32x4*)(ks + s * 256 + ch * 16);
              qd[0] = (f32x4){bflo(q0.x), bfhi(q0.x), bflo(q0.y), bfhi(q0.y)}; qd[1] = (f32x4){bflo(q0.z), bfhi(q0.z), bflo(q0.w), bfhi(q0.w)};
              qd[2] = (f32x4){bflo(q1.x), bfhi(q1.x), bflo(q1.y), bfhi(q1.y)}; qd[3] = (f32x4){bflo(q1.z), bfhi(q1.z), bflo(q1.w), bfhi(q1.w)};
              kd[0] = (f32x4){bflo(k0.x), bfhi(k0.x), bflo(k0.y), bfhi(k0.y)}; kd[1] = (f32x4){bflo(k0.z), bfhi(k0.z), bflo(k0.w), bfhi(k0.w)};
              kd[2] = (f32x4){bflo(k1.x), bfhi(k1.x), bflo(k1.y), bfhi(k1.y)}; kd[3] = (f32x4){bflo(k1.z), bfhi(k1.z), bflo(k1.w), bfhi(k1.w)};
              if (F.tid < 256) { const int s2 = F.tid >> 3, c4 = F.tid & 7; const int t2 = dir ? (SEQ - 1 - (blk * 32 + s2)) : (blk * 32 + s2);
                  const u32x2 vv = *(const u32x2*)(proj + (size_t)(b * SEQ + t2) * NPROJ + C_RV + h * RD + e0 + c4 * 4);
                  *(LAS f32x4*)(vs + s2 * 32 + c4 * 4) = (f32x4){bflo(vv.x), bfhi(vv.x), bflo(vv.y), bfhi(vv.y)}; } }
            __syncthreads();
            for (int s = 0; s < 32; ++s) {
                const LAS f32x4* qv = (const LAS f32x4*)(qs + s * 256 + dg * 16); const LAS f32x4* kv = (const LAS f32x4*)(ks + s * 256 + dg * 16);
                const float vv = vs[s * 32 + el];
                float dot = 0.f;
#pragma unroll
                for (int c = 0; c < 4; ++c) { const f32x4 q4 = qv[c], k4 = kv[c];
#pragma unroll
                    for (int j = 0; j < 4; ++j) { float sv = St[4 * c + j] * gam; if (dir) dot += q4[j] * sv; sv += k4[j] * vv; if (!dir) dot += q4[j] * sv; St[4 * c + j] = sv; } }
                dot += __shfl_xor(dot, 1); dot += __shfl_xor(dot, 2); dot += __shfl_xor(dot, 4); dot += __shfl_xor(dot, 8);
                if (dg == 0) os[s * 32 + el] = dot;
            }
            __syncthreads();
            { const int s = F.tid >> 4, c2 = F.tid & 15; const int t = dir ? (SEQ - 1 - (blk * 32 + s)) : (blk * 32 + s);
              *(f32x2*)(outp + (size_t)(b * SEQ + t) * RW + h * RD + e0 + c2 * 2) = *(const LAS f32x2*)(os + s * 32 + c2 * 2); }
        }
    }
    __syncthreads();
}
__device__ __forceinline__ void hgrn_naive(Frame& F, const bf16* proj, const float* gatez, const float* lblog, int layer, float* hof, float* hob) {
    LAS float* qs = (LAS float*)F.lds;
    LAS float* fs = qs + 32 * 128;
    LAS float* vs = fs + 32 * 128;
    LAS float* os = vs + 32 * 16;
    for (int item = F.vcu; item < 16 * 2 * 8; item += F.G) {
        const int es = item & 7, dir = (item >> 3) & 1, bh = item >> 4, b = bh >> 3, h = bh & 7;
        const int e0 = es * 16, dg = F.lane & 31, el = 2 * F.wave + (F.lane >> 5);
        float* outp = dir ? hob : hof;
        float St[4] = {0.f, 0.f, 0.f, 0.f};
        const int sch = F.tid & 15;
        float lbv[8];
#pragma unroll
        for (int j = 0; j < 8; ++j) { float acc = 0.f;
            if (layer > 0) { const int col = h * HD + sch * 8 + j; float mx = -1e30f; for (int l = 0; l < NL; ++l) mx = fmaxf(mx, lblog[(l * 2 + dir) * HW + col]);
                float den = 0.f, num = 0.f; for (int l = 0; l < NL; ++l) { const float ev = __expf(lblog[(l * 2 + dir) * HW + col] - mx); den += ev; if (l >= 1 && l <= layer) num += ev; } acc = num / den; }
            lbv[j] = acc; }
        for (int blk = 0; blk < SEQ / 32; ++blk) {
            __syncthreads();
            { const int s = F.tid >> 4; const int t = dir ? (SEQ - 1 - (blk * 32 + s)) : (blk * 32 + s);
              const u32x4 q0 = *(const u32x4*)(proj + (size_t)(b * SEQ + t) * NPROJ + C_HQ + h * HD + sch * 8);
              const float qsc = 0.08838834764831845f;
              LAS f32x4* qd = (LAS f32x4*)(qs + s * 128 + sch * 8);
              qd[0] = (f32x4){bflo(q0.x), bfhi(q0.x), bflo(q0.y), bfhi(q0.y)} * qsc; qd[1] = (f32x4){bflo(q0.z), bfhi(q0.z), bflo(q0.w), bfhi(q0.w)} * qsc;
              const float* zp = gatez + (size_t)(b * SEQ + t) * 2048 + dir * HW + h * HD + sch * 8;
              const f32x4 z0 = *(const f32x4*)zp, z1 = *(const f32x4*)(zp + 4);
              f32x4 f0, f1;
#pragma unroll
              for (int j = 0; j < 4; ++j) { f0[j] = lbv[j] + (1.0f - lbv[j]) * fast_sigmoid(z0[j]); f1[j] = lbv[4 + j] + (1.0f - lbv[4 + j]) * fast_sigmoid(z1[j]); }
              LAS f32x4* fd = (LAS f32x4*)(fs + s * 128 + sch * 8); fd[0] = f0; fd[1] = f1;
              if (F.tid < 128) { const int s2 = F.tid >> 2, c4 = F.tid & 3; const int t2 = dir ? (SEQ - 1 - (blk * 32 + s2)) : (blk * 32 + s2);
                  const u32x2 vv = *(const u32x2*)(proj + (size_t)(b * SEQ + t2) * NPROJ + C_HI + h * HD + e0 + c4 * 4);
                  *(LAS f32x4*)(vs + s2 * 16 + c4 * 4) = (f32x4){bflo(vv.x), bfhi(vv.x), bflo(vv.y), bfhi(vv.y)}; } }
            __syncthreads();
            for (int s = 0; s < 32; ++s) {
                const f32x4 q4 = *(const LAS f32x4*)(qs + s * 128 + dg * 4), f4 = *(const LAS f32x4*)(fs + s * 128 + dg * 4);
                const float vv = vs[s * 16 + el];
                float dot = 0.f;
#pragma unroll
                for (int j = 0; j < 4; ++j) { const float sv = f4[j] * St[j] + (1.0f - f4[j]) * vv; dot += q4[j] * sv; St[j] = sv; }
                dot += __shfl_xor(dot, 1); dot += __shfl_xor(dot, 2); dot += __shfl_xor(dot, 4); dot += __shfl_xor(dot, 8); dot += __shfl_xor(dot, 16);
                if (dg == 0) os[s * 16 + el] = dot;
            }
            __syncthreads();
            { const int s = F.tid >> 4, c1 = F.tid & 15; const int t = dir ? (SEQ - 1 - (blk * 32 + s)) : (blk * 32 + s);
              outp[(size_t)(b * SEQ + t) * HW + h * HD + e0 + c1] = os[s * 16 + c1]; }
        }
    }
    __syncthreads();
}
__device__ __forceinline__ void mixer_finalize(Frame& F, const bf16* proj, const float* rof, const float* rob, const float* hof, const float* hob, const float* rng, const float* hng, bf16* mixin) {
    for (int it = F.gw; it < M * RH; it += F.NGW) {
        const int row = it >> 3, h = it & 7; const size_t o = (size_t)row * RW + h * RD + F.lane * 4;
        const f32x4 a = *(const f32x4*)(rof + o), bq = *(const f32x4*)(rob + o); const f32x4 v = a + bq;
        const float mu = wave_sum((v.x + v.y) + (v.z + v.w)) * (1.0f / RD);
        const f32x4 dv = v - mu; const float var = wave_sum((dv.x * dv.x + dv.y * dv.y) + (dv.z * dv.z + dv.w * dv.w)) * (1.0f / RD);
        const float rs = 1.0f / sqrtf(var + GN_EPS);
        const f32x4 g = *(const f32x4*)(rng + h * RD + F.lane * 4);
        const u32x2 gt = *(const u32x2*)(proj + (size_t)row * NPROJ + C_RG + h * RD + F.lane * 4);
        const f32x4 gate = (f32x4){silu_f(bflo(gt.x)), silu_f(bfhi(gt.x)), silu_f(bflo(gt.y)), silu_f(bfhi(gt.y))};
        const f32x4 y = dv * rs * g * gate;
        u32x2 w; w.x = cvt_pk_bf16(y.x, y.y); w.y = cvt_pk_bf16(y.z, y.w);
        *(u32x2*)(mixin + (size_t)row * D + h * RD + F.lane * 4) = w;
    }
    for (int it = F.gw; it < M * HH; it += F.NGW) {
        const int row = it >> 3, h = it & 7; const size_t o = (size_t)row * HW + h * HD + F.lane * 2;
        const f32x2 a = *(const f32x2*)(hof + o), bq = *(const f32x2*)(hob + o); const f32x2 v = a + bq;
        const float ms = wave_sum(v.x * v.x + v.y * v.y) * (1.0f / HD);
        const float rs = 1.0f / sqrtf(ms + RMS_EPS);
        const f32x2 g = *(const f32x2*)(hng + h * HD + F.lane * 2);
        const unsigned gt = *(const unsigned*)(proj + (size_t)row * NPROJ + C_HG + h * HD + F.lane * 2);
        const float y0 = v.x * rs * g.x * silu_f(bflo(gt)), y1 = v.y * rs * g.y * silu_f(bfhi(gt));
        *(unsigned*)(mixin + (size_t)row * D + RW + h * HD + F.lane * 2) = cvt_pk_bf16(y0, y1);
    }
}

template <int MT, int NT, bool TR>
__device__ __forceinline__ void wave_mma(f32x4 (&acc)[MT][NT], const LAS bf16* A, int lda, const LAS bf16* Bm, int ldb, int K, int lane) {
    const int r = lane & 15, q = lane >> 4;
    for (int k0 = 0; k0 < K; k0 += 32) {
        bf16x8 a[MT], b[NT];
#pragma unroll
        for (int mt = 0; mt < MT; ++mt) a[mt] = *(const LAS bf16x8*)(A + (mt * 16 + r) * lda + k0 + 8 * q);
#pragma unroll
        for (int nt = 0; nt < NT; ++nt) b[nt] = *(const LAS bf16x8*)(Bm + (nt * 16 + r) * ldb + k0 + 8 * q);
#pragma unroll
        for (int mt = 0; mt < MT; ++mt)
#pragma unroll
            for (int nt = 0; nt < NT; ++nt)
                acc[mt][nt] = TR ? __builtin_amdgcn_mfma_f32_16x16x32_bf16(b[nt], a[mt], acc[mt][nt], 0, 0, 0) : __builtin_amdgcn_mfma_f32_16x16x32_bf16(a[mt], b[nt], acc[mt][nt], 0, 0, 0);
    }
}
__device__ __forceinline__ void stage_tile(LAS bf16* dst, int lld, const bf16* src, size_t gld, int rows, int cols, int tid) {
    const int cpr = cols >> 3, total = rows * cpr;
    for (int i = tid; i < total; i += NWAVES * 64) { const int r = i / cpr, c = i - r * cpr; *(LAS u32x4*)(dst + r * lld + c * 8) = *(const u32x4*)(src + (size_t)r * gld + c * 8); }
}
__device__ __forceinline__ void stage_tile_tr(LAS bf16* dst, int lld, const bf16* src, size_t gld, int rows, int cols, int tid) {
    const int cpr = cols >> 3, total = rows * cpr;
    for (int i = tid; i < total; i += NWAVES * 64) { const int c = i / rows, r = i - c * rows; const u32x4 v = *(const u32x4*)(src + (size_t)r * gld + c * 8);
        LAS bf16* d = dst + (c * 8) * lld + r;
        d[0] = (bf16)(v.x & 0xffff); d[lld] = (bf16)(v.x >> 16); d[2 * lld] = (bf16)(v.y & 0xffff); d[3 * lld] = (bf16)(v.y >> 16);
        d[4 * lld] = (bf16)(v.z & 0xffff); d[5 * lld] = (bf16)(v.z >> 16); d[6 * lld] = (bf16)(v.w & 0xffff); d[7 * lld] = (bf16)(v.w >> 16); }
}

__device__ __forceinline__ void fourier_ut(Frame& F, const bf16* proj, const bf16* fwt, bf16* ut) {
    LAS bf16* zs = (LAS bf16*)F.lds;
    LAS bf16* ws = zs + 128 * 136;
    for (int item = F.vcu; item < NB * FG * 32; item += F.G) {
        const int nb = item & 31, g = (item >> 5) & 7, b = item >> 8;
        __syncthreads();
        stage_tile(zs, 136, proj + (size_t)(b * SEQ + nb * 128) * NPROJ + C_FZ + g * FD, NPROJ, 128, 128, F.tid);
        stage_tile(ws, 136, fwt + (size_t)g * 256 * 128, 128, 256, 128, F.tid);
        __syncthreads();
        f32x4 acc[1][16];
#pragma unroll
        for (int nt = 0; nt < 16; ++nt) acc[0][nt] = (f32x4){0.f, 0.f, 0.f, 0.f};
        wave_mma<1, 16, false>(acc, zs + F.wave * 16 * 136, 136, ws, 136, 128, F.lane);
        const int r = F.lane & 15, q = F.lane >> 4; const int n = nb * 128 + F.wave * 16 + 4 * q;
#pragma unroll
        for (int nt = 0; nt < 16; ++nt) { const int dd = nt * 16 + r; const int d = dd & 127, half = dd >> 7;
            u32x2 w; w.x = cvt_pk_bf16(acc[0][nt][0], acc[0][nt][1]); w.y = cvt_pk_bf16(acc[0][nt][2], acc[0][nt][3]);
            *(u32x2*)(ut + (size_t)(b * FW + g * FD + d) * 8192 + half * 4096 + n) = w; }
    }
    __syncthreads();
}

__device__ __forceinline__ void xattn_phase(Frame& F, const bf16* xq, const bf16* kvmem, bf16* xo) {
    LAS bf16* ra = (LAS bf16*)F.lds;
    LAS bf16* rb = ra + 128 * 264;
    for (int item = F.vcu; item < NB * XH * 32; item += F.G) {
        const int qb = item & 31, hd = (item >> 5) & 3, b = item >> 7;
        __syncthreads();
        stage_tile(ra, 264, xq + (size_t)(b * SEQ + qb * 128) * XW + hd * XD, XW, 128, 256, F.tid);
        f32x4 s[2][8];
#pragma unroll
        for (int hf = 0; hf < 2; ++hf) {
            if (hf) __syncthreads();
            stage_tile(rb, 264, kvmem + (size_t)(b * MEMT + hf * 128) * 2048 + hd * XD, 2048, 128, 256, F.tid);
            __syncthreads();
            f32x4 acc[1][8];
#pragma unroll
            for (int nt = 0; nt < 8; ++nt) acc[0][nt] = (f32x4){0.f, 0.f, 0.f, 0.f};
            wave_mma<1, 8, true>(acc, ra + F.wave * 16 * 264, 264, rb, 264, 256, F.lane);
#pragma unroll
            for (int nt = 0; nt < 8; ++nt) s[hf][nt] = acc[0][nt];
        }
        float mx = -1e30f;
#pragma unroll
        for (int hf = 0; hf < 2; ++hf)
#pragma unroll
            for (int nt = 0; nt < 8; ++nt)
#pragma unroll
                for (int j = 0; j < 4; ++j) mx = fmaxf(mx, s[hf][nt][j]);
        mx = fmaxf(mx, __shfl_xor(mx, 16)); mx = fmaxf(mx, __shfl_xor(mx, 32));
        float sum = 0.f;
#pragma unroll
        for (int hf = 0; hf < 2; ++hf)
#pragma unroll
            for (int nt = 0; nt < 8; ++nt)
#pragma unroll
                for (int j = 0; j < 4; ++j) { const float p = __expf(s[hf][nt][j] - mx); s[hf][nt][j] = p; sum += p; }
        sum += __shfl_xor(sum, 16); sum += __shfl_xor(sum, 32);
        const float inv = 1.0f / sum;
        __syncthreads();
        { const int r = F.lane & 15, q = F.lane >> 4; LAS bf16* prow = ra + (F.wave * 16 + r) * 264;
#pragma unroll
          for (int hf = 0; hf < 2; ++hf)
#pragma unroll
              for (int nt = 0; nt < 8; ++nt) { u32x2 w; w.x = cvt_pk_bf16(s[hf][nt][0], s[hf][nt][1]); w.y = cvt_pk_bf16(s[hf][nt][2], s[hf][nt][3]);
                  *(LAS u32x2*)(prow + hf * 128 + nt * 16 + 4 * q) = w; } }
        f32x4 o[1][16];
#pragma unroll
        for (int nt = 0; nt < 16; ++nt) o[0][nt] = (f32x4){0.f, 0.f, 0.f, 0.f};
#pragma unroll
        for (int hf = 0; hf < 2; ++hf) {
            if (hf) __syncthreads();
            stage_tile_tr(rb, 136, kvmem + (size_t)(b * MEMT + hf * 128) * 2048 + 1024 + hd * XD, 2048, 128, 256, F.tid);
            __syncthreads();
            wave_mma<1, 16, true>(o, ra + F.wave * 16 * 264 + hf * 128, 264, rb, 136, 128, F.lane);
        }
        { const int r = F.lane & 15, q = F.lane >> 4; bf16* orow = xo + (size_t)(b * SEQ + qb * 128 + F.wave * 16 + r) * XW + hd * XD + 4 * q;
#pragma unroll
          for (int nt = 0; nt < 16; ++nt) { u32x2 w; w.x = cvt_pk_bf16(o[0][nt][0] * inv, o[0][nt][1] * inv); w.y = cvt_pk_bf16(o[0][nt][2] * inv, o[0][nt][3] * inv); *(u32x2*)(orow + nt * 16) = w; } }
    }
    __syncthreads();
}

__global__ void __launch_bounds__(NWAVES * 64, 2) fwd_kernel(Args args) {
    extern __shared__ __attribute__((aligned(16))) unsigned char lds[];
    Frame F;
    F.lds = (LAS unsigned char*)lds;
    F.tid = threadIdx.x; F.lane = F.tid & 63; F.wave = __builtin_amdgcn_readfirstlane(F.tid >> 6);
    F.G = gridDim.x; { const int bx = blockIdx.x; F.vcu = (F.G % 8 == 0) ? (bx % 8) * (F.G / 8) + bx / 8 : bx; }
    F.gw = F.vcu * NWAVES + F.wave; F.NGW = F.G * NWAVES;
    unsigned char* ws = args.ws; F.ws = ws;
    volatile LAS unsigned* MISC = (volatile LAS unsigned*)(F.lds + MISC_OFF);
    for (int u = F.tid; u < (LDS_BYTES - LDSCTL_OFF) / 4; u += NWAVES * 64) ((LAS unsigned*)(F.lds + LDSCTL_OFF))[u] = 0u;
    __syncthreads();
    XcdBarrier bar; bar.bar = (unsigned*)(ws + WS_CTL) + CW_BAR; bar.x = 0; bar.st = nullptr;
    if (args.single) bar = xcd_barrier_post((unsigned*)(ws + WS_CTL) + CW_BAR, MISC + 8);
#define GRID_BAR() do { if (args.single) xcd_barrier(bar); } while (0)
#define RELAUNDER() do { int t_ = threadIdx.x; asm volatile("" : "+v"(t_)); F.tid = t_; F.lane = t_ & 63; F.wave = __builtin_amdgcn_readfirstlane(t_ >> 6); F.gw = F.vcu * NWAVES + F.wave; } while (0)

    const float* x_in = args.in[0]; const float* mem = args.in[1]; const float* mem_g = args.in[2];
    bf16* W_in = (bf16*)(ws + WS_WIN); bf16* W_out = (bf16*)(ws + WS_WOUT); bf16* W_q = (bf16*)(ws + WS_WQ); bf16* W_kv = (bf16*)(ws + WS_WKV);
    bf16* W_o = (bf16*)(ws + WS_WO); bf16* W_gu = (bf16*)(ws + WS_WGU); bf16* W_dn = (bf16*)(ws + WS_WDN);
    bf16* anorm = (bf16*)(ws + WS_ANORM); bf16* proj = (bf16*)(ws + WS_PROJ); bf16* hid = (bf16*)(ws + WS_PROJ); float* gatez = (float*)(ws + WS_GATEZ);
    bf16* mixin = (bf16*)(ws + WS_MIXIN); float* tmp = (float*)(ws + WS_TMP);
    float* rof = (float*)(ws + WS_SCR); float* rob = (float*)(ws + WS_SCR + 64 * MiB); float* hof = (float*)(ws + WS_SCR + 128 * MiB); float* hob = (float*)(ws + WS_SCR + 160 * MiB);
    bf16* dft = (bf16*)(ws + WS_DFT); bf16* ut = (bf16*)(ws + WS_UT); bf16* xq = (bf16*)(ws + WS_XQ); bf16* xo = (bf16*)(ws + WS_XO);
    bf16* kvmem = (bf16*)(ws + WS_KVMEM); bf16* memn = (bf16*)(ws + WS_MEMN); float* ropec = (float*)(ws + WS_ROPE); float* ropes = ropec + SEQ * 128;
    bf16* fwt = (bf16*)(ws + WS_FWT);
    float* hout = args.out;
    const int lo = args.ph_lo, hi = args.ph_hi;
#ifndef PHASE_MASK
#define PHASE_MASK 0xffffffffu
#endif
#define IN(k) (((PHASE_MASK >> (k)) & 1u) && lo <= (k) && (k) < hi)

    for (int layer = args.layer_lo; layer < args.layer_hi; ++layer) {
        if (IN(PH_PRE) && layer == 0) {
            RELAUNDER();
            const int gt = F.vcu * (NWAVES * 64) + F.tid, NT = F.G * NWAVES * 64;
            for (int i = gt; i < SEQ * 128; i += NT) { const int pos = i >> 7, j = i & 127;
                const float inv = exp2f(-(float)j * (13.287712379549449f / 128.0f)); const float ang = (float)pos * inv;
                const double rev = (double)ang * 0.15915494309189535; const float fr = (float)(rev - __builtin_rint(rev));
                ropec[i] = __builtin_amdgcn_cosf(fr); ropes[i] = __builtin_amdgcn_sinf(fr); }
            for (int i = gt; i < SEQ * 8192 / 8; i += NT) { const int k = i >> 10, c8 = (i & 1023) * 8; const int sn = c8 >> 12, n0 = c8 & 4095;
                float v[8];
#pragma unroll
                for (int j = 0; j < 8; ++j) { const int mm = (k * (n0 + j)) & 4095; const float fr = (float)mm * (1.0f / 4096.0f); v[j] = sn ? __builtin_amdgcn_sinf(fr) : __builtin_amdgcn_cosf(fr); }
                u32x4 w; w.x = cvt_pk_bf16(v[0], v[1]); w.y = cvt_pk_bf16(v[2], v[3]); w.z = cvt_pk_bf16(v[4], v[5]); w.w = cvt_pk_bf16(v[6], v[7]);
                *(u32x4*)(dft + (size_t)k * 8192 + c8) = w; }
            for (int row = F.gw; row < NB * MEMT; row += F.NGW) rms_row_to_bf16(mem + (size_t)row * D, mem_g, memn + (size_t)row * D, F.lane);
            GRID_BAR();
        }
        if (IN(PH_CONV)) {
            RELAUNDER();
            LAS float* scr = (LAS float*)(F.lds + F.wave * 16384);
            convert_matrix(F, args.in[4] + (size_t)layer * D * NPROJ, D, NPROJ, W_in, 0, 0, scr);
            convert_matrix(F, args.in[10] + (size_t)layer * D * D, D, D, W_out, 0, 0, scr);
            convert_matrix(F, args.in[13] + (size_t)layer * D * XW, D, XW, W_q, 0, 0, scr);
            convert_matrix(F, args.in[14] + (size_t)layer * D * XW, D, XW, W_kv, 0, 0, scr);
            convert_matrix(F, args.in[15] + (size_t)layer * D * XW, D, XW, W_kv, XW, 0, scr);
            convert_matrix(F, args.in[16] + (size_t)layer * XW * D, XW, D, W_o, 0, 0, scr);
            convert_matrix(F, args.in[19] + (size_t)layer * D * FFH, D, FFH, W_gu, 0, 1, scr);
            convert_matrix(F, args.in[20] + (size_t)layer * D * FFH, D, FFH, W_gu, 0, 2, scr);
            convert_matrix(F, args.in[21] + (size_t)layer * FFH * D, FFH, D, W_dn, 0, 0, scr);
            { const float* fw = args.in[8] + (size_t)layer * FG * FD * FD; const int gt = F.vcu * (NWAVES * 64) + F.tid, NT = F.G * NWAVES * 64;
              for (int i = gt; i < FG * 256 * 128; i += NT) { const int c = i & 127, dd = (i >> 7) & 255, g = i >> 15; const int d = dd & 127, sn = dd >> 7;
                  float acc = 0.f;
                  for (int cp = 0; cp < 128; ++cp) { const float fr = (float)((c * cp) & 127) * (1.0f / 128.0f); const float tv = sn ? -__builtin_amdgcn_sinf(fr) : __builtin_amdgcn_cosf(fr); acc += tv * fw[(g * FD + cp) * FD + d]; }
                  fwt[i] = (bf16)(cvt_pk_bf16(acc * 0.0013810679320049757f, 0.f) & 0xffff); } }
            if (layer == 0) for (int row = F.gw; row < M; row += F.NGW) rms_row_to_bf16(x_in + (size_t)row * D, args.in[3], anorm + (size_t)row * D, F.lane);
            __syncthreads();
            GRID_BAR();
        }
        if (IN(PH_INPROJ)) {
            RELAUNDER();
            pg8::Gemm g{anorm, W_in, M, NPROJ, D}; pg8::StaticOrder S; S.init(M, NPROJ, F.G, (int)blockIdx.x);
            pg8::EpiInProj E{proj, gatez, ropec, ropes};
            pg8::gemm_phase<pg8::EpiInProj, pg8::StaticOrder, PG8_ALIGN, PG8_SP2>(F.lds, g, S, E);
            GRID_BAR();
        }
        if (IN(PH_MIXA)) {
            RELAUNDER();
            fourier_ut(F, proj, fwt, ut);
            retention_naive(F, proj, rof, rob);
            hgrn_naive(F, proj, gatez, args.in[6], layer, hof, hob);
            GRID_BAR();
        }
        if (IN(PH_MIXB)) {
            RELAUNDER();
            mixer_finalize(F, proj, rof, rob, hof, hob, args.in[5] + (size_t)layer * RW, args.in[7] + (size_t)layer * HW, mixin);
            __syncthreads();
            pg8::Gemm g{dft, ut, SEQ, NB * FW, 2 * SEQ}; pg8::StaticOrder S; S.init(SEQ, NB * FW, F.G, (int)blockIdx.x);
            pg8::EpiFourier E{mixin, args.in[9] + (size_t)layer * FW};
            pg8::gemm_phase<pg8::EpiFourier, pg8::StaticOrder, PG8_ALIGN, PG8_SP2>(F.lds, g, S, E);
            GRID_BAR();
        }
        if (IN(PH_WOUT)) {
            RELAUNDER();
            pg8::Gemm g{mixin, W_out, M, D, D}; pg8::StaticOrder S; S.init(M, D, F.G, (int)blockIdx.x);
            pg8::EpiF32 E{tmp, D};
            pg8::gemm_phase<pg8::EpiF32, pg8::StaticOrder, PG8_ALIGN, PG8_SP2>(F.lds, g, S, E);
            GRID_BAR();
        }
        if (IN(PH_NORM1)) {
            RELAUNDER();
            norm_phase(F, tmp, layer == 0 ? x_in : hout, hout, args.in[11] + (size_t)layer * D, args.in[12] + (size_t)layer * D, anorm);
            GRID_BAR();
        }
        if (IN(PH_XQ)) {
            RELAUNDER();
            { pg8::Gemm g{anorm, W_q, M, XW, D}; pg8::StaticOrder S; S.init(M, XW, F.G, (int)blockIdx.x);
              pg8::EpiBf16 E{xq, XW, 0.0625f};
              pg8::gemm_phase<pg8::EpiBf16, pg8::StaticOrder, PG8_ALIGN, PG8_SP2>(F.lds, g, S, E); }
            { pg8::Gemm g{memn, W_kv, NB * MEMT, 2 * XW, D}; pg8::StaticOrder S; S.init(NB * MEMT, 2 * XW, F.G, (int)blockIdx.x - 128);
              pg8::EpiBf16 E{kvmem, 2 * XW, 1.0f};
              pg8::gemm_phase<pg8::EpiBf16, pg8::StaticOrder, PG8_ALIGN, PG8_SP2>(F.lds, g, S, E); }
            GRID_BAR();
        }
        if (IN(PH_XATT)) {
            RELAUNDER();
            xattn_phase(F, xq, kvmem, xo);
            GRID_BAR();
        }
        if (IN(PH_XWO)) {
            RELAUNDER();
            pg8::Gemm g{xo, W_o, M, D, XW}; pg8::StaticOrder S; S.init(M, D, F.G, (int)blockIdx.x);
            pg8::EpiF32 E{tmp, D};
            pg8::gemm_phase<pg8::EpiF32, pg8::StaticOrder, PG8_ALIGN, PG8_SP2>(F.lds, g, S, E);
            GRID_BAR();
        }
        if (IN(PH_NORM2)) {
            RELAUNDER();
            norm_phase(F, tmp, hout, hout, args.in[17] + (size_t)layer * D, args.in[18] + (size_t)layer * D, anorm);
            GRID_BAR();
        }
        if (IN(PH_FFN1)) {
            RELAUNDER();
            pg8::Gemm g{anorm, W_gu, M, 2 * FFH, D}; pg8::StaticOrder S; S.init(M, 2 * FFH, F.G, (int)blockIdx.x);
            pg8::EpiSwiGlu E{hid, FFH};
            pg8::gemm_phase<pg8::EpiSwiGlu, pg8::StaticOrder, PG8_ALIGN, PG8_SP2>(F.lds, g, S, E);
            GRID_BAR();
        }
        if (IN(PH_FFN2)) {
            RELAUNDER();
            pg8::Gemm g{hid, W_dn, M, D, FFH}; pg8::StaticOrder S; S.init(M, D, F.G, (int)blockIdx.x);
            pg8::EpiF32 E{tmp, D};
            pg8::gemm_phase<pg8::EpiF32, pg8::StaticOrder, PG8_ALIGN, PG8_SP2>(F.lds, g, S, E);
            GRID_BAR();
        }
        if (IN(PH_NORM3)) {
            RELAUNDER();
            const bool more = layer + 1 < NL;
            norm_phase(F, tmp, hout, hout, args.in[22] + (size_t)layer * D, more ? args.in[3] + (size_t)(layer + 1) * D : nullptr, anorm);
            if (more) GRID_BAR();
        }
    }
#undef IN
#undef GRID_BAR
}

extern "C" void kernel_launch(void* const* d_in, const int* in_sizes, int n_in, void* d_out, int out_size, void* d_ws, size_t ws_size, hipStream_t stream) {
    static int grid = 0;
    if (grid == 0) {
        if (n_in != 23 || out_size != M * D || ws_size < WS_END) { fprintf(stderr, "kernel_launch: unexpected shapes (n_in %d, out %d, ws %zu < %zu)\n", n_in, out_size, ws_size, (size_t)WS_END); grid = -1; return; }
        int dev = 0, cus = 0, per_cu = 0;
        if (hipGetDevice(&dev) != hipSuccess || hipDeviceGetAttribute(&cus, hipDeviceAttributeMultiprocessorCount, dev) != hipSuccess) { grid = -1; return; }
        if (hipFuncSetAttribute((const void*)fwd_kernel, hipFuncAttributeMaxDynamicSharedMemorySize, LDS_BYTES) != hipSuccess) { fprintf(stderr, "kernel_launch: hipFuncSetAttribute failed\n"); grid = -1; return; }
        if (hipOccupancyMaxActiveBlocksPerMultiprocessor(&per_cu, (const void*)fwd_kernel, NWAVES * 64, LDS_BYTES) != hipSuccess || per_cu < 1) fprintf(stderr, "kernel_launch: occupancy query reports %d\n", per_cu);
        (void)hipGetLastError();
        grid = cus;
    }
    if (grid < 0) return;
    (void)in_sizes;
    if (hipMemsetAsync((char*)d_ws + WS_CTL, 0, CTL_ZERO_BYTES, stream) != hipSuccess) return;
    Args a{};
    for (int i = 0; i < 23; ++i) a.in[i] = (const float*)d_in[i];
    a.out = (float*)d_out; a.ws = (unsigned char*)d_ws; a.pad = 0;
#if ONE_LAUNCH
    a.layer_lo = 0; a.layer_hi = NL; a.ph_lo = 0; a.ph_hi = PH_COUNT; a.single = 1;
    hipLaunchKernelGGL(fwd_kernel, dim3(grid), dim3(NWAVES * 64), LDS_BYTES, stream, a);
#else
    a.single = 0;
    for (int layer = 0; layer < NL; ++layer)
        for (int ph = (layer == 0 ? PH_PRE : PH_CONV); ph < PH_COUNT; ++ph) {
            a.layer_lo = layer; a.layer_hi = layer + 1; a.ph_lo = ph; a.ph_hi = ph + 1;
            hipLaunchKernelGGL(fwd_kernel, dim3(grid), dim3(NWAVES * 64), LDS_BYTES, stream, a);
        }
#endif
}
```

```cpp
#include <hip/hip_runtime.h>
#include <cstdio>
#include <cstdint>

#ifndef ONE_LAUNCH
#define ONE_LAUNCH 1
#endif

#define LAS __attribute__((address_space(3)))
#define GAS __attribute__((address_space(1)))
typedef unsigned short bf16;
typedef short bf16x8 __attribute__((ext_vector_type(8)));
typedef float f32x4 __attribute__((ext_vector_type(4)));
typedef float f32x2 __attribute__((ext_vector_type(2)));
typedef unsigned u32x4 __attribute__((ext_vector_type(4)));
typedef unsigned u32x2 __attribute__((ext_vector_type(2)));
typedef int i32x4 __attribute__((ext_vector_type(4)));

constexpr int D = 4096, NB = 2, SEQ = 4096, NL = 2, M = NB * SEQ;
constexpr int RW = 2048, RH = 8, RD = 256;
constexpr int HW = 1024, HH = 8, HD = 128;
constexpr int FW = 1024, FG = 8, FD = 128;
constexpr int NPROJ = 14336;
constexpr int XW = 1024, XH = 4, XD = 256, MEMT = 256;
constexpr int FFH = 11008;
constexpr int C_RQ = 0, C_RK = 2048, C_RV = 4096, C_RG = 6144, C_HQ = 8192, C_HFF = 9216, C_HFB = 10240, C_HI = 11264, C_HG = 12288, C_FZ = 13312;
constexpr float RMS_EPS = 1e-6f, GN_EPS = 1e-5f;

constexpr size_t MiB = 1u << 20;
constexpr size_t WS_CTL = 0, CTL_ZERO_BYTES = 1 * MiB;
constexpr size_t WS_WIN = 1 * MiB;
constexpr size_t WS_WOUT = 113 * MiB;
constexpr size_t WS_WQ = 145 * MiB;
constexpr size_t WS_WKV = 153 * MiB;
constexpr size_t WS_WO = 169 * MiB;
constexpr size_t WS_WGU = 177 * MiB;
constexpr size_t WS_WDN = 349 * MiB;
constexpr size_t WS_ANORM = 435 * MiB;
constexpr size_t WS_PROJ = 499 * MiB;
constexpr size_t WS_GATEZ = 723 * MiB;
constexpr size_t WS_MIXIN = 787 * MiB;
constexpr size_t WS_TMP = 851 * MiB;
constexpr size_t WS_SCR = 979 * MiB;
constexpr size_t WS_DFT = 1171 * MiB;
constexpr size_t WS_UT = 1235 * MiB;
constexpr size_t WS_XQ = 1267 * MiB;
constexpr size_t WS_XO = 1283 * MiB;
constexpr size_t WS_KVMEM = 1299 * MiB;
constexpr size_t WS_MEMN = 1301 * MiB;
constexpr size_t WS_ROPE = 1305 * MiB;
constexpr size_t WS_FWT = 1309 * MiB;
constexpr size_t WS_FWT1 = 1310 * MiB;
constexpr size_t WS_END = 1311 * MiB;
constexpr int CW_BAR = 4096, CW_CONVQ = 8192;

constexpr int LDS_BYTES = 147456;
constexpr int LDSCTL_OFF = LDS_BYTES - 512, MISC_OFF = LDSCTL_OFF + 320;
constexpr int NWAVES = 8;

typedef __bf16 bf16x2_t __attribute__((ext_vector_type(2)));
__device__ __forceinline__ unsigned cvt_pk_bf16(float lo, float hi) { const f32x2 v = {lo, hi}; return __builtin_bit_cast(unsigned, __builtin_convertvector(v, bf16x2_t)); }
__device__ __forceinline__ float bf2f(unsigned b) { return __uint_as_float(b << 16); }
__device__ __forceinline__ float bflo(unsigned w) { return __uint_as_float(w << 16); }
__device__ __forceinline__ float bfhi(unsigned w) { return __uint_as_float(w & 0xffff0000u); }
__device__ __forceinline__ float wave_sum(float v) {
#pragma unroll
    for (int o = 1; o < 64; o <<= 1) v += __shfl_xor(v, o);
    return v;
}
__device__ __forceinline__ float fast_sigmoid(float x) { return __builtin_amdgcn_rcpf(1.0f + __expf(-x)); }
__device__ __forceinline__ float silu_f(float x) { return x * fast_sigmoid(x); }
#define LDS_WAIT() asm volatile("s_waitcnt lgkmcnt(0)" ::: "memory")
#define VM_WAIT() asm volatile("s_waitcnt vmcnt(0)" ::: "memory")

namespace pg8 {
constexpr int BM = 256, BK = 64, HALF = 128, HTB = HALF * BK * 2, STAGE_BYTES = 8 * HTB, NXCD = 8, WGM = 8;
__host__ __device__ __forceinline__ int lds_byte(int r, int c) { const int st = (r >> 4) * 2 + (c >> 5), rr = r & 15, cc = c & 31, ob = rr * 64 + cc * 2; return st * 1024 + (ob ^ (((ob >> 9) & 1) << 5)); }
__host__ __device__ __forceinline__ void stage_rc(int b, int& R, int& C) { const int st = b / 1024, sb = b % 1024, swz = sb ^ (((sb >> 9) & 1) << 5); R = (st >> 1) * 16 + swz / 64; C = (st & 1) * 32 + (swz % 64) / 2; }
__host__ __device__ __forceinline__ int perm32(int rho) { const int n = rho >> 4, i = rho & 15; return 8 * (i >> 2) + 4 * n + (i & 3); }
struct Unit { int pm, pn; };
struct Gemm { const bf16* A; const bf16* Bt; int M, N, K; };
struct StaticOrder {
    int nM, nN, nwg, G, c;
    __host__ __device__ void init(int M_, int N_, int G_, int c_) { nM = M_ / BM; nN = N_ / BM; nwg = nM * nN; G = G_; c = c_; }
    __host__ __device__ bool next(int i, Unit& u) const {
        if (c < 0) return false;
        const long Lx = (long)i * G + c; if (Lx >= nwg) return false;
        int wgid = (int)Lx; { const int q = nwg / NXCD, r = nwg % NXCD, xcd = wgid % NXCD, off = wgid / NXCD; wgid = (xcd < r ? xcd * (q + 1) : r * (q + 1) + (xcd - r) * q) + off; }
        const int nig = WGM * nN, gid = wgid / nig, fm = gid * WGM, gsz = (nM - fm) < WGM ? (nM - fm) : WGM;
        u.pm = fm + ((wgid % nig) % gsz); u.pn = (wgid % nig) / gsz; return true;
    }
    __device__ __forceinline__ void a_ready(const Unit&) const {}
    __device__ __forceinline__ void done(const Unit&) const {}
};

struct EpiF32 {
    static constexpr bool PERM = false;
    static constexpr int NSCALE = 0; __device__ __forceinline__ const float* scale_ptr(const Unit&, int) const { return nullptr; }
    float* C; int ldc;
    __device__ __forceinline__ void operator()(const f32x4 (&acc)[2][2][4][2], const Unit& u, int wr, int wc, int fr, int fq, const LAS float* sl) const {
        const int row0 = u.pm * BM + wr * 64 + fr, col0 = u.pn * BM + wc * 32 + 4 * fq;
#pragma unroll
        for (int ai = 0; ai < 2; ++ai)
#pragma unroll
            for (int m = 0; m < 4; ++m) { float* rowp = C + (size_t)(row0 + ai * HALF + m * 16) * ldc + col0;
#pragma unroll
                for (int bj = 0; bj < 2; ++bj)
#pragma unroll
                    for (int n = 0; n < 2; ++n) *(f32x4*)(rowp + bj * HALF + n * 16) = acc[ai][bj][m][n]; }
    }
};
struct EpiBf16 {
    static constexpr bool PERM = true;
    static constexpr int NSCALE = 1;
    __device__ __forceinline__ const float* scale_ptr(const Unit& u, int) const { return rs ? rs + u.pm * BM : nullptr; }
    bf16* O; int ldc; float scale; const float* rs;
    __device__ __forceinline__ void operator()(const f32x4 (&acc)[2][2][4][2], const Unit& u, int wr, int wc, int fr, int fq, const LAS float* sl) const {
        const int row0 = u.pm * BM + wr * 64 + fr, col0 = u.pn * BM + wc * 32 + 8 * fq;
        float scv[2][4];
#pragma unroll
        for (int ai = 0; ai < 2; ++ai)
#pragma unroll
            for (int m = 0; m < 4; ++m) scv[ai][m] = rs ? scale * sl[wr * 64 + fr + ai * HALF + m * 16] : scale;
        asm volatile("" ::: "memory");
#pragma unroll
        for (int ai = 0; ai < 2; ++ai)
#pragma unroll
            for (int m = 0; m < 4; ++m) { bf16* rowp = O + (size_t)(row0 + ai * HALF + m * 16) * ldc + col0; const float sc = scv[ai][m];
#pragma unroll
                for (int bj = 0; bj < 2; ++bj) { const f32x4 v0 = acc[ai][bj][m][0] * sc, v1 = acc[ai][bj][m][1] * sc;
                    u32x4 w; w.x = cvt_pk_bf16(v0[0], v0[1]); w.y = cvt_pk_bf16(v0[2], v0[3]); w.z = cvt_pk_bf16(v1[0], v1[1]); w.w = cvt_pk_bf16(v1[2], v1[3]);
                    *(u32x4*)(rowp + bj * HALF) = w; } }
    }
};
struct EpiInProj {
    static constexpr bool PERM = true;
    static constexpr int NSCALE = 2;
    __device__ __forceinline__ const float* scale_ptr(const Unit& u, int k) const { return k == 0 ? rs + u.pm * BM : cm + u.pn * BM; }
    bf16* proj; const float* ropec; const float* ropes; const float* rs; const float* cm;
    __device__ __forceinline__ void operator()(const f32x4 (&acc)[2][2][4][2], const Unit& u, int wr, int wc, int fr, int fq, const LAS float* sl) const {
        const int row0 = u.pm * BM + wr * 64 + fr, colw = wc * 32 + 8 * fq;
        const LAS float* cp = sl + 256 + colw;
        const f32x4 ca0 = *(const LAS f32x4*)(cp) * (1.0f / 127.0f), ca1 = *(const LAS f32x4*)(cp + 4) * (1.0f / 127.0f), cb0 = *(const LAS f32x4*)(cp + HALF) * (1.0f / 127.0f), cb1 = *(const LAS f32x4*)(cp + HALF + 4) * (1.0f / 127.0f);
        float rsl[2][4];
#pragma unroll
        for (int ai = 0; ai < 2; ++ai)
#pragma unroll
            for (int m = 0; m < 4; ++m) rsl[ai][m] = sl[wr * 64 + fr + ai * HALF + m * 16];
        if (u.pn < 16) {
            const float sc0 = u.pn < 8 ? 0.0625f : 1.0f;
            const f32x4 C0 = *(const f32x4*)(ropec + 16 * 128 + colw), C1 = *(const f32x4*)(ropec + 16 * 128 + colw + 4), S0 = *(const f32x4*)(ropes + 16 * 128 + colw), S1 = *(const f32x4*)(ropes + 16 * 128 + colw + 4);
            f32x4 cc0[2], cc1[2], ss0[2], ss1[2];
#pragma unroll
            for (int ai = 0; ai < 2; ++ai) { const int pos0 = (row0 + ai * HALF) & (SEQ - 1);
                cc0[ai] = *(const f32x4*)(ropec + pos0 * 128 + colw); cc1[ai] = *(const f32x4*)(ropec + pos0 * 128 + colw + 4);
                ss0[ai] = *(const f32x4*)(ropes + pos0 * 128 + colw); ss1[ai] = *(const f32x4*)(ropes + pos0 * 128 + colw + 4); }
            asm volatile("" ::: "memory");
#pragma unroll
            for (int ai = 0; ai < 2; ++ai) {
                f32x4 c0 = cc0[ai], c1 = cc1[ai], s0 = ss0[ai], s1 = ss1[ai];
#pragma unroll
                for (int m = 0; m < 4; ++m) { const int r = row0 + ai * HALF + m * 16; const float sc = sc0 * rsl[ai][m];
                    if (m) { const f32x4 n0 = c0 * C0 - s0 * S0, n1 = c1 * C1 - s1 * S1; s0 = s0 * C0 + c0 * S0; s1 = s1 * C1 + c1 * S1; c0 = n0; c1 = n1; }
                    const f32x4 a0 = acc[ai][0][m][0] * ca0, a1 = acc[ai][0][m][1] * ca1, b0 = acc[ai][1][m][0] * cb0, b1 = acc[ai][1][m][1] * cb1;
                    const f32x4 o10 = (a0 * c0 - b0 * s0) * sc, o11 = (a1 * c1 - b1 * s1) * sc, o20 = (a0 * s0 + b0 * c0) * sc, o21 = (a1 * s1 + b1 * c1) * sc;
                    bf16* rowp = proj + (size_t)r * NPROJ + u.pn * BM + colw;
                    u32x4 w; w.x = cvt_pk_bf16(o10[0], o10[1]); w.y = cvt_pk_bf16(o10[2], o10[3]); w.z = cvt_pk_bf16(o11[0], o11[1]); w.w = cvt_pk_bf16(o11[2], o11[3]);
                    *(u32x4*)(rowp) = w;
                    w.x = cvt_pk_bf16(o20[0], o20[1]); w.y = cvt_pk_bf16(o20[2], o20[3]); w.z = cvt_pk_bf16(o21[0], o21[1]); w.w = cvt_pk_bf16(o21[2], o21[3]);
                    *(u32x4*)(rowp + HALF) = w; } }
        } else {
            asm volatile("" ::: "memory");
#pragma unroll
            for (int ai = 0; ai < 2; ++ai)
#pragma unroll
                for (int m = 0; m < 4; ++m) { bf16* rowp = proj + (size_t)(row0 + ai * HALF + m * 16) * NPROJ + u.pn * BM + colw; const float sc = rsl[ai][m];
                    { const f32x4 v0 = acc[ai][0][m][0] * ca0 * sc, v1 = acc[ai][0][m][1] * ca1 * sc;
                      u32x4 w; w.x = cvt_pk_bf16(v0[0], v0[1]); w.y = cvt_pk_bf16(v0[2], v0[3]); w.z = cvt_pk_bf16(v1[0], v1[1]); w.w = cvt_pk_bf16(v1[2], v1[3]); *(u32x4*)(rowp) = w; }
                    { const f32x4 v0 = acc[ai][1][m][0] * cb0 * sc, v1 = acc[ai][1][m][1] * cb1 * sc;
                      u32x4 w; w.x = cvt_pk_bf16(v0[0], v0[1]); w.y = cvt_pk_bf16(v0[2], v0[3]); w.z = cvt_pk_bf16(v1[0], v1[1]); w.w = cvt_pk_bf16(v1[2], v1[3]); *(u32x4*)(rowp + HALF) = w; } }
        }
    }
};
struct EpiSwiGlu {
    static constexpr bool PERM = true;
    static constexpr int NSCALE = 0; __device__ __forceinline__ const float* scale_ptr(const Unit&, int) const { return nullptr; }
    bf16* H; int ldc; const float* rs;
    __device__ __forceinline__ void operator()(const f32x4 (&acc)[2][2][4][2], const Unit& u, int wr, int wc, int fr, int fq, const LAS float* sl) const {
        const int row0 = u.pm * BM + wr * 64 + fr, col0 = u.pn * HALF + wc * 32 + 8 * fq;
#pragma unroll
        for (int ai = 0; ai < 2; ++ai)
#pragma unroll
            for (int m = 0; m < 4; ++m) { bf16* rowp = H + (size_t)(row0 + ai * HALF + m * 16) * ldc + col0; const float sc = rs[row0 + ai * HALF + m * 16];
                f32x4 v0, v1;
#pragma unroll
                for (int j = 0; j < 4; ++j) { v0[j] = silu_f(acc[ai][0][m][0][j] * sc) * (acc[ai][1][m][0][j] * sc); v1[j] = silu_f(acc[ai][0][m][1][j] * sc) * (acc[ai][1][m][1][j] * sc); }
                u32x4 w; w.x = cvt_pk_bf16(v0[0], v0[1]); w.y = cvt_pk_bf16(v0[2], v0[3]); w.z = cvt_pk_bf16(v1[0], v1[1]); w.w = cvt_pk_bf16(v1[2], v1[3]);
                *(u32x4*)(rowp) = w; }
    }
};
struct EpiSwiGluQ {
    static constexpr bool PERM = true;
    static constexpr int NSCALE = 3;
    __device__ __forceinline__ const float* scale_ptr(const Unit& u, int k) const { return k == 0 ? rq + u.pm * BM : (k == 1 ? cmg : cmu) + u.pn * HALF; }
    bf16* H; int ldc; const float* rq; const float* cmg; const float* cmu;
    __device__ __forceinline__ void operator()(const f32x4 (&acc)[2][2][4][2], const Unit& u, int wr, int wc, int fr, int fq, const LAS float* sl) const {
        const int row0 = u.pm * BM + wr * 64 + fr, col0 = u.pn * HALF + wc * 32 + 8 * fq;
        const int cl = wc * 32 + 8 * fq;
        const f32x4 sg0 = *(const LAS f32x4*)(sl + 256 + cl) * (1.0f / 127.0f), sg1 = *(const LAS f32x4*)(sl + 256 + cl + 4) * (1.0f / 127.0f);
        const f32x4 su0 = *(const LAS f32x4*)(sl + 512 + cl) * (1.0f / 127.0f), su1 = *(const LAS f32x4*)(sl + 512 + cl + 4) * (1.0f / 127.0f);
        float rql[2][4];
#pragma unroll
        for (int ai = 0; ai < 2; ++ai)
#pragma unroll
            for (int m = 0; m < 4; ++m) rql[ai][m] = sl[wr * 64 + fr + ai * HALF + m * 16];
        asm volatile("" ::: "memory");
#pragma unroll
        for (int ai = 0; ai < 2; ++ai)
#pragma unroll
            for (int m = 0; m < 4; ++m) { bf16* rowp = H + (size_t)(row0 + ai * HALF + m * 16) * ldc + col0; const float sc = rql[ai][m];
                f32x4 v0, v1;
#pragma unroll
                for (int j = 0; j < 4; ++j) { v0[j] = silu_f(acc[ai][0][m][0][j] * (sc * sg0[j])) * (acc[ai][1][m][0][j] * (sc * su0[j])); v1[j] = silu_f(acc[ai][0][m][1][j] * (sc * sg1[j])) * (acc[ai][1][m][1][j] * (sc * su1[j])); }
                u32x4 w; w.x = cvt_pk_bf16(v0[0], v0[1]); w.y = cvt_pk_bf16(v0[2], v0[3]); w.z = cvt_pk_bf16(v1[0], v1[1]); w.w = cvt_pk_bf16(v1[2], v1[3]);
                *(u32x4*)(rowp) = w; }
    }
};
struct SkipOrder : StaticOrder {
    int skip0, nskip;
    __device__ __forceinline__ bool next(int i, Unit& u) const { if (!StaticOrder::next(i, u)) return false; if (u.pn >= skip0) u.pn += nskip; return true; }
};
struct OneUnit {
    int pm, pn;
    __device__ __forceinline__ bool next(int i, Unit& u) const { if (pm < 0 || i > 0) return false; u.pm = pm; u.pn = pn; return true; }
    __device__ __forceinline__ void a_ready(const Unit&) const {}
    __device__ __forceinline__ void done(const Unit&) const {}
};
struct EpiFourier2 {
    static constexpr bool PERM = false;
    bf16* O; const float* bias; const float* nyq; const float* fa;
    static constexpr int NSCALE = 0; __device__ __forceinline__ const float* scale_ptr(const Unit&, int) const { return nullptr; }
    __device__ __forceinline__ void operator()(const f32x4 (&acc)[2][2][4][2], const Unit& u, int wr, int wc, int fr, int fq, const LAS float* sl) const {
        const int krow0 = (u.pm - 8) * BM + wr * 64 + fr, cbase = (u.pn - 8) * BM + wc * 32 + 4 * fq, b = cbase >> 10, colm0 = cbase & 1023;
#pragma unroll
        for (int ai = 0; ai < 2; ++ai)
#pragma unroll
            for (int m = 0; m < 4; ++m) { const int k = krow0 + ai * HALF + m * 16; const float sg = (k & 1) ? -1.0f : 1.0f;
                const float* ap = fa + (size_t)k * 2048 + cbase;
                bf16* row1 = O + (size_t)(b * SEQ + k) * D + 3072 + colm0; bf16* row2 = O + (size_t)(b * SEQ + ((SEQ - k) & (SEQ - 1))) * D + 3072 + colm0;
#pragma unroll
                for (int bj = 0; bj < 2; ++bj)
#pragma unroll
                    for (int n = 0; n < 2; ++n) { const int off = bj * HALF + n * 16;
                        const f32x4 av = *(const f32x4*)(ap + off); const f32x4 e = *(const f32x4*)(nyq + cbase + off) * sg + *(const f32x4*)(bias + colm0 + off); const f32x4 bv = acc[ai][bj][m][n];
                        const f32x4 p = av + bv + e, qv = av - bv + e;
                        u32x2 w; w.x = cvt_pk_bf16(p[0], p[1]); w.y = cvt_pk_bf16(p[2], p[3]); *(u32x2*)(row1 + off) = w;
                        if (k != 0) { w.x = cvt_pk_bf16(qv[0], qv[1]); w.y = cvt_pk_bf16(qv[2], qv[3]); *(u32x2*)(row2 + off) = w; } }
                asm volatile("" ::: "memory"); }
    }
};

template <class Epi, class Sched, bool ALIGN_EPI = false, bool SP2 = false, bool I8 = false>
__device__ __forceinline__ void gemm_phase(LAS unsigned char* lds, const Gemm g, const Sched& S, const Epi& E) {
    int tid_ = threadIdx.x; asm volatile("" : "+v"(tid_));
    const int tid = tid_, wid = __builtin_amdgcn_readfirstlane(tid >> 6), lane = tid & 63, wr = wid >> 2, wc = wid & 3, fr = lane & 15, fq = lane >> 4;
    const int KB = I8 ? g.K : 2 * g.K, nt = KB / (BK * 2);
    unsigned voffA[2], voffB[2];
#pragma unroll
    for (int i = 0; i < 2; ++i) { int R, C; stage_rc(tid * 16 + i * 8192, R, C); const int Rb = Epi::PERM ? ((R & ~31) + perm32(R & 31)) : R;
        voffA[i] = (unsigned)(R * KB + 2 * C); voffB[i] = (unsigned)(Rb * KB + 2 * C); }
    const size_t kstep = (size_t)(BK * 2);
    const size_t hstep = (size_t)HALF * KB;
    const size_t tstep = 2 * hstep;
    const unsigned ldsw = (unsigned)wid * 1024u;
    const int aoff = lds_byte(wr * 64 + fr, fq * 8), boff = lds_byte(wc * 32 + fr, fq * 8);
#define PG8_SA(b, h) (((b) * 2 + (h)) * HTB)
#define PG8_SB(b, h) ((4 + (b) * 2 + (h)) * HTB)
#define PG8_STAGE(bufoff, gbase, voff) do { _Pragma("unroll") for (int _i = 0; _i < 2; ++_i) \
        __builtin_amdgcn_global_load_lds((const unsigned*)((const char*)(gbase) + (voff)[_i]), (LAS unsigned*)(lds + (bufoff) + ldsw + _i * 8192), 16, 0, 0); } while (0)
#define PG8_LDA(dst, b, h) do { _Pragma("unroll") for (int m = 0; m < 4; ++m) _Pragma("unroll") for (int k = 0; k < 2; ++k) dst[m][k] = *(const LAS bf16x8*)(lds + PG8_SA(b, h) + aoff + m * 2048 + k * 1024); } while (0)
#define PG8_LDB(dst, b, h) do { _Pragma("unroll") for (int n = 0; n < 2; ++n) _Pragma("unroll") for (int k = 0; k < 2; ++k) dst[n][k] = *(const LAS bf16x8*)(lds + PG8_SB(b, h) + boff + n * 2048 + k * 1024); } while (0)
#define PG8_MMA(ai, bj, At, Bt) do { __builtin_amdgcn_s_setprio(1); _Pragma("unroll") for (int m = 0; m < 4; ++m) _Pragma("unroll") for (int n = 0; n < 2; ++n) _Pragma("unroll") for (int k = 0; k < 2; ++k) { \
        if constexpr (I8) acc[ai][bj][m][n] = __builtin_bit_cast(f32x4, __builtin_amdgcn_mfma_i32_16x16x64_i8(__builtin_bit_cast(i32x4, Bt[n][k]), __builtin_bit_cast(i32x4, At[m][k]), __builtin_bit_cast(i32x4, acc[ai][bj][m][n]), 0, 0, 0)); \
        else acc[ai][bj][m][n] = __builtin_amdgcn_mfma_f32_16x16x32_bf16(Bt[n][k], At[m][k], acc[ai][bj][m][n], 0, 0, 0); } __builtin_amdgcn_s_setprio(0); } while (0)
#define PG8_WAIT_V(n) asm volatile("s_waitcnt vmcnt(" #n ")" ::: "memory")
#define PG8_WAIT_L(n) asm volatile("s_waitcnt lgkmcnt(" #n ")" ::: "memory")
#define PG8_BAR __builtin_amdgcn_s_barrier()
#define PG8_SCHED __builtin_amdgcn_sched_barrier(0)
    Unit cur, nxt; int ui = 0;
    if (!S.next(0, cur)) return;
#define PG8_SCALES(unit, par) do { if constexpr (Epi::NSCALE > 0) { if (wid < Epi::NSCALE) { const float* gp_ = E.scale_ptr(unit, wid); \
        if (gp_) __builtin_amdgcn_global_load_lds((const unsigned*)(gp_ + 4 * lane), (LAS unsigned*)(lds + 8 * HTB + (par) * 3072 + wid * 1024), 16, 0, 0); } } } while (0)
    PG8_SCALES(cur, 0);
    f32x4 acc[2][2][4][2];
#pragma unroll
    for (int a = 0; a < 2; ++a)
#pragma unroll
        for (int b = 0; b < 2; ++b)
#pragma unroll
            for (int m = 0; m < 4; ++m)
#pragma unroll
                for (int n = 0; n < 2; ++n) acc[a][b][m][n] = (f32x4){0.f, 0.f, 0.f, 0.f};
    bf16x8 At[4][2], B0[2][2], B1[2][2];
    const char* cA = (const char*)g.A + (size_t)cur.pm * tstep; const char* cB = (const char*)g.Bt + (size_t)cur.pn * tstep;
    S.a_ready(cur);
    if constexpr (SP2) {
        PG8_STAGE(PG8_SB(0, 0), cB, voffB); PG8_STAGE(PG8_SB(0, 1), cB + hstep, voffB); PG8_STAGE(PG8_SA(0, 0), cA, voffA); PG8_STAGE(PG8_SA(0, 1), cA + hstep, voffA);
        if (wr == 1) PG8_BAR;
        PG8_WAIT_V(2); PG8_BAR;
        PG8_STAGE(PG8_SB(1, 0), cB + kstep, voffB); PG8_STAGE(PG8_SA(1, 0), cA + kstep, voffA); PG8_STAGE(PG8_SB(1, 1), cB + hstep + kstep, voffB);
        PG8_WAIT_V(6); PG8_BAR;
    } else {
        PG8_STAGE(PG8_SB(0, 0), cB, voffB); PG8_STAGE(PG8_SA(0, 0), cA, voffA); PG8_STAGE(PG8_SB(0, 1), cB + hstep, voffB); PG8_STAGE(PG8_SA(0, 1), cA + hstep, voffA);
        if (wr == 1) PG8_BAR;
        PG8_WAIT_V(4); PG8_BAR;
        PG8_STAGE(PG8_SB(1, 0), cB + kstep, voffB); PG8_STAGE(PG8_SA(1, 0), cA + kstep, voffA); PG8_STAGE(PG8_SB(1, 1), cB + hstep + kstep, voffB);
        PG8_WAIT_V(6); PG8_BAR;
    }
    for (;;) {
        const bool has_next = S.next(ui + 1, nxt);
        const char* nA = has_next ? (const char*)g.A + (size_t)nxt.pm * tstep : cA; const char* nB = has_next ? (const char*)g.Bt + (size_t)nxt.pn * tstep : cB;
        for (int t = 0; t < nt; t += 2) {
            const bool last = (t == nt - 2);
            const char* a1 = cA + (size_t)(t + 1) * kstep;
            const char* a2 = last ? nA : cA + (size_t)(t + 2) * kstep; const char* b2 = last ? nB : cB + (size_t)(t + 2) * kstep;
            const char* a3 = a2 + kstep; const char* b3 = b2 + kstep;
            if (last && has_next) { S.a_ready(nxt); PG8_SCALES(nxt, (ui + 1) & 1); }
            if constexpr (SP2) {
            PG8_LDB(B0, 0, 0); PG8_LDB(B1, 0, 1); PG8_SCHED; PG8_LDA(At, 0, 0); PG8_STAGE(PG8_SA(1, 1), a1 + hstep, voffA);
            PG8_WAIT_V(8); PG8_WAIT_L(0); PG8_BAR; PG8_MMA(0, 0, At, B0); PG8_MMA(0, 1, At, B1); PG8_BAR; PG8_SCHED;
            PG8_LDA(At, 0, 1); PG8_STAGE(PG8_SB(0, 0), b2, voffB); PG8_STAGE(PG8_SB(0, 1), b2 + hstep, voffB); PG8_STAGE(PG8_SA(0, 0), a2, voffA);
            PG8_WAIT_V(8); PG8_WAIT_L(0); PG8_BAR; PG8_MMA(1, 0, At, B0); PG8_MMA(1, 1, At, B1); PG8_BAR; PG8_SCHED;
            PG8_LDB(B0, 1, 0); PG8_LDB(B1, 1, 1); PG8_SCHED; PG8_LDA(At, 1, 0); PG8_STAGE(PG8_SA(0, 1), a2 + hstep, voffA);
            PG8_WAIT_V(8); PG8_WAIT_L(0); PG8_BAR; PG8_MMA(0, 0, At, B0); PG8_MMA(0, 1, At, B1); PG8_BAR; PG8_SCHED;
            PG8_LDA(At, 1, 1); PG8_STAGE(PG8_SB(1, 0), b3, voffB); PG8_STAGE(PG8_SB(1, 1), b3 + hstep, voffB); PG8_STAGE(PG8_SA(1, 0), a3, voffA);
            PG8_WAIT_V(8); PG8_WAIT_L(0); PG8_BAR; PG8_MMA(1, 0, At, B0); PG8_MMA(1, 1, At, B1); PG8_BAR; PG8_SCHED;
            } else {
            PG8_LDB(B0, 0, 0); PG8_SCHED; PG8_LDA(At, 0, 0); PG8_STAGE(PG8_SA(1, 1), a1 + hstep, voffA);
            PG8_WAIT_L(8); PG8_BAR; PG8_WAIT_L(0); PG8_MMA(0, 0, At, B0); PG8_BAR; PG8_SCHED;
            PG8_LDB(B1, 0, 1); PG8_STAGE(PG8_SB(0, 0), b2, voffB);
            PG8_BAR; PG8_WAIT_L(0); PG8_MMA(0, 1, At, B1); PG8_BAR;
            PG8_LDA(At, 0, 1); PG8_STAGE(PG8_SA(0, 0), a2, voffA);
            PG8_BAR; PG8_WAIT_L(0); PG8_MMA(1, 0, At, B0); PG8_BAR; PG8_SCHED;
            PG8_STAGE(PG8_SB(0, 1), b2 + hstep, voffB);
            PG8_WAIT_V(6); PG8_BAR; PG8_MMA(1, 1, At, B1); PG8_BAR;
            PG8_LDB(B0, 1, 0); PG8_SCHED; PG8_LDA(At, 1, 0); PG8_STAGE(PG8_SA(0, 1), a2 + hstep, voffA);
            PG8_WAIT_L(8); PG8_BAR; PG8_WAIT_L(0); PG8_MMA(0, 0, At, B0); PG8_BAR; PG8_SCHED;
            PG8_LDB(B1, 1, 1); PG8_STAGE(PG8_SB(1, 0), b3, voffB);
            PG8_BAR; PG8_WAIT_L(0); PG8_MMA(0, 1, At, B1); PG8_BAR;
            PG8_LDA(At, 1, 1); PG8_STAGE(PG8_SA(1, 0), a3, voffA);
            PG8_BAR; PG8_WAIT_L(0); PG8_MMA(1, 0, At, B0); PG8_BAR; PG8_SCHED;
            PG8_STAGE(PG8_SB(1, 1), b3 + hstep, voffB);
            PG8_WAIT_V(6); PG8_BAR; PG8_MMA(1, 1, At, B1); PG8_BAR;
            }
        }
        if constexpr (ALIGN_EPI) { if (wr == 0) PG8_BAR; }
        if constexpr (I8) {
#pragma unroll
            for (int a = 0; a < 2; ++a)
#pragma unroll
                for (int b = 0; b < 2; ++b)
#pragma unroll
                    for (int m = 0; m < 4; ++m)
#pragma unroll
                        for (int n = 0; n < 2; ++n) acc[a][b][m][n] = __builtin_convertvector(__builtin_bit_cast(i32x4, acc[a][b][m][n]), f32x4); }
        E(acc, cur, wr, wc, fr, fq, (const LAS float*)(lds + 8 * HTB + (ui & 1) * 3072)); S.done(cur);
        if (!has_next) break;
#pragma unroll
        for (int a = 0; a < 2; ++a)
#pragma unroll
            for (int b = 0; b < 2; ++b)
#pragma unroll
                for (int m = 0; m < 4; ++m)
#pragma unroll
                    for (int n = 0; n < 2; ++n) acc[a][b][m][n] = (f32x4){0.f, 0.f, 0.f, 0.f};
        cur = nxt; cA = nA; cB = nB; ++ui;
        if constexpr (ALIGN_EPI) { if (wr == 1) PG8_BAR; }
    }
    PG8_WAIT_V(0);
    if constexpr (!ALIGN_EPI) { if (wr == 0) PG8_BAR; }
    PG8_BAR;
#undef PG8_SCALES
#undef PG8_SA
#undef PG8_SB
#undef PG8_STAGE
#undef PG8_LDA
#undef PG8_LDB
#undef PG8_MMA
#undef PG8_WAIT_V
#undef PG8_WAIT_L
#undef PG8_BAR
#undef PG8_SCHED
}
}
#define PG8_SP2 true
#define PG8_ALIGN true

#define XB_TMO      128
#define XB_XCNT(j)  (256  + 64 * (j))
#define XB_XSUB(j)  (1280 + 64 * (j))
#define XB_XGEN(j)  (2304 + 64 * (j))
#define XB_TOP      3328
#define XB_TOPGEN   3392
#define XCD_BAR_WORDS 3456
#define XB_SPIN_CAP (1u << 18)
__device__ __forceinline__ unsigned xb_ld(unsigned* p)              { return __hip_atomic_load(p, __ATOMIC_RELAXED, __HIP_MEMORY_SCOPE_AGENT); }
__device__ __forceinline__ unsigned xb_add(unsigned* p, unsigned v) { return __hip_atomic_fetch_add(p, v, __ATOMIC_RELAXED, __HIP_MEMORY_SCOPE_AGENT); }
__device__ __forceinline__ unsigned xb_xcc_id() { return (unsigned)__builtin_amdgcn_s_getreg((3 << 11) | 20) & 0xFu; }
#define XB_SPIN(cond, bar) do { unsigned _sp = 0; while (cond) { __builtin_amdgcn_s_sleep(1); \
    if ((++_sp & 255u) == 0u) { if (xb_ld(&(bar)[XB_TMO])) break; if (_sp > XB_SPIN_CAP) { atomicAdd(&(bar)[XB_TMO], 1u); break; } } } } while (0)
struct XcdBarrier { unsigned* bar; unsigned x; volatile LAS unsigned* st; };
__device__ __forceinline__ XcdBarrier xcd_barrier_post(unsigned* bar, volatile LAS unsigned* st) {
    XcdBarrier b; b.bar = bar; b.x = xb_xcc_id(); b.st = st;
    if (threadIdx.x == 0) (void)xb_add(&bar[XB_XCNT(b.x)], 1u);
    return b;
}
__device__ __forceinline__ void xcd_barrier_complete(unsigned* bar, unsigned x, unsigned& nloc, unsigned& nx) {
    const unsigned G = gridDim.x * gridDim.y * gridDim.z;
    unsigned sum, cnt, mine, sp = 0u;
    for (;;) {
        sum = 0u; cnt = 0u; mine = 0u;
#pragma unroll
        for (unsigned j = 0; j < 16; ++j) { const unsigned c = xb_ld(&bar[XB_XCNT(j)]); sum += c; cnt += (c > 0u) ? 1u : 0u; mine = (j == x) ? c : mine; }
        if (sum == G) break;
        __builtin_amdgcn_s_sleep(1);
        if ((++sp & 255u) == 0u) { if (xb_ld(&bar[XB_TMO])) break; if (sp > XB_SPIN_CAP) { atomicAdd(&bar[XB_TMO], 1u); break; } }
    }
    nloc = mine > 0u ? mine : 1u; nx = cnt > 0u ? cnt : 1u;
}
__device__ __forceinline__ void xcd_barrier(const XcdBarrier& b) {
    asm volatile("s_waitcnt vmcnt(0)" ::: "memory");
    __syncthreads();
    if (threadIdx.x == 0) {
        unsigned* bar = b.bar;
        __builtin_amdgcn_s_waitcnt(0);
        unsigned nloc = b.st[0], nx = b.st[1];
        if (nloc == 0u) { xcd_barrier_complete(bar, b.x, nloc, nx); b.st[0] = nloc; b.st[1] = nx; }
        const unsigned old = xb_add(&bar[XB_XSUB(b.x)], 1u);
        const unsigned gen = old / nloc;
        if (old + 1u == (gen + 1u) * nloc) {
            __builtin_amdgcn_fence(__ATOMIC_RELEASE, "agent");
            asm volatile("s_waitcnt vmcnt(0)" ::: "memory");
            const unsigned og = xb_add(&bar[XB_TOP], 1u);
            const unsigned tg = og / nx;
            if (og + 1u == (tg + 1u) * nx) xb_add(&bar[XB_TOPGEN], 1u);
            else XB_SPIN(xb_ld(&bar[XB_TOPGEN]) == tg, bar);
            __builtin_amdgcn_fence(__ATOMIC_ACQUIRE, "agent");
            xb_add(&bar[XB_XGEN(b.x)], 1u);
            asm volatile("s_waitcnt vmcnt(0)" ::: "memory");
        } else {
            XB_SPIN(xb_ld(&bar[XB_XGEN(b.x)]) == gen, bar);
            __builtin_amdgcn_fence(__ATOMIC_ACQUIRE, "agent");
            asm volatile("s_waitcnt vmcnt(0)" ::: "memory");
        }
    }
    __syncthreads();
}

struct Args { const float* in[23]; float* out; unsigned char* ws; int layer_lo, layer_hi, ph_lo, ph_hi, single, pad; };
struct Frame {
    LAS unsigned char* lds;
    int tid, lane, wave, vcu, G, gw, NGW, bid;
    unsigned char* ws;
};
enum { PH_PRE = 0, PH_CONV, PH_INPROJ, PH_MIXA, PH_MIXB, PH_WOUT, PH_NORM1, PH_XQ, PH_XATT, PH_XWO, PH_NORM2, PH_FFN1, PH_FFN2, PH_NORM3, PH_COUNT };

__device__ __forceinline__ void transpose_item64(const float* W, int K, int N, bf16* WT, int drow0, int k0, int n0, LAS unsigned* scr, int lane, const float* gk) {
    const int m = lane & 15, kp = lane >> 4;
    f32x4 va[8], vb[8];
#pragma unroll
    for (int i = 0; i < 8; ++i) { const float* p = W + (size_t)(k0 + 8 * i + 2 * kp) * N + n0 + 4 * m; va[i] = __builtin_nontemporal_load((const f32x4*)p); vb[i] = __builtin_nontemporal_load((const f32x4*)(p + N)); }
    if (gk) {
#pragma unroll
        for (int i = 0; i < 8; ++i) { const f32x2 g2 = *(const f32x2*)(gk + k0 + 8 * i + 2 * kp); va[i] = va[i] * g2.x; vb[i] = vb[i] * g2.y; } }
#pragma unroll
    for (int i = 0; i < 8; ++i)
#pragma unroll
        for (int j = 0; j < 4; ++j) scr[(4 * m + j) * 33 + 4 * i + kp] = cvt_pk_bf16(va[i][j], vb[i][j]);
    LDS_WAIT(); asm volatile("" ::: "memory");
    const int c = lane & 7;
#pragma unroll
    for (int jj = 0; jj < 8; ++jj) { const int n = (lane >> 3) + 8 * jj; const LAS unsigned* sp = scr + n * 33 + 4 * c;
        u32x4 o; o.x = sp[0]; o.y = sp[1]; o.z = sp[2]; o.w = sp[3];
        __builtin_nontemporal_store(o, (u32x4*)(WT + (size_t)(drow0 + n) * K + k0 + 8 * c)); }
    LDS_WAIT(); asm volatile("" ::: "memory");
}
__device__ __forceinline__ void colmax_pass(Frame& F, const float* W, int K, int N, const float* gk, float* cmax) {
    const int nblk = N / 256, items = (K / 128) * nblk;
    for (int it = F.gw; it < items; it += F.NGW) { const int kb = it / nblk, nb = it - kb * nblk; const float* p = W + (size_t)(kb * 128) * N + nb * 256 + 4 * F.lane;
        f32x4 mx = (f32x4){0.f, 0.f, 0.f, 0.f};
#pragma unroll 8
        for (int kk = 0; kk < 128; ++kk) { const f32x4 w = __builtin_nontemporal_load((const f32x4*)(p + (size_t)kk * N)); const float g = gk[kb * 128 + kk];
            mx.x = fmaxf(mx.x, fabsf(w.x * g)); mx.y = fmaxf(mx.y, fabsf(w.y * g)); mx.z = fmaxf(mx.z, fabsf(w.z * g)); mx.w = fmaxf(mx.w, fabsf(w.w * g)); }
        unsigned* cm = (unsigned*)(cmax + nb * 256 + 4 * F.lane);
        atomicMax(cm + 0, __float_as_uint(mx.x)); atomicMax(cm + 1, __float_as_uint(mx.y)); atomicMax(cm + 2, __float_as_uint(mx.z)); atomicMax(cm + 3, __float_as_uint(mx.w)); }
}
__device__ __forceinline__ unsigned q8(float x) { int v = (int)__builtin_rintf(x); v = v < -127 ? -127 : (v > 127 ? 127 : v); return (unsigned)v & 0xffu; }
__device__ __forceinline__ void transpose_item64_q(const float* W, int K, int N, signed char* WT, int drow0, int k0, int n0, LAS unsigned* scr, int lane, const float* gk, const float* cmax) {
    const int m = lane & 15, kp = lane >> 4;
    f32x4 va[4][4];
#pragma unroll
    for (int i = 0; i < 4; ++i)
#pragma unroll
        for (int kk = 0; kk < 4; ++kk) va[i][kk] = __builtin_nontemporal_load((const f32x4*)(W + (size_t)(k0 + 16 * i + 4 * kp + kk) * N + n0 + 4 * m));
    const f32x4 cm = *(const f32x4*)(cmax + n0 + 4 * m);
    f32x4 inv; inv.x = cm.x > 0.f ? 127.0f / cm.x : 0.f; inv.y = cm.y > 0.f ? 127.0f / cm.y : 0.f; inv.z = cm.z > 0.f ? 127.0f / cm.z : 0.f; inv.w = cm.w > 0.f ? 127.0f / cm.w : 0.f;
#pragma unroll
    for (int i = 0; i < 4; ++i) { const f32x4 g4 = *(const f32x4*)(gk + k0 + 16 * i + 4 * kp);
#pragma unroll
        for (int j = 0; j < 4; ++j) { const float sj = inv[j];
            scr[(4 * m + j) * 17 + 4 * i + kp] = q8(va[i][0][j] * g4.x * sj) | (q8(va[i][1][j] * g4.y * sj) << 8) | (q8(va[i][2][j] * g4.z * sj) << 16) | (q8(va[i][3][j] * g4.w * sj) << 24); } }
    LDS_WAIT(); asm volatile("" ::: "memory");
    const int c = lane & 3;
#pragma unroll
    for (int jj = 0; jj < 4; ++jj) { const int n = (lane >> 2) + 16 * jj; const LAS unsigned* sp = scr + n * 17 + 4 * c;
        u32x4 o; o.x = sp[0]; o.y = sp[1]; o.z = sp[2]; o.w = sp[3];
        __builtin_nontemporal_store(o, (u32x4*)(WT + (size_t)(drow0 + n) * K + k0 + 16 * c)); }
    LDS_WAIT(); asm volatile("" ::: "memory");
}
__device__ __forceinline__ void convert_matrix(Frame& F, const float* W, int K, int N, bf16* WT, int row_off, int mode, LAS unsigned* scr, const float* gk, const float* cmq) {
    const int nblk = N / 64, items = (K / 64) * nblk;
    for (int it = F.gw; it < items; it += F.NGW) {
        const int kb = it / nblk, nb = it % nblk, n0 = 64 * nb;
        const int drow0 = mode == 0 ? row_off + n0 : ((n0 >> 7) * 256 + (mode == 2 ? 128 : 0) + (n0 & 127));
        if (cmq) transpose_item64_q(W, K, N, (signed char*)WT, drow0, 64 * kb, n0, scr, F.lane, gk, cmq);
        else transpose_item64(W, K, N, WT, drow0, 64 * kb, n0, scr, F.lane, gk);
    }
}

constexpr int CV1 = 64 * 64, CV2 = CV1 + 64 * 16, CV3 = CV2 + 64 * 16, CV4 = CV3 + 64 * 16, CV5 = CV4 + 16 * 64, CV6 = CV5 + 64 * 172, CV7 = CV6 + 64 * 172, CV8 = CV7 + 172 * 64;
constexpr int CV9 = CV8 + 64 * 224;
constexpr int CV_PER_ITEM = 16, CV_ITEMS = CV8 / CV_PER_ITEM, CV_ITEMS_ALL = CV9 / CV_PER_ITEM, CV_P_ITEMS = CV5 / CV_PER_ITEM;
static_assert(CV8 % CV_PER_ITEM == 0, "conversion tiles per item");
struct ConvDst { bf16 *W_out, *W_q, *W_kv, *W_o, *W_gu, *W_dn, *W_in; const float* cmax; const float* cmin; };
__device__ __forceinline__ void convert_tile(const float* const* in_, int layer, int tt, const ConvDst& cd, LAS unsigned* scr, int lane) {
    struct { const float* const* p; __device__ __forceinline__ const float* operator[](int k) const { return (const float*)(GAS const float*)p[k]; } } in{in_};
    const float* W; const float* gk = nullptr; int K, N, row_off = 0, mode = 0, loc; bf16* WT;
    if (tt < CV1)      { W = in[10] + (size_t)layer * D * D;    K = D;   N = D;   WT = cd.W_out; loc = tt; }
    else if (tt < CV2) { W = in[13] + (size_t)layer * D * XW;   K = D;   N = XW;  WT = cd.W_q;  loc = tt - CV1; gk = in[12] + (size_t)layer * D; }
    else if (tt < CV3) { W = in[14] + (size_t)layer * D * XW;   K = D;   N = XW;  WT = cd.W_kv; loc = tt - CV2; }
    else if (tt < CV4) { W = in[15] + (size_t)layer * D * XW;   K = D;   N = XW;  WT = cd.W_kv; loc = tt - CV3; row_off = XW; }
    else if (tt < CV5) { W = in[16] + (size_t)layer * XW * D;   K = XW;  N = D;   WT = cd.W_o;  loc = tt - CV4; }
    else if (tt < CV6) { W = in[19] + (size_t)layer * D * FFH;  K = D;   N = FFH; WT = cd.W_gu; loc = tt - CV5; mode = 1; gk = in[18] + (size_t)layer * D; }
    else if (tt < CV7) { W = in[20] + (size_t)layer * D * FFH;  K = D;   N = FFH; WT = cd.W_gu; loc = tt - CV6; mode = 2; gk = in[18] + (size_t)layer * D; }
    else if (tt < CV8) { W = in[21] + (size_t)layer * FFH * D;  K = FFH; N = D;   WT = cd.W_dn; loc = tt - CV7; }
    else               { W = in[4] + (size_t)(layer + 1) * D * NPROJ; K = D; N = NPROJ; WT = cd.W_in; loc = tt - CV8; gk = in[3] + (size_t)(layer + 1) * D; }
    const int nblk = N / 64, kb = loc / nblk, nb = loc - kb * nblk, n0 = 64 * nb;
    const int drow0 = mode == 0 ? row_off + n0 : ((n0 >> 7) * 256 + (mode == 2 ? 128 : 0) + (n0 & 127));
    if (tt >= CV8) transpose_item64_q(W, K, N, (signed char*)WT, drow0, 64 * kb, n0, scr, lane, gk, cd.cmin + (size_t)(layer + 1) * NPROJ);
    else if (mode != 0) transpose_item64_q(W, K, N, (signed char*)WT, drow0, 64 * kb, n0, scr, lane, gk, cd.cmax + (size_t)layer * 2 * FFH + (mode == 2 ? FFH : 0));
    else transpose_item64(W, K, N, WT, drow0, 64 * kb, n0, scr, lane, gk);
}
__device__ __forceinline__ unsigned conv_next(unsigned* q, unsigned limit, unsigned* stopw, unsigned stopv) {
    if (stopw && __hip_atomic_load(stopw, __ATOMIC_RELAXED, __HIP_MEMORY_SCOPE_AGENT) >= stopv) return 0xffffffffu;
    if (__hip_atomic_load(q, __ATOMIC_RELAXED, __HIP_MEMORY_SCOPE_AGENT) >= limit) return 0xffffffffu;
    return __hip_atomic_fetch_add(q, 1u, __ATOMIC_RELAXED, __HIP_MEMORY_SCOPE_AGENT);
}
__device__ __forceinline__ void conv_pull(Frame& F, const float* const* in, int layer, unsigned* q, int limit, int count, const ConvDst& cd, volatile LAS unsigned* slot, unsigned* stopw, unsigned stopv) {
    LAS unsigned* scr = (LAS unsigned*)(F.lds + F.wave * 16384);
    __syncthreads();
    unsigned nxt = 0xffffffffu;
    if (F.tid == 0) nxt = conv_next(q, (unsigned)limit, stopw, stopv);
    for (;;) {
        if (F.tid == 0) slot[0] = nxt;
        __syncthreads();
        const unsigned cur = slot[0];
        __syncthreads();
        if (cur >= (unsigned)count) break;
        if (F.tid == 0) nxt = conv_next(q, (unsigned)limit, stopw, stopv);
        const int t0 = (int)cur * CV_PER_ITEM + F.wave * 2;
        convert_tile(in, layer, t0, cd, scr, F.lane);
        convert_tile(in, layer, t0 + 1, cd, scr, F.lane);
    }
}

__device__ __forceinline__ void rms_row_to_bf16(const float* xrow, const float* g, bf16* orow, int lane) {
    const f32x4* xr = (const f32x4*)xrow + lane; const f32x4* gr = (const f32x4*)g + lane;
    f32x4 v[16]; float s = 0.f;
#pragma unroll
    for (int j = 0; j < 16; ++j) { v[j] = xr[64 * j]; s += (v[j].x * v[j].x + v[j].y * v[j].y) + (v[j].z * v[j].z + v[j].w * v[j].w); }
    const float r = 1.0f / sqrtf(wave_sum(s) * (1.0f / D) + RMS_EPS);
    u32x2* o8 = (u32x2*)orow + lane;
#pragma unroll
    for (int j = 0; j < 16; ++j) { const f32x4 gg = gr[64 * j]; u32x2 w; w.x = cvt_pk_bf16(v[j].x * r * gg.x, v[j].y * r * gg.y); w.y = cvt_pk_bf16(v[j].z * r * gg.z, v[j].w * r * gg.w); o8[64 * j] = w; }
}
__device__ __forceinline__ void norm_phase(Frame& F, const bf16* tmp, const float* hin32, bf16* hb, float* out32, const float* gpost, float* rs_out) {
    LAS float* gl = (LAS float*)F.lds;
    __syncthreads();
    for (int i = F.tid; i < D / 4; i += NWAVES * 64) ((LAS f32x4*)gl)[i] = ((const f32x4*)gpost)[i];
    __syncthreads();
    for (int row0 = F.gw; row0 < M; row0 += 2 * F.NGW) {
        f32x4 v[2][16]; float s[2] = {0.f, 0.f};
#pragma unroll
        for (int rr = 0; rr < 2; ++rr) { const int row = row0 + rr * F.NGW; const u32x4* tr = (const u32x4*)(tmp + (size_t)row * D) + F.lane;
#pragma unroll
            for (int j = 0; j < 8; ++j) { const u32x4 w = __builtin_nontemporal_load(tr + 64 * j);
                v[rr][2 * j] = (f32x4){bflo(w.x), bfhi(w.x), bflo(w.y), bfhi(w.y)}; v[rr][2 * j + 1] = (f32x4){bflo(w.z), bfhi(w.z), bflo(w.w), bfhi(w.w)}; }
        }
#pragma unroll
        for (int rr = 0; rr < 2; ++rr)
#pragma unroll
            for (int j = 0; j < 16; ++j) s[rr] += (v[rr][j].x * v[rr][j].x + v[rr][j].y * v[rr][j].y) + (v[rr][j].z * v[rr][j].z + v[rr][j].w * v[rr][j].w);
#pragma unroll
        for (int o = 1; o < 64; o <<= 1) { s[0] += __shfl_xor(s[0], o); s[1] += __shfl_xor(s[1], o); }
        float s2[2] = {0.f, 0.f};
#pragma unroll
        for (int rr = 0; rr < 2; ++rr) { const int row = row0 + rr * F.NGW; const float r = 1.0f / sqrtf(s[rr] * (1.0f / D) + RMS_EPS);
            u32x4* hbr = (u32x4*)(hb + (size_t)row * D) + F.lane;
            u32x4 hw[8];
            if (!hin32) {
#pragma unroll
                for (int j = 0; j < 8; ++j) hw[j] = __builtin_nontemporal_load(hbr + 64 * j); }
            asm volatile("" ::: "memory");
#pragma unroll
            for (int j = 0; j < 8; ++j) { const int off = 8 * F.lane + 512 * j;
                f32x4 h0, h1;
                if (hin32) { h0 = *(const f32x4*)(hin32 + (size_t)row * D + off); h1 = *(const f32x4*)(hin32 + (size_t)row * D + off + 4); }
                else { const u32x4 w = hw[j]; h0 = (f32x4){bflo(w.x), bfhi(w.x), bflo(w.y), bfhi(w.y)}; h1 = (f32x4){bflo(w.z), bfhi(w.z), bflo(w.w), bfhi(w.w)}; }
                const f32x4 g0 = *(const LAS f32x4*)(gl + off), g1 = *(const LAS f32x4*)(gl + off + 4);
                h0 = h0 + v[rr][2 * j] * r * g0; h1 = h1 + v[rr][2 * j + 1] * r * g1;
                s2[rr] += (h0.x * h0.x + h0.y * h0.y) + (h0.z * h0.z + h0.w * h0.w) + (h1.x * h1.x + h1.y * h1.y) + (h1.z * h1.z + h1.w * h1.w);
                if (out32) { *(f32x4*)(out32 + (size_t)row * D + off) = h0; *(f32x4*)(out32 + (size_t)row * D + off + 4) = h1; }
                else { u32x4 w; w.x = cvt_pk_bf16(h0.x, h0.y); w.y = cvt_pk_bf16(h0.z, h0.w); w.z = cvt_pk_bf16(h1.x, h1.y); w.w = cvt_pk_bf16(h1.z, h1.w); hbr[64 * j] = w; } } }
        if (rs_out) {
#pragma unroll
            for (int o = 1; o < 64; o <<= 1) { s2[0] += __shfl_xor(s2[0], o); s2[1] += __shfl_xor(s2[1], o); }
            if (F.lane == 0) { rs_out[row0] = 1.0f / sqrtf(s2[0] * (1.0f / D) + RMS_EPS); rs_out[row0 + F.NGW] = 1.0f / sqrtf(s2[1] * (1.0f / D) + RMS_EPS); }
        }
    }
}
__device__ __forceinline__ void norm_phase_q(Frame& F, const bf16* tmp, bf16* hb, const float* gpost, signed char* hq, float* rq, float* rs_out) {
    LAS float* gl = (LAS float*)F.lds;
    __syncthreads();
    for (int i = F.tid; i < D / 4; i += NWAVES * 64) ((LAS f32x4*)gl)[i] = ((const f32x4*)gpost)[i];
    __syncthreads();
    for (int row0 = F.gw; row0 < M; row0 += 2 * F.NGW) {
        f32x4 v[2][16]; float s[2] = {0.f, 0.f};
#pragma unroll
        for (int rr = 0; rr < 2; ++rr) { const int row = row0 + rr * F.NGW; const u32x4* tr = (const u32x4*)(tmp + (size_t)row * D) + F.lane;
#pragma unroll
            for (int j = 0; j < 8; ++j) { const u32x4 w = __builtin_nontemporal_load(tr + 64 * j);
                v[rr][2 * j] = (f32x4){bflo(w.x), bfhi(w.x), bflo(w.y), bfhi(w.y)}; v[rr][2 * j + 1] = (f32x4){bflo(w.z), bfhi(w.z), bflo(w.w), bfhi(w.w)}; }
        }
#pragma unroll
        for (int rr = 0; rr < 2; ++rr)
#pragma unroll
            for (int j = 0; j < 16; ++j) s[rr] += (v[rr][j].x * v[rr][j].x + v[rr][j].y * v[rr][j].y) + (v[rr][j].z * v[rr][j].z + v[rr][j].w * v[rr][j].w);
#pragma unroll
        for (int o = 1; o < 64; o <<= 1) { s[0] += __shfl_xor(s[0], o); s[1] += __shfl_xor(s[1], o); }
        float s2[2] = {0.f, 0.f}, am[2] = {0.f, 0.f};
#pragma unroll
        for (int rr = 0; rr < 2; ++rr) { const int row = row0 + rr * F.NGW; const float r = 1.0f / sqrtf(s[rr] * (1.0f / D) + RMS_EPS);
            u32x4* hbr = (u32x4*)(hb + (size_t)row * D) + F.lane;
            u32x4 hw[8];
#pragma unroll
            for (int j = 0; j < 8; ++j) hw[j] = __builtin_nontemporal_load(hbr + 64 * j);
            asm volatile("" ::: "memory");
#pragma unroll
            for (int j = 0; j < 8; ++j) { const int off = 8 * F.lane + 512 * j;
                const u32x4 w = hw[j]; f32x4 h0 = (f32x4){bflo(w.x), bfhi(w.x), bflo(w.y), bfhi(w.y)}, h1 = (f32x4){bflo(w.z), bfhi(w.z), bflo(w.w), bfhi(w.w)};
                const f32x4 g0 = *(const LAS f32x4*)(gl + off), g1 = *(const LAS f32x4*)(gl + off + 4);
                h0 = h0 + v[rr][2 * j] * r * g0; h1 = h1 + v[rr][2 * j + 1] * r * g1;
                s2[rr] += (h0.x * h0.x + h0.y * h0.y) + (h0.z * h0.z + h0.w * h0.w) + (h1.x * h1.x + h1.y * h1.y) + (h1.z * h1.z + h1.w * h1.w);
                am[rr] = fmaxf(am[rr], fmaxf(fmaxf(fmaxf(fabsf(h0.x), fabsf(h0.y)), fmaxf(fabsf(h0.z), fabsf(h0.w))), fmaxf(fmaxf(fabsf(h1.x), fabsf(h1.y)), fmaxf(fabsf(h1.z), fabsf(h1.w)))));
                v[rr][2 * j] = h0; v[rr][2 * j + 1] = h1;
                u32x4 wo; wo.x = cvt_pk_bf16(h0.x, h0.y); wo.y = cvt_pk_bf16(h0.z, h0.w); wo.z = cvt_pk_bf16(h1.x, h1.y); wo.w = cvt_pk_bf16(h1.z, h1.w); hbr[64 * j] = wo; } }
#pragma unroll
        for (int o = 1; o < 64; o <<= 1) { s2[0] += __shfl_xor(s2[0], o); s2[1] += __shfl_xor(s2[1], o); am[0] = fmaxf(am[0], __shfl_xor(am[0], o)); am[1] = fmaxf(am[1], __shfl_xor(am[1], o)); }
#pragma unroll
        for (int rr = 0; rr < 2; ++rr) { const int row = row0 + rr * F.NGW; const float inv = am[rr] > 0.f ? 127.0f / am[rr] : 0.f;
            u32x2* qo = (u32x2*)(hq + (size_t)row * D) + F.lane;
#pragma unroll
            for (int j = 0; j < 8; ++j) { const f32x4 a = v[rr][2 * j] * inv, bq = v[rr][2 * j + 1] * inv;
                u32x2 w; w.x = q8(a.x) | (q8(a.y) << 8) | (q8(a.z) << 16) | (q8(a.w) << 24); w.y = q8(bq.x) | (q8(bq.y) << 8) | (q8(bq.z) << 16) | (q8(bq.w) << 24); qo[64 * j] = w; }
            if (F.lane == 0) { const float rsn = 1.0f / sqrtf(s2[rr] * (1.0f / D) + RMS_EPS); rq[row] = rsn * am[rr] * (1.0f / 127.0f); if (rs_out) rs_out[row] = rsn; } }
    }
}
__device__ __forceinline__ void x_to_stream(Frame& F, const float* x, bf16* hb, float* rs_out) {
    for (int row = F.gw; row < M; row += F.NGW) {
        float s2 = 0.f;
#pragma unroll
        for (int j = 0; j < 8; ++j) { const int off = 8 * F.lane + 512 * j; const f32x4 h0 = *(const f32x4*)(x + (size_t)row * D + off), h1 = *(const f32x4*)(x + (size_t)row * D + off + 4);
            s2 += (h0.x * h0.x + h0.y * h0.y) + (h0.z * h0.z + h0.w * h0.w) + (h1.x * h1.x + h1.y * h1.y) + (h1.z * h1.z + h1.w * h1.w);
            u32x4 w; w.x = cvt_pk_bf16(h0.x, h0.y); w.y = cvt_pk_bf16(h0.z, h0.w); w.z = cvt_pk_bf16(h1.x, h1.y); w.w = cvt_pk_bf16(h1.z, h1.w); *((u32x4*)(hb + (size_t)row * D + off)) = w; }
        s2 = wave_sum(s2);
        if (F.lane == 0) rs_out[row] = 1.0f / sqrtf(s2 * (1.0f / D) + RMS_EPS);
    }
}

template <int MT, int NT, bool TR>
__device__ __forceinline__ void wave_mma(f32x4 (&acc)[MT][NT], const LAS bf16* A, int lda, const LAS bf16* Bm, int ldb, int K, int lane) {
    const int r = lane & 15, q = lane >> 4;
    for (int k0 = 0; k0 < K; k0 += 32) {
        bf16x8 a[MT], b[NT];
#pragma unroll
        for (int mt = 0; mt < MT; ++mt) a[mt] = *(const LAS bf16x8*)(A + (mt * 16 + r) * lda + k0 + 8 * q);
#pragma unroll
        for (int nt = 0; nt < NT; ++nt) b[nt] = *(const LAS bf16x8*)(Bm + (nt * 16 + r) * ldb + k0 + 8 * q);
#pragma unroll
        for (int mt = 0; mt < MT; ++mt)
#pragma unroll
            for (int nt = 0; nt < NT; ++nt)
                acc[mt][nt] = TR ? __builtin_amdgcn_mfma_f32_16x16x32_bf16(b[nt], a[mt], acc[mt][nt], 0, 0, 0) : __builtin_amdgcn_mfma_f32_16x16x32_bf16(a[mt], b[nt], acc[mt][nt], 0, 0, 0);
    }
}
__device__ __forceinline__ void stage_tile(LAS bf16* dst, int lld, const bf16* src, size_t gld, int rows, int cols, int tid) {
    const int cpr = cols >> 3, total = rows * cpr;
    for (int i = tid; i < total; i += NWAVES * 64) { const int r = i / cpr, c = i - r * cpr; *(LAS u32x4*)(dst + r * lld + c * 8) = *(const u32x4*)(src + (size_t)r * gld + c * 8); }
}
__device__ __forceinline__ void stage_tile_tr(LAS bf16* dst, int lld, const bf16* src, size_t gld, int rows, int cols, int tid) {
    const int cpr = cols >> 3, total = rows * cpr;
    for (int i = tid; i < total; i += NWAVES * 64) { const int c = i / rows, r = i - c * rows; const u32x4 v = *(const u32x4*)(src + (size_t)r * gld + c * 8);
        LAS bf16* d = dst + (c * 8) * lld + r;
        d[0] = (bf16)(v.x & 0xffff); d[lld] = (bf16)(v.x >> 16); d[2 * lld] = (bf16)(v.y & 0xffff); d[3 * lld] = (bf16)(v.y >> 16);
        d[4 * lld] = (bf16)(v.z & 0xffff); d[5 * lld] = (bf16)(v.z >> 16); d[6 * lld] = (bf16)(v.w & 0xffff); d[7 * lld] = (bf16)(v.w >> 16); }
}

struct NoScale { __device__ __forceinline__ float operator()(int) const { return 1.0f; } static constexpr bool ON = false; };
struct Exp2Scale { float a, b; static constexpr bool ON = true; __device__ __forceinline__ float operator()(int r) const { return exp2f(a + b * (float)r); } };
template <class RS>
__device__ __forceinline__ void stage_tile_tr2(LAS bf16* dst, int lld, const bf16* src, size_t gld, int rows, int cols, int tid, const RS& sc) {
    const int hp = rows >> 1, total = hp * (cols >> 3), ls = lld >> 1;
    for (int i = tid; i < total; i += NWAVES * 64) { const int rp = i % hp, c8 = i / hp;
        const u32x4 a = *(const u32x4*)(src + (size_t)(2 * rp) * gld + c8 * 8), b = *(const u32x4*)(src + (size_t)(2 * rp + 1) * gld + c8 * 8);
        LAS unsigned* d = (LAS unsigned*)(dst + (c8 * 8) * lld + 2 * rp);
        if (RS::ON) { const float s0 = sc(2 * rp), s1 = sc(2 * rp + 1);
            d[0 * ls] = cvt_pk_bf16(bflo(a.x) * s0, bflo(b.x) * s1); d[1 * ls] = cvt_pk_bf16(bfhi(a.x) * s0, bfhi(b.x) * s1);
            d[2 * ls] = cvt_pk_bf16(bflo(a.y) * s0, bflo(b.y) * s1); d[3 * ls] = cvt_pk_bf16(bfhi(a.y) * s0, bfhi(b.y) * s1);
            d[4 * ls] = cvt_pk_bf16(bflo(a.z) * s0, bflo(b.z) * s1); d[5 * ls] = cvt_pk_bf16(bfhi(a.z) * s0, bfhi(b.z) * s1);
            d[6 * ls] = cvt_pk_bf16(bflo(a.w) * s0, bflo(b.w) * s1); d[7 * ls] = cvt_pk_bf16(bfhi(a.w) * s0, bfhi(b.w) * s1);
        } else {
            d[0 * ls] = (a.x & 0xffffu) | (b.x << 16); d[1 * ls] = (a.x >> 16) | (b.x & 0xffff0000u);
            d[2 * ls] = (a.y & 0xffffu) | (b.y << 16); d[3 * ls] = (a.y >> 16) | (b.y & 0xffff0000u);
            d[4 * ls] = (a.z & 0xffffu) | (b.z << 16); d[5 * ls] = (a.z >> 16) | (b.z & 0xffff0000u);
            d[6 * ls] = (a.w & 0xffffu) | (b.w << 16); d[7 * ls] = (a.w >> 16) | (b.w & 0xffff0000u);
        } }
}

typedef short s16x4 __attribute__((ext_vector_type(4)));
__device__ __forceinline__ bf16x8 tr_frag(const LAS bf16* base, int pitch, int lane) {
    const int g = lane >> 4, q = (lane >> 2) & 3, p = lane & 3;
    const LAS bf16* a = base + (8 * g + q) * pitch + 4 * p;
    const s16x4 lo = __builtin_amdgcn_ds_read_tr16_b64_v4i16((LAS s16x4*)a);
    const s16x4 hi = __builtin_amdgcn_ds_read_tr16_b64_v4i16((LAS s16x4*)(a + 4 * pitch));
    return __builtin_shufflevector(lo, hi, 0, 1, 2, 3, 4, 5, 6, 7);
}
template <int MT, int NT, bool TR, bool AT, bool BT>
__device__ __forceinline__ void wave_mma_g(f32x4 (&acc)[MT][NT], const LAS bf16* A, int lda, const LAS bf16* Bm, int ldb, int K, int lane) {
    const int r = lane & 15, q = lane >> 4;
    for (int k0 = 0; k0 < K; k0 += 32) {
        bf16x8 a[MT], b[NT];
#pragma unroll
        for (int mt = 0; mt < MT; ++mt) { if (AT) a[mt] = tr_frag(A + k0 * lda + 16 * mt, lda, lane); else a[mt] = *(const LAS bf16x8*)(A + (mt * 16 + r) * lda + k0 + 8 * q); }
#pragma unroll
        for (int nt = 0; nt < NT; ++nt) { if (BT) b[nt] = tr_frag(Bm + k0 * ldb + 16 * nt, ldb, lane); else b[nt] = *(const LAS bf16x8*)(Bm + (nt * 16 + r) * ldb + k0 + 8 * q); }
#pragma unroll
        for (int mt = 0; mt < MT; ++mt)
#pragma unroll
            for (int nt = 0; nt < NT; ++nt)
                acc[mt][nt] = TR ? __builtin_amdgcn_mfma_f32_16x16x32_bf16(b[nt], a[mt], acc[mt][nt], 0, 0, 0) : __builtin_amdgcn_mfma_f32_16x16x32_bf16(a[mt], b[nt], acc[mt][nt], 0, 0, 0);
    }
}
template <int N> struct Pf { u32x4 r[N]; };
template <int N, int CPR> __device__ __forceinline__ void pf_load(Pf<N>& p, const bf16* src, size_t gld, int tid) {
#pragma unroll
    for (int it = 0; it < N; ++it) { const int i = tid + NWAVES * 64 * it; p.r[it] = *(const u32x4*)(src + (size_t)(i / CPR) * gld + (i % CPR) * 8); }
}
template <int N, int CPR> __device__ __forceinline__ void pf_store(LAS bf16* dst, int lld, int tid, const Pf<N>& p) {
#pragma unroll
    for (int it = 0; it < N; ++it) { const int i = tid + NWAVES * 64 * it; *(LAS u32x4*)(dst + (i / CPR) * lld + (i % CPR) * 8) = p.r[it]; }
}
__device__ __forceinline__ u32x4 scale_bf16x8(u32x4 v, float s) {
    u32x4 o; o.x = cvt_pk_bf16(bflo(v.x) * s, bfhi(v.x) * s); o.y = cvt_pk_bf16(bflo(v.y) * s, bfhi(v.y) * s); o.z = cvt_pk_bf16(bflo(v.z) * s, bfhi(v.z) * s); o.w = cvt_pk_bf16(bflo(v.w) * s, bfhi(v.w) * s); return o;
}

struct RsCtx { const bf16* proj; bf16* st; LAS bf16* kt; LAS bf16* vt; int b, h, bh, dir, e0; float l2g, gC; };
__device__ __forceinline__ void rs_load(Pf<8>& pk, Pf<2>& pv, const RsCtx& c, int ci, int tid) {
    const int ch = c.dir ? 31 - ci : ci; const bf16* rowp = c.proj + (size_t)(c.b * SEQ + ch * 128) * NPROJ;
    pf_load<8, 32>(pk, rowp + C_RK + c.h * RD, NPROJ, tid); pf_load<2, 8>(pv, rowp + C_RV + c.h * RD + c.e0, NPROJ, tid);
}
__device__ __forceinline__ void rs_step(Frame& F, f32x4 (&acc)[4][2], Pf<8>& pk, Pf<2>& pv, const RsCtx& c, int ci) {
    const int r = F.lane & 15, q = F.lane >> 4;
    const int ch = c.dir ? 31 - ci : ci;
    bf16* sp = c.st + ((((size_t)(c.bh * 2 + c.dir) * 32 + ch) * 256 + c.e0) * 256) + 32 * F.wave + 4 * q;
#pragma unroll
    for (int mt = 0; mt < 4; ++mt)
#pragma unroll
        for (int nt = 0; nt < 2; ++nt) { u32x2 w; w.x = cvt_pk_bf16(acc[mt][nt][0], acc[mt][nt][1]); w.y = cvt_pk_bf16(acc[mt][nt][2], acc[mt][nt][3]);
            *(u32x2*)(sp + (size_t)(16 * mt + r) * 256 + 16 * nt) = w; }
    __syncthreads();
    pf_store<8, 32>(c.kt, 272, F.tid, pk);
#pragma unroll
    for (int it = 0; it < 2; ++it) { const int i = F.tid + NWAVES * 64 * it, row = i >> 3;
        const float sc = exp2f(c.l2g * (float)(c.dir ? row : 127 - row)); *(LAS u32x4*)(c.vt + row * 80 + (i & 7) * 8) = scale_bf16x8(pv.r[it], sc); }
    __syncthreads();
    if (ci + 2 < 32) rs_load(pk, pv, c, ci + 2, F.tid);
#pragma unroll
    for (int mt = 0; mt < 4; ++mt)
#pragma unroll
        for (int nt = 0; nt < 2; ++nt) acc[mt][nt] = acc[mt][nt] * c.gC;
    wave_mma_g<4, 2, true, true, true>(acc, c.vt, 80, c.kt + 32 * F.wave, 272, 128, F.lane);
}
__device__ __forceinline__ void ret_state_pass(Frame& F, int first, int stride, const bf16* proj, bf16* st) {
    for (int item = first; item < 128; item += stride) {
        RsCtx c; c.proj = proj; c.st = st; c.kt = (LAS bf16*)F.lds; c.vt = c.kt + 128 * 272;
        const int es = item & 3; c.dir = (item >> 2) & 1; c.bh = item >> 3; c.b = c.bh >> 3; c.h = c.bh & 7; c.e0 = es * 64;
        const int hg = c.dir ? (7 - c.h) : c.h; const float gam = 1.0f - exp2f(-5.0f - (float)hg); c.l2g = log2f(gam); c.gC = exp2f(128.0f * c.l2g);
        f32x4 acc[4][2];
#pragma unroll
        for (int mt = 0; mt < 4; ++mt)
#pragma unroll
            for (int nt = 0; nt < 2; ++nt) acc[mt][nt] = (f32x4){0.f, 0.f, 0.f, 0.f};
        Pf<8> pkA, pkB; Pf<2> pvA, pvB;
        rs_load(pkA, pvA, c, 0, F.tid); rs_load(pkB, pvB, c, 1, F.tid);
        for (int ci = 0; ci < 32; ci += 2) { rs_step(F, acc, pkA, pvA, c, ci); rs_step(F, acc, pkB, pvB, c, ci + 1); }
    }
    __syncthreads();
}
struct RoCtx { const bf16* kbase; const bf16* vbase; const bf16* stf; const bf16* stb; };
template <int S> __device__ __forceinline__ void ro_issue(Pf<4>& pa, Pf<2>& pv, const RoCtx& c, int tid) {
    if constexpr (S < 2) pf_load<4, 32>(pa, c.kbase + (size_t)(64 * S) * NPROJ, NPROJ, tid);
    else if constexpr (S < 14) { constexpr int es = (S - 2) / 3, kind = (S - 2) % 3;
        if constexpr (kind == 0) pf_load<4, 32>(pa, c.stf + (size_t)(64 * es) * 256, 256, tid);
        else if constexpr (kind == 1) pf_load<4, 32>(pa, c.stb + (size_t)(64 * es) * 256, 256, tid);
        else pf_load<2, 8>(pv, c.vbase + 64 * es, NPROJ, tid); }
}
template <int S> __device__ __forceinline__ void ro_round(Frame& F, Pf<4>& pa, Pf<2>& pv, const RoCtx& c, LAS bf16* qs, LAS bf16* ps, LAS bf16* bs, f32x4 (&o)[4][1][4], int n, float l2f, float l2b, float qdf, float qdb) {
    const int q = F.lane >> 4;
    __syncthreads();
    if constexpr (S < 2 || (S - 2) % 3 != 2) pf_store<4, 32>(bs, 264, F.tid, pa); else pf_store<2, 8>(bs, 80, F.tid, pv);
    __syncthreads();
    ro_issue<S + 1>(pa, pv, c, F.tid);
    if constexpr (S < 2) {
        f32x4 s[1][4];
#pragma unroll
        for (int nt = 0; nt < 4; ++nt) s[0][nt] = (f32x4){0.f, 0.f, 0.f, 0.f};
        wave_mma<1, 4, true>(s, qs + F.wave * 16 * 264, 264, bs, 264, 256, F.lane);
#pragma unroll
        for (int nt = 0; nt < 4; ++nt) { float p[4];
#pragma unroll
            for (int j = 0; j < 4; ++j) { const int mkey = 64 * S + 16 * nt + 4 * q + j; const int dist = n - mkey;
                const float w = dist >= 0 ? exp2f((float)dist * l2f) : exp2f((float)(-dist) * l2b); p[j] = s[0][nt][j] * w; }
            u32x2 w2; w2.x = cvt_pk_bf16(p[0], p[1]); w2.y = cvt_pk_bf16(p[2], p[3]);
            *(LAS u32x2*)(ps + n * 136 + 64 * S + 16 * nt + 4 * q) = w2; }
    } else { constexpr int es = (S - 2) / 3, kind = (S - 2) % 3;
        if constexpr (kind < 2) {
            f32x4 t[1][4];
#pragma unroll
            for (int nt = 0; nt < 4; ++nt) t[0][nt] = (f32x4){0.f, 0.f, 0.f, 0.f};
            wave_mma<1, 4, true>(t, qs + F.wave * 16 * 264, 264, bs, 264, 256, F.lane);
#pragma unroll
            for (int nt = 0; nt < 4; ++nt) { if constexpr (kind == 0) o[es][0][nt] = t[0][nt] * qdf; else o[es][0][nt] = o[es][0][nt] + t[0][nt] * qdb; }
        } else {
            wave_mma_g<1, 4, true, false, true>(o[es], ps + F.wave * 16 * 136, 136, bs, 80, 128, F.lane);
        }
    }
}
__device__ __forceinline__ void ret_output_pass(Frame& F, int first, int stride, const bf16* proj, const bf16* st, const float* rng, bf16* mixin) {
    LAS bf16* qs = (LAS bf16*)F.lds;
    LAS bf16* ps = qs + 128 * 264;
    LAS bf16* bs = ps + 128 * 136;
    const int r = F.lane & 15, q = F.lane >> 4;
    for (int item = first; item < 512; item += stride) {
        const int ch = item & 31, bh = item >> 5, b = bh >> 3, h = bh & 7;
        const float l2f = log2f(1.0f - exp2f(-5.0f - (float)h)), l2b = log2f(1.0f - exp2f(-5.0f - (float)(7 - h)));
        const size_t row0 = (size_t)b * SEQ + ch * 128;
        const int n = 16 * F.wave + r;
        RoCtx c; c.kbase = proj + row0 * NPROJ + C_RK + h * RD; c.vbase = proj + row0 * NPROJ + C_RV + h * RD;
        c.stf = st + (((size_t)(bh * 2 + 0) * 32 + ch) * 256) * 256; c.stb = st + (((size_t)(bh * 2 + 1) * 32 + ch) * 256) * 256;
        Pf<4> pa; Pf<2> pv;
        ro_issue<0>(pa, pv, c, F.tid);
        __syncthreads();
        stage_tile(qs, 264, proj + row0 * NPROJ + C_RQ + h * RD, NPROJ, 128, 256, F.tid);
        const float qdf = exp2f((float)(n + 1) * l2f), qdb = exp2f((float)(128 - n) * l2b);
        f32x4 o[4][1][4];
        ro_round<0>(F, pa, pv, c, qs, ps, bs, o, n, l2f, l2b, qdf, qdb); ro_round<1>(F, pa, pv, c, qs, ps, bs, o, n, l2f, l2b, qdf, qdb);
        ro_round<2>(F, pa, pv, c, qs, ps, bs, o, n, l2f, l2b, qdf, qdb); ro_round<3>(F, pa, pv, c, qs, ps, bs, o, n, l2f, l2b, qdf, qdb); ro_round<4>(F, pa, pv, c, qs, ps, bs, o, n, l2f, l2b, qdf, qdb);
        ro_round<5>(F, pa, pv, c, qs, ps, bs, o, n, l2f, l2b, qdf, qdb); ro_round<6>(F, pa, pv, c, qs, ps, bs, o, n, l2f, l2b, qdf, qdb); ro_round<7>(F, pa, pv, c, qs, ps, bs, o, n, l2f, l2b, qdf, qdb);
        ro_round<8>(F, pa, pv, c, qs, ps, bs, o, n, l2f, l2b, qdf, qdb); ro_round<9>(F, pa, pv, c, qs, ps, bs, o, n, l2f, l2b, qdf, qdb); ro_round<10>(F, pa, pv, c, qs, ps, bs, o, n, l2f, l2b, qdf, qdb);
        ro_round<11>(F, pa, pv, c, qs, ps, bs, o, n, l2f, l2b, qdf, qdb); ro_round<12>(F, pa, pv, c, qs, ps, bs, o, n, l2f, l2b, qdf, qdb); ro_round<13>(F, pa, pv, c, qs, ps, bs, o, n, l2f, l2b, qdf, qdb);
        float sm = 0.f;
#pragma unroll
        for (int es = 0; es < 4; ++es)
#pragma unroll
            for (int nt = 0; nt < 4; ++nt) sm += (o[es][0][nt][0] + o[es][0][nt][1]) + (o[es][0][nt][2] + o[es][0][nt][3]);
        sm += __shfl_xor(sm, 16); sm += __shfl_xor(sm, 32);
        const float mu = sm * (1.0f / RD); float sv = 0.f;
#pragma unroll
        for (int es = 0; es < 4; ++es)
#pragma unroll
            for (int nt = 0; nt < 4; ++nt) { const f32x4 dvv = o[es][0][nt] - mu; o[es][0][nt] = dvv; sv += (dvv[0] * dvv[0] + dvv[1] * dvv[1]) + (dvv[2] * dvv[2] + dvv[3] * dvv[3]); }
        sv += __shfl_xor(sv, 16); sv += __shfl_xor(sv, 32);
        const float rs = 1.0f / sqrtf(sv * (1.0f / RD) + GN_EPS);
        const bf16* gp = proj + (row0 + n) * NPROJ + C_RG + h * RD + 4 * q; bf16* op = mixin + (row0 + n) * D + h * RD + 4 * q; const float* gg = rng + h * RD + 4 * q;
#pragma unroll
        for (int es = 0; es < 4; ++es)
#pragma unroll
            for (int nt = 0; nt < 4; ++nt) { const int e = 64 * es + 16 * nt; const u32x2 gt = *(const u32x2*)(gp + e); const f32x4 g4 = *(const f32x4*)(gg + e);
                const f32x4 v = o[es][0][nt] * rs * g4;
                u32x2 w; w.x = cvt_pk_bf16(v[0] * silu_f(bflo(gt.x)), v[1] * silu_f(bfhi(gt.x))); w.y = cvt_pk_bf16(v[2] * silu_f(bflo(gt.y)), v[3] * silu_f(bfhi(gt.y)));
                *(u32x2*)(op + e) = w; }
    }
    __syncthreads();
}

__device__ __forceinline__ float hgrn_lb(const float* lblog, int layer, int dir, int col) {
    if (layer == 0) return 0.f;
    float mx = -1e30f;
    for (int l = 0; l < NL; ++l) mx = fmaxf(mx, lblog[(l * 2 + dir) * HW + col]);
    float den = 0.f, num = 0.f;
    for (int l = 0; l < NL; ++l) { const float ev = __expf(lblog[(l * 2 + dir) * HW + col] - mx); den += ev; if (l >= 1 && l <= layer) num += ev; }
    return num / den;
}
constexpr int HSB = 4;
struct HsCtx { const bf16* proj; const float* gatez; bf16* hst; LAS bf16* kpt; LAS bf16* vt; LAS float* tot; LAS float* adec; int b, h, bh, dir, d0, d, sg; float lb; };
__device__ __forceinline__ void hs_load(float (&zr)[HSB][4], Pf<2> (&pv)[HSB], const HsCtx& c, int cg, int tid) {
#pragma unroll
    for (int cb = 0; cb < HSB; ++cb) { const int ci = cg * HSB + cb, ch = c.dir ? 63 - ci : ci; const size_t row0 = (size_t)c.b * SEQ + ch * 64;
        const bf16* zp = c.proj + (row0 + 4 * c.sg) * NPROJ + C_HFF + c.dir * HW + c.h * HD + c.d0 + c.d;
#pragma unroll
        for (int ii = 0; ii < 4; ++ii) zr[cb][ii] = bf2f(zp[(size_t)ii * NPROJ]);
        pf_load<2, 16>(pv[cb], c.proj + row0 * NPROJ + C_HI + c.h * HD, NPROJ, tid); }
}
__device__ __forceinline__ void hs_step(Frame& F, f32x4 (&acc)[1][2], float (&zr)[HSB][4], Pf<2> (&pv)[HSB], const HsCtx& c, int cg) {
    const int r = F.lane & 15, q = F.lane >> 4, d = c.d, sg = c.sg, dir = c.dir;
    float lf[HSB][4], kk[HSB][4], mytot[HSB];
#pragma unroll
    for (int cb = 0; cb < HSB; ++cb) {
#pragma unroll
        for (int ii = 0; ii < 4; ++ii) { const float f = c.lb + (1.0f - c.lb) * fast_sigmoid(zr[cb][ii]); lf[cb][ii] = __logf(f); kk[cb][ii] = 1.0f - f; }
        if (dir == 0) { lf[cb][1] += lf[cb][0]; lf[cb][2] += lf[cb][1]; lf[cb][3] += lf[cb][2]; } else { lf[cb][2] += lf[cb][3]; lf[cb][1] += lf[cb][2]; lf[cb][0] += lf[cb][1]; }
        mytot[cb] = dir == 0 ? lf[cb][3] : lf[cb][0]; }
    __syncthreads();
#pragma unroll
    for (int cb = 0; cb < HSB; ++cb) { c.tot[cb * 512 + sg * 32 + d] = mytot[cb]; pf_store<2, 16>(c.vt + cb * 64 * 144, 144, F.tid, pv[cb]); }
    __syncthreads();
    if (cg + 2 < 64 / HSB) hs_load(zr, pv, c, cg + 2, F.tid);
#pragma unroll
    for (int cb = 0; cb < HSB; ++cb) {
        float other = 0.f, all = 0.f;
#pragma unroll
        for (int g = 0; g < 16; ++g) { const float tv = c.tot[cb * 512 + g * 32 + d]; all += tv; if (dir == 0 ? (g < sg) : (g > sg)) other += tv; }
        float kv[4];
#pragma unroll
        for (int ii = 0; ii < 4; ++ii) kv[ii] = kk[cb][ii] * __expf(all - (lf[cb][ii] + other));
        { u32x2 w; w.x = cvt_pk_bf16(kv[0], kv[1]); w.y = cvt_pk_bf16(kv[2], kv[3]); *(LAS u32x2*)(c.kpt + cb * 32 * 72 + d * 72 + 4 * sg) = w; }
        if (sg == 0) c.adec[cb * 32 + d] = __expf(all); }
    __syncthreads();
#pragma unroll
    for (int cb = 0; cb < HSB; ++cb) { const int ci = cg * HSB + cb, ch = dir ? 63 - ci : ci;
#pragma unroll
        for (int nt = 0; nt < 2; ++nt) { u32x2 w; w.x = cvt_pk_bf16(acc[0][nt][0], acc[0][nt][1]); w.y = cvt_pk_bf16(acc[0][nt][2], acc[0][nt][3]);
            *(u32x2*)(c.hst + ((((size_t)(c.bh * 2 + dir) * 64 + ch) * 128 + 16 * F.wave + r) * 128) + c.d0 + 16 * nt + 4 * q) = w; }
#pragma unroll
        for (int nt = 0; nt < 2; ++nt) { const f32x4 a4 = *(const LAS f32x4*)(c.adec + cb * 32 + 16 * nt + 4 * q); acc[0][nt] = acc[0][nt] * a4; }
        wave_mma_g<1, 2, true, true, false>(acc, c.vt + cb * 64 * 144 + 16 * F.wave, 144, c.kpt + cb * 32 * 72, 72, 64, F.lane); }
}
__device__ __forceinline__ void hgrn_state_pass(Frame& F, int first, int stride, const bf16* proj, const float* gatez, const float* lblog, int layer, bf16* hst) {
    for (int item = first; item < 128; item += stride) {
        HsCtx c; c.proj = proj; c.gatez = gatez; c.hst = hst;
        c.kpt = (LAS bf16*)F.lds; c.vt = c.kpt + HSB * 32 * 72; c.tot = (LAS float*)(c.vt + HSB * 64 * 144); c.adec = c.tot + HSB * 512;
        const int ds = item & 3; c.dir = (item >> 2) & 1; c.bh = item >> 3; c.b = c.bh >> 3; c.h = c.bh & 7; c.d0 = ds * 32; c.d = F.tid & 31; c.sg = F.tid >> 5;
        c.lb = hgrn_lb(lblog, layer, c.dir, c.h * HD + c.d0 + c.d);
        f32x4 acc[1][2]; acc[0][0] = (f32x4){0.f, 0.f, 0.f, 0.f}; acc[0][1] = (f32x4){0.f, 0.f, 0.f, 0.f};
        float zA[HSB][4], zB[HSB][4]; Pf<2> pvA[HSB], pvB[HSB];
        hs_load(zA, pvA, c, 0, F.tid); hs_load(zB, pvB, c, 1, F.tid);
        for (int cg = 0; cg < 64 / HSB; cg += 2) { hs_step(F, acc, zA, pvA, c, cg); hs_step(F, acc, zB, pvB, c, cg + 1); }
    }
    __syncthreads();
}
__device__ __forceinline__ void hgrn_output_pass(Frame& F, int first, int stride, int last, const bf16* proj, const float* gatez, const float* lblog, int layer, const bf16* hst, const float* hng, bf16* mixin) {
    LAS bf16* qd = (LAS bf16*)F.lds;
    LAS bf16* kd = qd + 64 * 136;
    LAS bf16* qx = kd + 64 * 136;
    LAS bf16* ps = qx + 64 * 136;
    LAS bf16* vt = ps + 64 * 72;
    LAS bf16* sT = vt + 64 * 144;
    LAS float* tot = (LAS float*)(sT + 128 * 136);
    LAS float* rsq = tot + 512;
    const int r = F.lane & 15, q = F.lane >> 4, rg = F.wave & 3, eh = F.wave >> 2;
    const int d = F.tid & 127, sq = F.tid >> 7;
    const int nitems = first < last ? (last - first + stride - 1) / stride : 0, nunits = 2 * nitems;
    if (nunits == 0) return;
    float zr[16]; unsigned short qr[16]; Pf<4> pst; Pf<2> pvv;
#define HO_ISSUE(u_) do { const int it_ = first + ((u_) >> 1) * stride, dr_ = (u_) & 1; const int ch_ = it_ & 63, bh_ = it_ >> 6, b_ = bh_ >> 3, h_ = bh_ & 7; const size_t r0_ = (size_t)b_ * SEQ + ch_ * 64; \
        const bf16* zp_ = proj + (r0_ + 16 * sq) * NPROJ + C_HFF + dr_ * HW + h_ * HD + d; const bf16* qp_ = proj + (r0_ + 16 * sq) * NPROJ + C_HQ + h_ * HD + d; \
        _Pragma("unroll") for (int ii = 0; ii < 16; ++ii) { zr[ii] = bf2f(zp_[(size_t)ii * NPROJ]); qr[ii] = qp_[(size_t)ii * NPROJ]; } \
        pf_load<4, 16>(pst, hst + (((size_t)(bh_ * 2 + dr_) * 64 + ch_) * 128) * 128, 128, F.tid); \
        if (dr_ == 0) pf_load<2, 16>(pvv, proj + r0_ * NPROJ + C_HI + h_ * HD, NPROJ, F.tid); } while (0)
    HO_ISSUE(0);
    f32x4 o[1][4];
    for (int u = 0; u < nunits; ++u) {
        const int item = first + (u >> 1) * stride, dir = u & 1;
        const int ch = item & 63, bh = item >> 6, b = bh >> 3, h = bh & 7; const size_t row0 = (size_t)b * SEQ + ch * 64;
        if (dir == 0) {
#pragma unroll
            for (int nt = 0; nt < 4; ++nt) o[0][nt] = (f32x4){0.f, 0.f, 0.f, 0.f};
        }
        const float lb = hgrn_lb(lblog, layer, dir, h * HD + d);
        float lf[16], kk[16], qv[16];
#pragma unroll
        for (int ii = 0; ii < 16; ++ii) { const float f = lb + (1.0f - lb) * fast_sigmoid(zr[ii]); lf[ii] = __logf(f); kk[ii] = 1.0f - f; qv[ii] = bf2f(qr[ii]) * 0.08838834764831845f; }
        if (dir == 0) {
#pragma unroll
            for (int ii = 1; ii < 16; ++ii) lf[ii] += lf[ii - 1];
        } else {
#pragma unroll
            for (int ii = 14; ii >= 0; --ii) lf[ii] += lf[ii + 1];
        }
        const float mytot = dir == 0 ? lf[15] : lf[0];
        __syncthreads();
        tot[sq * 128 + d] = mytot;
        if (dir == 0) pf_store<2, 16>(vt, 144, F.tid, pvv);
        pf_store<4, 16>(sT, 136, F.tid, pst);
        __syncthreads();
        if (u + 1 < nunits) HO_ISSUE(u + 1);
        const float t0 = tot[d], t1 = tot[128 + d], t2 = tot[256 + d], t3 = tot[384 + d];
        float other, R;
        if (dir == 0) { other = sq == 0 ? 0.f : (sq == 1 ? t0 : (sq == 2 ? t0 + t1 : t0 + t1 + t2)); R = t0 + t1; }
        else { other = sq == 3 ? 0.f : (sq == 2 ? t3 : (sq == 1 ? t3 + t2 : t3 + t2 + t1)); R = t3 + t2; }
#pragma unroll
        for (int ii = 0; ii < 16; ++ii) { const float cum = lf[ii] + other; const int t = 16 * sq + ii;
            const float ea = __expf(cum - R), eb = __expf(R - cum), ec = __expf(cum);
            qd[t * 136 + d] = (bf16)(cvt_pk_bf16(qv[ii] * ea, 0.f) & 0xffffu); kd[t * 136 + d] = (bf16)(cvt_pk_bf16(kk[ii] * eb, 0.f) & 0xffffu); qx[t * 136 + d] = (bf16)(cvt_pk_bf16(qv[ii] * ec, 0.f) & 0xffffu); }
        __syncthreads();
        { f32x4 s[1][2]; s[0][0] = (f32x4){0.f, 0.f, 0.f, 0.f}; s[0][1] = (f32x4){0.f, 0.f, 0.f, 0.f};
          wave_mma<1, 2, true>(s, qd + rg * 16 * 136, 136, kd + eh * 32 * 136, 136, 128, F.lane);
          const int t = 16 * rg + r;
#pragma unroll
          for (int nt = 0; nt < 2; ++nt) { float p[4];
#pragma unroll
              for (int j = 0; j < 4; ++j) { const int sk = 32 * eh + 16 * nt + 4 * q + j; const bool keep = dir == 0 ? (sk <= t) : (sk >= t); p[j] = keep ? s[0][nt][j] : 0.f; }
              u32x2 w; w.x = cvt_pk_bf16(p[0], p[1]); w.y = cvt_pk_bf16(p[2], p[3]);
              *(LAS u32x2*)(ps + t * 72 + 32 * eh + 16 * nt + 4 * q) = w; } }
        __syncthreads();
        wave_mma_g<1, 4, true, false, true>(o, ps + rg * 16 * 72, 72, vt + eh * 64, 144, 64, F.lane);
        wave_mma<1, 4, true>(o, qx + rg * 16 * 136, 136, sT + eh * 64 * 136, 136, 128, F.lane);
        if (dir == 1) {
            float ss = 0.f;
#pragma unroll
            for (int nt = 0; nt < 4; ++nt) ss += (o[0][nt][0] * o[0][nt][0] + o[0][nt][1] * o[0][nt][1]) + (o[0][nt][2] * o[0][nt][2] + o[0][nt][3] * o[0][nt][3]);
            ss += __shfl_xor(ss, 16); ss += __shfl_xor(ss, 32);
            const int t = 16 * rg + r;
            if (q == 0) rsq[t * 2 + eh] = ss;
            __syncthreads();
            const float rs = 1.0f / sqrtf((rsq[t * 2] + rsq[t * 2 + 1]) * (1.0f / HD) + RMS_EPS);
            const bf16* gp = proj + (row0 + t) * NPROJ + C_HG + h * HD + 64 * eh + 4 * q; bf16* op = mixin + (row0 + t) * D + RW + h * HD + 64 * eh + 4 * q; const float* gg = hng + h * HD + 64 * eh + 4 * q;
#pragma unroll
            for (int nt = 0; nt < 4; ++nt) { const u32x2 gt = *(const u32x2*)(gp + 16 * nt); const f32x4 g4 = *(const f32x4*)(gg + 16 * nt); const f32x4 v = o[0][nt] * rs * g4;
                u32x2 w; w.x = cvt_pk_bf16(v[0] * silu_f(bflo(gt.x)), v[1] * silu_f(bfhi(gt.x))); w.y = cvt_pk_bf16(v[2] * silu_f(bflo(gt.y)), v[3] * silu_f(bfhi(gt.y)));
                *(u32x2*)(op + 16 * nt) = w; }
        }
    }
#undef HO_ISSUE
    __syncthreads();
}

__device__ __forceinline__ void fourier_ut2(Frame& F, int bid, const bf16* proj, const bf16* fwt, bf16* ut2, float* nyq) {
    LAS bf16* zc = (LAS bf16*)F.lds;
    LAS bf16* zs = zc + 128 * 136;
    LAS bf16* ws = zs + 128 * 136;
    const int g = bid & 7, nb = (bid >> 3) & 15, b = bid >> 7;
    const bf16* zb = proj + (size_t)(b * SEQ) * NPROJ + C_FZ + g * FD;
    u32x4 ra[4], rb[4];
#pragma unroll
    for (int it = 0; it < 4; ++it) { const int i = F.tid + NWAVES * 64 * it, row = i >> 4, ch = i & 15, n = nb * 128 + row; const int mrow = (SEQ - n) & (SEQ - 1);
        ra[it] = *(const u32x4*)(zb + (size_t)n * NPROJ + ch * 8); rb[it] = *(const u32x4*)(zb + (size_t)mrow * NPROJ + ch * 8); }
    __syncthreads();
    stage_tile(ws, 136, fwt + (size_t)g * 256 * 128, 128, 256, 128, F.tid);
#pragma unroll
    for (int it = 0; it < 4; ++it) { const int i = F.tid + NWAVES * 64 * it, row = i >> 4, ch = i & 15, n = nb * 128 + row; const float k0 = n == 0 ? 0.f : 1.f;
        const u32x4 a = ra[it], m = rb[it]; u32x4 sc, sd;
        sc.x = cvt_pk_bf16(bflo(a.x) + k0 * bflo(m.x), bfhi(a.x) + k0 * bfhi(m.x)); sd.x = cvt_pk_bf16(k0 * (bflo(a.x) - bflo(m.x)), k0 * (bfhi(a.x) - bfhi(m.x)));
        sc.y = cvt_pk_bf16(bflo(a.y) + k0 * bflo(m.y), bfhi(a.y) + k0 * bfhi(m.y)); sd.y = cvt_pk_bf16(k0 * (bflo(a.y) - bflo(m.y)), k0 * (bfhi(a.y) - bfhi(m.y)));
        sc.z = cvt_pk_bf16(bflo(a.z) + k0 * bflo(m.z), bfhi(a.z) + k0 * bfhi(m.z)); sd.z = cvt_pk_bf16(k0 * (bflo(a.z) - bflo(m.z)), k0 * (bfhi(a.z) - bfhi(m.z)));
        sc.w = cvt_pk_bf16(bflo(a.w) + k0 * bflo(m.w), bfhi(a.w) + k0 * bfhi(m.w)); sd.w = cvt_pk_bf16(k0 * (bflo(a.w) - bflo(m.w)), k0 * (bfhi(a.w) - bfhi(m.w)));
        *(LAS u32x4*)(zc + row * 136 + ch * 8) = sc; *(LAS u32x4*)(zs + row * 136 + ch * 8) = sd; }
    __syncthreads();
    const int r = F.lane & 15, q = F.lane >> 4; const int n = nb * 128 + F.wave * 16 + 4 * q;
#pragma unroll
    for (int part = 0; part < 2; ++part) {
        f32x4 acc[1][8];
#pragma unroll
        for (int nt = 0; nt < 8; ++nt) acc[0][nt] = (f32x4){0.f, 0.f, 0.f, 0.f};
        wave_mma<1, 8, false>(acc, (part ? zs : zc) + F.wave * 16 * 136, 136, ws + part * 128 * 136, 136, 128, F.lane);
#pragma unroll
        for (int nt = 0; nt < 8; ++nt) { const int d = nt * 16 + r;
            u32x2 w; w.x = cvt_pk_bf16(acc[0][nt][0], acc[0][nt][1]); w.y = cvt_pk_bf16(acc[0][nt][2], acc[0][nt][3]);
            *(u32x2*)(ut2 + (size_t)(part * 2048 + b * FW + g * FD + d) * 2048 + n) = w; }
    }
    if (nb == 0 && F.tid < 128) {
        const int d = F.tid; const bf16* zr = zb + (size_t)2048 * NPROJ; float acc = 0.f;
        for (int c8 = 0; c8 < 16; ++c8) { const u32x4 zv = *(const u32x4*)(zr + c8 * 8); const u32x4 wv = *(const LAS u32x4*)(ws + d * 136 + c8 * 8);
            acc += bflo(zv.x) * bflo(wv.x) + bfhi(zv.x) * bfhi(wv.x) + bflo(zv.y) * bflo(wv.y) + bfhi(zv.y) * bfhi(wv.y) + bflo(zv.z) * bflo(wv.z) + bfhi(zv.z) * bfhi(wv.z) + bflo(zv.w) * bflo(wv.w) + bfhi(zv.w) * bfhi(wv.w); }
        nyq[b * FW + g * FD + d] = acc;
    }
    __syncthreads();
}
__device__ __forceinline__ void fourier_mid_row(Frame& F, int first_wave, int nwaves, const bf16* ut2, const float* nyq, const float* bias, bf16* mixin) {
    for (int c = first_wave; c < NB * FW; c += nwaves) {
        const u32x4* rowp = (const u32x4*)(ut2 + (size_t)c * 2048) + F.lane; float sacc = 0.f;
#pragma unroll
        for (int j = 0; j < 4; ++j) { const u32x4 v = rowp[64 * j]; sacc += (bflo(v.x) - bfhi(v.x)) + (bflo(v.y) - bfhi(v.y)) + (bflo(v.z) - bfhi(v.z)) + (bflo(v.w) - bfhi(v.w)); }
        sacc = wave_sum(sacc);
        if (F.lane == 0) { const int b = c >> 10, colm = c & 1023; const float y = sacc + nyq[c] + bias[colm];
            mixin[(size_t)(b * SEQ + 2048) * D + 3072 + colm] = (bf16)(cvt_pk_bf16(y, 0.f) & 0xffffu); }
    }
}

__device__ __forceinline__ void xattn_phase(Frame& F, const bf16* xq, const bf16* kvmem, bf16* xo) {
    LAS bf16* ra = (LAS bf16*)F.lds;
    LAS bf16* rb = ra + 128 * 264;
    for (int item = F.vcu; item < NB * XH * 32; item += F.G) {
        const int qb = item & 31, hd = (item >> 5) & 3, b = item >> 7;
        __syncthreads();
        stage_tile(ra, 264, xq + (size_t)(b * SEQ + qb * 128) * XW + hd * XD, XW, 128, 256, F.tid);
        f32x4 s[2][8];
#pragma unroll
        for (int hf = 0; hf < 2; ++hf) {
            if (hf) __syncthreads();
            stage_tile(rb, 264, kvmem + (size_t)(b * MEMT + hf * 128) * 2048 + hd * XD, 2048, 128, 256, F.tid);
            __syncthreads();
            f32x4 acc[1][8];
#pragma unroll
            for (int nt = 0; nt < 8; ++nt) acc[0][nt] = (f32x4){0.f, 0.f, 0.f, 0.f};
            wave_mma<1, 8, true>(acc, ra + F.wave * 16 * 264, 264, rb, 264, 256, F.lane);
#pragma unroll
            for (int nt = 0; nt < 8; ++nt) s[hf][nt] = acc[0][nt];
        }
        float mx = -1e30f;
#pragma unroll
        for (int hf = 0; hf < 2; ++hf)
#pragma unroll
            for (int nt = 0; nt < 8; ++nt)
#pragma unroll
                for (int j = 0; j < 4; ++j) mx = fmaxf(mx, s[hf][nt][j]);
        mx = fmaxf(mx, __shfl_xor(mx, 16)); mx = fmaxf(mx, __shfl_xor(mx, 32));
        float sum = 0.f;
#pragma unroll
        for (int hf = 0; hf < 2; ++hf)
#pragma unroll
            for (int nt = 0; nt < 8; ++nt)
#pragma unroll
                for (int j = 0; j < 4; ++j) { const float p = __expf(s[hf][nt][j] - mx); s[hf][nt][j] = p; sum += p; }
        sum += __shfl_xor(sum, 16); sum += __shfl_xor(sum, 32);
        const float inv = 1.0f / sum;
        __syncthreads();
        { const int r = F.lane & 15, q = F.lane >> 4; LAS bf16* prow = ra + (F.wave * 16 + r) * 264;
#pragma unroll
          for (int hf = 0; hf < 2; ++hf)
#pragma unroll
              for (int nt = 0; nt < 8; ++nt) { u32x2 w; w.x = cvt_pk_bf16(s[hf][nt][0], s[hf][nt][1]); w.y = cvt_pk_bf16(s[hf][nt][2], s[hf][nt][3]);
                  *(LAS u32x2*)(prow + hf * 128 + nt * 16 + 4 * q) = w; } }
        f32x4 o[1][16];
#pragma unroll
        for (int nt = 0; nt < 16; ++nt) o[0][nt] = (f32x4){0.f, 0.f, 0.f, 0.f};
#pragma unroll
        for (int hf = 0; hf < 2; ++hf) {
            if (hf) __syncthreads();
            stage_tile(rb, 272, kvmem + (size_t)(b * MEMT + hf * 128) * 2048 + 1024 + hd * XD, 2048, 128, 256, F.tid);
            __syncthreads();
            wave_mma_g<1, 16, true, false, true>(o, ra + F.wave * 16 * 264 + hf * 128, 264, rb, 272, 128, F.lane);
        }
        { const int r = F.lane & 15, q = F.lane >> 4; bf16* orow = xo + (size_t)(b * SEQ + qb * 128 + F.wave * 16 + r) * XW + hd * XD + 4 * q;
#pragma unroll
          for (int nt = 0; nt < 16; ++nt) { u32x2 w; w.x = cvt_pk_bf16(o[0][nt][0] * inv, o[0][nt][1] * inv); w.y = cvt_pk_bf16(o[0][nt][2] * inv, o[0][nt][3] * inv); *(u32x2*)(orow + nt * 16) = w; } }
    }
    __syncthreads();
}

#define AIN(k) ((const float*)(GAS const float*)args.in[k])
#define x_in (AIN(0))
#define mem (AIN(1))
#define mem_g (AIN(2))
#define W_in ((bf16*)(wsp + WS_WIN))
#define W_out ((bf16*)(wsp + WS_WOUT))
#define W_q ((bf16*)(wsp + WS_WQ))
#define W_kv ((bf16*)(wsp + WS_WKV))
#define W_o ((bf16*)(wsp + WS_WO))
#define W_gu ((bf16*)(wsp + WS_WGU))
#define W_dn ((bf16*)(wsp + WS_WDN))
#define anorm ((bf16*)(wsp + WS_ANORM))
#define proj ((bf16*)(wsp + WS_PROJ))
#define hid ((bf16*)(wsp + WS_PROJ))
#define gatez ((float*)(wsp + WS_GATEZ))
#define mixin ((bf16*)(wsp + WS_MIXIN))
#define tmpb ((bf16*)(wsp + WS_TMP))
#define rst ((bf16*)(wsp + WS_SCR))
#define hst ((bf16*)(wsp + WS_SCR + 128 * MiB))
#define dft ((bf16*)(wsp + WS_DFT))
#define ut ((bf16*)(wsp + WS_UT))
#define xq ((bf16*)(wsp + WS_XQ))
#define xo ((bf16*)(wsp + WS_XO))
#define kvmem ((bf16*)(wsp + WS_KVMEM))
#define memn ((bf16*)(wsp + WS_MEMN))
#define ropec ((float*)(wsp + WS_ROPE))
#define ropes ((float*)(wsp + WS_ROPE) + SEQ * 128)
#define fwt ((bf16*)(wsp + (layer == 0 ? WS_FWT : WS_FWT1)))
#define nyq ((float*)(wsp + WS_FWT + 640 * 1024))
#define rsv ((float*)(wsp + WS_FWT + 768 * 1024))
#define rqv ((float*)(wsp + WS_FWT + 832 * 1024))
#define hq ((signed char*)(wsp + WS_GATEZ))
#define cmaxf ((float*)(wsp + WS_CTL + 256 * 1024))
#define cminf ((float*)(wsp + WS_CTL + 448 * 1024))
#define hout ((float*)(GAS float*)args.out)
#define cq ((unsigned*)(wsp + WS_CTL) + CW_CONVQ)
#define cd (ConvDst{W_out, W_q, W_kv, W_o, W_gu, W_dn, W_in, cmaxf, cminf})
__global__ void __launch_bounds__(NWAVES * 64, 2) fwd_kernel(Args args) {
    extern __shared__ __attribute__((aligned(16))) unsigned char lds[];
    Frame F;
    F.lds = (LAS unsigned char*)lds;
    F.tid = threadIdx.x; F.lane = F.tid & 63; F.wave = __builtin_amdgcn_readfirstlane(F.tid >> 6);
    F.bid = blockIdx.x; F.G = gridDim.x; { const int bx = blockIdx.x; F.vcu = (F.G % 8 == 0) ? (bx % 8) * (F.G / 8) + bx / 8 : bx; }
    F.gw = F.vcu * NWAVES + F.wave; F.NGW = F.G * NWAVES;
    unsigned char* ws = (unsigned char*)(GAS unsigned char*)args.ws; F.ws = ws;
    volatile LAS unsigned* MISC = (volatile LAS unsigned*)(F.lds + MISC_OFF);
    for (int u = F.tid; u < (LDS_BYTES - LDSCTL_OFF) / 4; u += NWAVES * 64) ((LAS unsigned*)(F.lds + LDSCTL_OFF))[u] = 0u;
    __syncthreads();
    XcdBarrier bar; bar.bar = (unsigned*)(ws + WS_CTL) + CW_BAR; bar.x = 0; bar.st = nullptr;
    if (args.single) bar = xcd_barrier_post((unsigned*)(ws + WS_CTL) + CW_BAR, MISC + 8);
#define GRID_BAR() do { if (args.single) xcd_barrier(bar); } while (0)
#define RELAUNDER() do { { int b_ = blockIdx.x; asm volatile("" : "+s"(b_)); F.bid = b_; } wsp = (GAS unsigned char*)args.ws; asm volatile("" : "+s"(wsp)); int t_ = threadIdx.x; asm volatile("" : "+v"(t_)); F.tid = t_; F.lane = t_ & 63; F.wave = __builtin_amdgcn_readfirstlane(t_ >> 6); F.gw = F.vcu * NWAVES + F.wave; } while (0)

    GAS unsigned char* wsp = (GAS unsigned char*)args.ws;
    const int lo = args.ph_lo, hi = args.ph_hi;
#ifndef PHASE_MASK
#define PHASE_MASK 0xffffffffu
#endif
#define IN(k) (((PHASE_MASK >> (k)) & 1u) && lo <= (k) && (k) < hi)

    for (int layer = args.layer_lo; layer < args.layer_hi; ++layer) {
        const int cv_total = layer + 1 < NL ? CV_ITEMS_ALL : CV_ITEMS;
        if (IN(PH_PRE) && layer == 0) {
            RELAUNDER();
            const int gt = F.vcu * (NWAVES * 64) + F.tid, NT = F.G * NWAVES * 64;
            for (int i = gt; i < SEQ * 128; i += NT) { const int pos = i >> 7, j = i & 127;
                const float inv = exp2f(-(float)j * (13.287712379549449f / 128.0f)); const float ang = (float)pos * inv;
                const double rev = (double)ang * 0.15915494309189535; const float fr = (float)(rev - __builtin_rint(rev));
                ropec[i] = __builtin_amdgcn_cosf(fr); ropes[i] = __builtin_amdgcn_sinf(fr); }
            for (int i = gt; i < SEQ * 2048 / 8; i += NT) { const int k = i >> 8, c8 = (i & 255) * 8; const int sn = k >> 11, kk = k & 2047;
                float v[8];
#pragma unroll
                for (int j = 0; j < 8; ++j) { const int mm = (kk * (c8 + j)) & 4095; const float fr = (float)mm * (1.0f / 4096.0f); v[j] = sn ? __builtin_amdgcn_sinf(fr) : __builtin_amdgcn_cosf(fr); }
                u32x4 w; w.x = cvt_pk_bf16(v[0], v[1]); w.y = cvt_pk_bf16(v[2], v[3]); w.z = cvt_pk_bf16(v[4], v[5]); w.w = cvt_pk_bf16(v[6], v[7]);
                *(u32x4*)(dft + (size_t)k * 2048 + c8) = w; }
            for (int row = F.gw; row < NB * MEMT; row += F.NGW) rms_row_to_bf16(mem + (size_t)row * D, mem_g, memn + (size_t)row * D, F.lane);
            for (int l = 0; l < NL; ++l) { colmax_pass(F, AIN(19) + (size_t)l * D * FFH, D, FFH, AIN(18) + (size_t)l * D, cmaxf + (size_t)l * 2 * FFH);
                colmax_pass(F, AIN(20) + (size_t)l * D * FFH, D, FFH, AIN(18) + (size_t)l * D, cmaxf + (size_t)l * 2 * FFH + FFH);
                if (l >= 1) colmax_pass(F, AIN(4) + (size_t)l * D * NPROJ, D, NPROJ, AIN(3) + (size_t)l * D, cminf + (size_t)l * NPROJ); }
            { const int gt2 = F.vcu * (NWAVES * 64) + F.tid; if (gt2 < NPROJ) cminf[gt2] = 127.0f; }
        }
        if (IN(PH_CONV) && layer == 0) {
            RELAUNDER();
            LAS unsigned* scr = (LAS unsigned*)(F.lds + F.wave * 16384);
            convert_matrix(F, AIN(4), D, NPROJ, W_in, 0, 0, scr, AIN(3), nullptr);
            { const int gt = F.vcu * (NWAVES * 64) + F.tid, NT = F.G * NWAVES * 64;
              for (int i = gt; i < NL * FG * 32 * 128; i += NT) { const int c = i & 127, d4 = (i >> 7) & 31, g = (i >> 12) & (FG - 1), l = i >> 15;
                  const float* fw = AIN(8) + (size_t)l * FG * FD * FD + (size_t)g * FD * FD + 4 * d4;
                  f32x4 ac = (f32x4){0.f, 0.f, 0.f, 0.f}, as = ac;
#pragma unroll 16
                  for (int cp = 0; cp < 128; ++cp) { const float fr = (float)((c * cp) & 127) * (1.0f / 128.0f); const f32x4 w = *(const f32x4*)(fw + cp * FD); ac = ac + w * __builtin_amdgcn_cosf(fr); as = as - w * __builtin_amdgcn_sinf(fr); }
                  bf16* fo = (bf16*)(wsp + (l == 0 ? WS_FWT : WS_FWT1)) + ((size_t)g * 256 + 4 * d4) * 128 + c;
#pragma unroll
                  for (int jd = 0; jd < 4; ++jd) { fo[jd * 128] = (bf16)(cvt_pk_bf16(ac[jd] * 0.0013810679320049757f, 0.f) & 0xffff); fo[128 * 128 + jd * 128] = (bf16)(cvt_pk_bf16(as[jd] * 0.0013810679320049757f, 0.f) & 0xffff); } } }
            x_to_stream(F, x_in, anorm, rsv);
            __syncthreads();
            GRID_BAR();
        }
        if (IN(PH_INPROJ)) {
            RELAUNDER();
            if (layer == 0) { pg8::Gemm g{anorm, W_in, M, NPROJ, D}; pg8::StaticOrder S; S.init(M, NPROJ, F.G, F.bid);
              pg8::EpiInProj E{proj, ropec, ropes, rsv, cminf};
              pg8::gemm_phase<pg8::EpiInProj, pg8::StaticOrder, PG8_ALIGN, PG8_SP2, false>(F.lds, g, S, E); }
            else { pg8::Gemm g{(const bf16*)hq, W_in, M, NPROJ, D}; pg8::StaticOrder S; S.init(M, NPROJ, F.G, F.bid);
              pg8::EpiInProj E{proj, ropec, ropes, rqv, cminf + (size_t)layer * NPROJ};
              pg8::gemm_phase<pg8::EpiInProj, pg8::StaticOrder, PG8_ALIGN, PG8_SP2, true>(F.lds, g, S, E); }
            GRID_BAR();
        }
        if (IN(PH_MIXA)) {
            RELAUNDER();
            const int bid = F.bid;
            unsigned* donew = cq + 64 * (layer * 2 + 1);
            if (bid < 128) ret_state_pass(F, bid, 128, proj, rst);
            else hgrn_state_pass(F, bid - 128, 128, proj, gatez, AIN(6), layer, hst);
            RELAUNDER();
            fourier_ut2(F, bid, proj, fwt, ut, nyq);
            { VM_WAIT(); __syncthreads(); if (F.tid == 0) __hip_atomic_fetch_add(donew, 1u, __ATOMIC_RELAXED, __HIP_MEMORY_SCOPE_AGENT); }
            conv_pull(F, args.in, layer, cq + 64 * (layer * 2 + 0), cv_total, cv_total, cd, MISC + 16, donew, 256u);
            GRID_BAR();
        }
        if (IN(PH_MIXB)) {
            RELAUNDER();
            const int bid = F.bid; const float* hng = AIN(7) + (size_t)layer * HW; const float* fbias = AIN(9) + (size_t)layer * FW;
            if (bid < 64) {
                pg8::Gemm g{dft, ut, SEQ, SEQ, 2048};
                { pg8::OneUnit S{bid >> 3, bid & 7}; pg8::EpiF32 E{(float*)(ws + WS_TMP), 2048};
                  pg8::gemm_phase<pg8::EpiF32, pg8::OneUnit, PG8_ALIGN, PG8_SP2>(F.lds, g, S, E); }
                RELAUNDER();
                { pg8::OneUnit S{8 + (bid >> 3), 8 + (bid & 7)}; pg8::EpiFourier2 E{mixin, fbias, nyq, (const float*)(ws + WS_TMP)};
                  pg8::gemm_phase<pg8::EpiFourier2, pg8::OneUnit, PG8_ALIGN, PG8_SP2>(F.lds, g, S, E); }
                RELAUNDER();
                hgrn_output_pass(F, 832 + bid, 64, 1024, proj, gatez, AIN(6), layer, hst, hng, mixin);
            } else {
                const int idx = bid - 64;
                if (idx < 64) fourier_mid_row(F, idx * NWAVES + F.wave, 64 * NWAVES, ut, nyq, fbias, mixin);
                ret_output_pass(F, idx, 192, proj, rst, AIN(5) + (size_t)layer * RW, mixin);
                if (idx < 128) hgrn_output_pass(F, idx, 128, 384, proj, gatez, AIN(6), layer, hst, hng, mixin);
                else hgrn_output_pass(F, 384 + (idx - 128), 64, 832, proj, gatez, AIN(6), layer, hst, hng, mixin);
            }
            conv_pull(F, args.in, layer, cq + 64 * (layer * 2 + 0), CV_P_ITEMS, cv_total, cd, MISC + 16, nullptr, 0u);
            GRID_BAR();
        }
        if (IN(PH_WOUT)) {
            RELAUNDER();
            pg8::Gemm g{mixin, W_out, M, D, D}; pg8::StaticOrder S; S.init(M, D, F.G, F.bid);
            pg8::EpiBf16 E{tmpb, D, 1.0f, nullptr};
            pg8::gemm_phase<pg8::EpiBf16, pg8::StaticOrder, PG8_ALIGN, PG8_SP2>(F.lds, g, S, E);
            GRID_BAR();
        }
        if (IN(PH_NORM1)) {
            RELAUNDER();
            norm_phase(F, tmpb, nullptr, anorm, nullptr, AIN(11) + (size_t)layer * D, rsv);
            GRID_BAR();
        }
        if (IN(PH_XQ)) {
            RELAUNDER();
            { pg8::Gemm g{anorm, W_q, M, XW, D}; pg8::StaticOrder S; S.init(M, XW, F.G, F.bid);
              pg8::EpiBf16 E{xq, XW, 0.0625f, rsv};
              pg8::gemm_phase<pg8::EpiBf16, pg8::StaticOrder, PG8_ALIGN, PG8_SP2>(F.lds, g, S, E); }
            { pg8::Gemm g{memn, W_kv, NB * MEMT, 2 * XW, D}; pg8::StaticOrder S; S.init(NB * MEMT, 2 * XW, F.G, F.bid - 128);
              pg8::EpiBf16 E{kvmem, 2 * XW, 1.0f, nullptr};
              pg8::gemm_phase<pg8::EpiBf16, pg8::StaticOrder, PG8_ALIGN, PG8_SP2>(F.lds, g, S, E); }
            { unsigned* donex = cq + 64 * (4 + layer);
              if (F.bid < 144) { VM_WAIT(); __syncthreads(); if (F.tid == 0) __hip_atomic_fetch_add(donex, 1u, __ATOMIC_RELAXED, __HIP_MEMORY_SCOPE_AGENT); }
              conv_pull(F, args.in, layer, cq + 64 * (layer * 2 + 0), cv_total, cv_total, cd, MISC + 16, donex, 144u); }
            GRID_BAR();
        }
        if (IN(PH_XATT)) {
            RELAUNDER();
            xattn_phase(F, xq, kvmem, xo);
            GRID_BAR();
        }
        if (IN(PH_XWO)) {
            RELAUNDER();
            pg8::Gemm g{xo, W_o, M, D, XW}; pg8::StaticOrder S; S.init(M, D, F.G, F.bid);
            pg8::EpiBf16 E{tmpb, D, 1.0f, nullptr};
            pg8::gemm_phase<pg8::EpiBf16, pg8::StaticOrder, PG8_ALIGN, PG8_SP2>(F.lds, g, S, E);
            GRID_BAR();
        }
        if (IN(PH_NORM2)) {
            RELAUNDER();
            norm_phase_q(F, tmpb, anorm, AIN(17) + (size_t)layer * D, hq, rqv, nullptr);
            conv_pull(F, args.in, layer, cq + 64 * (layer * 2 + 0), CV_ITEMS, cv_total, cd, MISC + 16, nullptr, 0u);
            GRID_BAR();
        }
        if (IN(PH_FFN1)) {
            RELAUNDER();
            pg8::Gemm g{(const bf16*)hq, W_gu, M, 2 * FFH, D}; pg8::StaticOrder S; S.init(M, 2 * FFH, F.G, F.bid);
            pg8::EpiSwiGluQ E{hid, FFH, rqv, cmaxf + (size_t)layer * 2 * FFH, cmaxf + (size_t)layer * 2 * FFH + FFH};
            pg8::gemm_phase<pg8::EpiSwiGluQ, pg8::StaticOrder, PG8_ALIGN, PG8_SP2, true>(F.lds, g, S, E);
            if (layer + 1 < NL) {
                unsigned* donef = cq + 64 * (8 + layer);
                VM_WAIT(); __syncthreads(); if (F.tid == 0) __hip_atomic_fetch_add(donef, 1u, __ATOMIC_RELAXED, __HIP_MEMORY_SCOPE_AGENT);
                conv_pull(F, args.in, layer, cq + 64 * (layer * 2 + 0), cv_total, cv_total, cd, MISC + 16, donef, (unsigned)F.G);
            }
            GRID_BAR();
        }
        if (IN(PH_FFN2)) {
            RELAUNDER();
            pg8::Gemm g{hid, W_dn, M, D, FFH}; pg8::StaticOrder S; S.init(M, D, F.G, F.bid);
            pg8::EpiBf16 E{tmpb, D, 1.0f, nullptr};
            pg8::gemm_phase<pg8::EpiBf16, pg8::StaticOrder, PG8_ALIGN, PG8_SP2>(F.lds, g, S, E);
            GRID_BAR();
        }
        if (IN(PH_NORM3)) {
            RELAUNDER();
            const bool more = layer + 1 < NL;
            if (more) norm_phase_q(F, tmpb, anorm, AIN(22) + (size_t)layer * D, hq, rqv, rsv);
            else norm_phase(F, tmpb, nullptr, anorm, hout, AIN(22) + (size_t)layer * D, nullptr);
            if (more) conv_pull(F, args.in, layer, cq + 64 * (layer * 2 + 0), cv_total, cv_total, cd, MISC + 16, nullptr, 0u);
            if (more) GRID_BAR();
        }
    }
#undef IN
#undef GRID_BAR
}

#undef x_in
#undef mem
#undef mem_g
#undef W_in
#undef W_out
#undef W_q
#undef W_kv
#undef W_o
#undef W_gu
#undef W_dn
#undef anorm
#undef proj
#undef hid
#undef gatez
#undef mixin
#undef tmpb
#undef rst
#undef hst
#undef dft
#undef ut
#undef xq
#undef xo
#undef kvmem
#undef memn
#undef ropec
#undef ropes
#undef fwt
#undef nyq
#undef rsv
#undef rqv
#undef hq
#undef cmaxf
#undef cminf
#undef hout
#undef cq
#undef cd
extern "C" void kernel_launch(void* const* d_in, const int* in_sizes, int n_in, void* d_out, int out_size, void* d_ws, size_t ws_size, hipStream_t stream) {
    static int grid = 0;
    if (grid == 0) {
        if (n_in != 23 || out_size != M * D || ws_size < WS_END) { fprintf(stderr, "kernel_launch: unexpected shapes (n_in %d, out %d, ws %zu < %zu)\n", n_in, out_size, ws_size, (size_t)WS_END); grid = -1; return; }
        int dev = 0, cus = 0, per_cu = 0;
        if (hipGetDevice(&dev) != hipSuccess || hipDeviceGetAttribute(&cus, hipDeviceAttributeMultiprocessorCount, dev) != hipSuccess) { grid = -1; return; }
        if (hipFuncSetAttribute((const void*)fwd_kernel, hipFuncAttributeMaxDynamicSharedMemorySize, LDS_BYTES) != hipSuccess) { fprintf(stderr, "kernel_launch: hipFuncSetAttribute failed\n"); grid = -1; return; }
        if (hipOccupancyMaxActiveBlocksPerMultiprocessor(&per_cu, (const void*)fwd_kernel, NWAVES * 64, LDS_BYTES) != hipSuccess || per_cu < 1) fprintf(stderr, "kernel_launch: occupancy query reports %d\n", per_cu);
        (void)hipGetLastError();
        grid = cus;
    }
    if (grid < 0) return;
    (void)in_sizes;
    if (hipMemsetAsync((char*)d_ws + WS_CTL, 0, CTL_ZERO_BYTES, stream) != hipSuccess) return;
    Args a{};
    for (int i = 0; i < 23; ++i) a.in[i] = (const float*)d_in[i];
    a.out = (float*)d_out; a.ws = (unsigned char*)d_ws; a.pad = 0;
#if ONE_LAUNCH
    a.layer_lo = 0; a.layer_hi = NL; a.ph_lo = 0; a.ph_hi = PH_COUNT; a.single = 1;
    hipLaunchKernelGGL(fwd_kernel, dim3(grid), dim3(NWAVES * 64), LDS_BYTES, stream, a);
#else
    a.single = 0;
    for (int layer = 0; layer < NL; ++layer)
        for (int ph = (layer == 0 ? PH_PRE : PH_CONV); ph < PH_COUNT; ++ph) {
            a.layer_lo = layer; a.layer_hi = layer + 1; a.ph_lo = ph; a.ph_hi = ph + 1;
            hipLaunchKernelGGL(fwd_kernel, dim3(grid), dim3(NWAVES * 64), LDS_BYTES, stream, a);
        }
#endif
}
```

```cpp
#include <hip/hip_runtime.h>
#include <cstdio>
#include <cstdint>

#ifndef ONE_LAUNCH
#define ONE_LAUNCH 1
#endif

#define LAS __attribute__((address_space(3)))
#define GAS __attribute__((address_space(1)))
typedef unsigned short bf16;
typedef short bf16x8 __attribute__((ext_vector_type(8)));
typedef float f32x4 __attribute__((ext_vector_type(4)));
typedef float f32x2 __attribute__((ext_vector_type(2)));
typedef unsigned u32x4 __attribute__((ext_vector_type(4)));
typedef unsigned u32x2 __attribute__((ext_vector_type(2)));
typedef int i32x4 __attribute__((ext_vector_type(4)));

constexpr int D = 4096, NB = 2, SEQ = 4096, NL = 2, M = NB * SEQ;
constexpr int RW = 2048, RH = 8, RD = 256;
constexpr int HW = 1024, HH = 8, HD = 128;
constexpr int FW = 1024, FG = 8, FD = 128;
constexpr int NPROJ = 14336;
constexpr int XW = 1024, XH = 4, XD = 256, MEMT = 256;
constexpr int FFH = 11008;
constexpr int C_RQ = 0, C_RK = 2048, C_RV = 4096, C_RG = 6144, C_HQ = 8192, C_HFF = 9216, C_HFB = 10240, C_HI = 11264, C_HG = 12288, C_FZ = 13312;
constexpr float RMS_EPS = 1e-6f, GN_EPS = 1e-5f;

constexpr size_t MiB = 1u << 20;
constexpr size_t WS_CTL = 0, CTL_ZERO_BYTES = 1 * MiB;
constexpr size_t WS_WIN = 1 * MiB;
constexpr size_t WS_WOUT = 113 * MiB;
constexpr size_t WS_WQ = 145 * MiB;
constexpr size_t WS_WKV = 153 * MiB;
constexpr size_t WS_WO = 169 * MiB;
constexpr size_t WS_WGU = 177 * MiB;
constexpr size_t WS_WDN = 349 * MiB;
constexpr size_t WS_ANORM = 435 * MiB;
constexpr size_t WS_PROJ = 499 * MiB;
constexpr size_t WS_GATEZ = 723 * MiB;
constexpr size_t WS_MIXIN = 787 * MiB;
constexpr size_t WS_TMP = 851 * MiB;
constexpr size_t WS_SCR = 979 * MiB;
constexpr size_t WS_DFT = 1171 * MiB;
constexpr size_t WS_UT = 1235 * MiB;
constexpr size_t WS_XQ = 1267 * MiB;
constexpr size_t WS_XO = 1283 * MiB;
constexpr size_t WS_KVMEM = 1299 * MiB;
constexpr size_t WS_MEMN = 1301 * MiB;
constexpr size_t WS_ROPE = 1305 * MiB;
constexpr size_t WS_FWT = 1309 * MiB;
constexpr size_t WS_FWT1 = 1310 * MiB;
constexpr size_t WS_END = 1311 * MiB;
constexpr int CW_BAR = 4096, CW_CONVQ = 8192;

constexpr int LDS_BYTES = 147456;
constexpr int LDSCTL_OFF = LDS_BYTES - 512, MISC_OFF = LDSCTL_OFF + 320;
constexpr int NWAVES = 8;

typedef __bf16 bf16x2_t __attribute__((ext_vector_type(2)));
__device__ __forceinline__ unsigned cvt_pk_bf16(float lo, float hi) { const f32x2 v = {lo, hi}; return __builtin_bit_cast(unsigned, __builtin_convertvector(v, bf16x2_t)); }
__device__ __forceinline__ float bf2f(unsigned b) { return __uint_as_float(b << 16); }
__device__ __forceinline__ float bflo(unsigned w) { return __uint_as_float(w << 16); }
__device__ __forceinline__ float bfhi(unsigned w) { return __uint_as_float(w & 0xffff0000u); }
__device__ __forceinline__ float wave_sum(float v) {
#pragma unroll
    for (int o = 1; o < 64; o <<= 1) v += __shfl_xor(v, o);
    return v;
}
__device__ __forceinline__ float fast_sigmoid(float x) { return __builtin_amdgcn_rcpf(1.0f + __expf(-x)); }
__device__ __forceinline__ float silu_f(float x) { return x * fast_sigmoid(x); }
#define LDS_WAIT() asm volatile("s_waitcnt lgkmcnt(0)" ::: "memory")
#define VM_WAIT() asm volatile("s_waitcnt vmcnt(0)" ::: "memory")

namespace pg8 {
constexpr int BM = 256, BK = 64, HALF = 128, HTB = HALF * BK * 2, STAGE_BYTES = 8 * HTB, NXCD = 8, WGM = 8;
__host__ __device__ __forceinline__ int lds_byte(int r, int c) { const int st = (r >> 4) * 2 + (c >> 5), rr = r & 15, cc = c & 31, ob = rr * 64 + cc * 2; return st * 1024 + (ob ^ (((ob >> 9) & 1) << 5)); }
__host__ __device__ __forceinline__ void stage_rc(int b, int& R, int& C) { const int st = b / 1024, sb = b % 1024, swz = sb ^ (((sb >> 9) & 1) << 5); R = (st >> 1) * 16 + swz / 64; C = (st & 1) * 32 + (swz % 64) / 2; }
__host__ __device__ __forceinline__ int perm32(int rho) { const int n = rho >> 4, i = rho & 15; return 8 * (i >> 2) + 4 * n + (i & 3); }
struct Unit { int pm, pn; };
struct Gemm { const bf16* A; const bf16* Bt; int M, N, K; };
struct StaticOrder {
    int nM, nN, nwg, G, c;
    __host__ __device__ void init(int M_, int N_, int G_, int c_) { nM = M_ / BM; nN = N_ / BM; nwg = nM * nN; G = G_; c = c_; }
    __host__ __device__ bool next(int i, Unit& u) const {
        if (c < 0) return false;
        const long Lx = (long)i * G + c; if (Lx >= nwg) return false;
        int wgid = (int)Lx; { const int q = nwg / NXCD, r = nwg % NXCD, xcd = wgid % NXCD, off = wgid / NXCD; wgid = (xcd < r ? xcd * (q + 1) : r * (q + 1) + (xcd - r) * q) + off; }
        const int nig = WGM * nN, gid = wgid / nig, fm = gid * WGM, gsz = (nM - fm) < WGM ? (nM - fm) : WGM;
        u.pm = fm + ((wgid % nig) % gsz); u.pn = (wgid % nig) / gsz; return true;
    }
    __device__ __forceinline__ void a_ready(const Unit&) const {}
    __device__ __forceinline__ void done(const Unit&) const {}
};

struct EpiF32 {
    static constexpr bool PERM = false;
    static constexpr int NSCALE = 0; __device__ __forceinline__ const float* scale_ptr(const Unit&, int) const { return nullptr; }
    float* C; int ldc;
    __device__ __forceinline__ void operator()(const f32x4 (&acc)[2][2][4][2], const Unit& u, int wr, int wc, int fr, int fq, const LAS float* sl) const {
        const int row0 = u.pm * BM + wr * 64 + fr, col0 = u.pn * BM + wc * 32 + 4 * fq;
#pragma unroll
        for (int ai = 0; ai < 2; ++ai)
#pragma unroll
            for (int m = 0; m < 4; ++m) { float* rowp = C + (size_t)(row0 + ai * HALF + m * 16) * ldc + col0;
#pragma unroll
                for (int bj = 0; bj < 2; ++bj)
#pragma unroll
                    for (int n = 0; n < 2; ++n) *(f32x4*)(rowp + bj * HALF + n * 16) = acc[ai][bj][m][n]; }
    }
};
struct EpiBf16 {
    static constexpr bool PERM = true;
    static constexpr int NSCALE = 1;
    __device__ __forceinline__ const float* scale_ptr(const Unit& u, int) const { return rs ? rs + u.pm * BM : nullptr; }
    bf16* O; int ldc; float scale; const float* rs;
    __device__ __forceinline__ void operator()(const f32x4 (&acc)[2][2][4][2], const Unit& u, int wr, int wc, int fr, int fq, const LAS float* sl) const {
        const int row0 = u.pm * BM + wr * 64 + fr, col0 = u.pn * BM + wc * 32 + 8 * fq;
        float scv[2][4];
#pragma unroll
        for (int ai = 0; ai < 2; ++ai)
#pragma unroll
            for (int m = 0; m < 4; ++m) scv[ai][m] = rs ? scale * sl[wr * 64 + fr + ai * HALF + m * 16] : scale;
        asm volatile("" ::: "memory");
#pragma unroll
        for (int ai = 0; ai < 2; ++ai)
#pragma unroll
            for (int m = 0; m < 4; ++m) { bf16* rowp = O + (size_t)(row0 + ai * HALF + m * 16) * ldc + col0; const float sc = scv[ai][m];
#pragma unroll
                for (int bj = 0; bj < 2; ++bj) { const f32x4 v0 = acc[ai][bj][m][0] * sc, v1 = acc[ai][bj][m][1] * sc;
                    u32x4 w; w.x = cvt_pk_bf16(v0[0], v0[1]); w.y = cvt_pk_bf16(v0[2], v0[3]); w.z = cvt_pk_bf16(v1[0], v1[1]); w.w = cvt_pk_bf16(v1[2], v1[3]);
                    *(u32x4*)(rowp + bj * HALF) = w; } }
    }
};
struct EpiInProj {
    static constexpr bool PERM = true;
    static constexpr int NSCALE = 2;
    __device__ __forceinline__ const float* scale_ptr(const Unit& u, int k) const { return k == 0 ? rs + u.pm * BM : cm + u.pn * BM; }
    bf16* proj; const float* ropec; const float* ropes; const float* rs; const float* cm;
    __device__ __forceinline__ void operator()(const f32x4 (&acc)[2][2][4][2], const Unit& u, int wr, int wc, int fr, int fq, const LAS float* sl) const {
        const int row0 = u.pm * BM + wr * 64 + fr, colw = wc * 32 + 8 * fq;
        const LAS float* cp = sl + 256 + colw;
        const f32x4 ca0 = *(const LAS f32x4*)(cp) * (1.0f / 127.0f), ca1 = *(const LAS f32x4*)(cp + 4) * (1.0f / 127.0f), cb0 = *(const LAS f32x4*)(cp + HALF) * (1.0f / 127.0f), cb1 = *(const LAS f32x4*)(cp + HALF + 4) * (1.0f / 127.0f);
        float rsl[2][4];
#pragma unroll
        for (int ai = 0; ai < 2; ++ai)
#pragma unroll
            for (int m = 0; m < 4; ++m) rsl[ai][m] = sl[wr * 64 + fr + ai * HALF + m * 16];
        if (u.pn < 16) {
            const float sc0 = u.pn < 8 ? 0.0625f : 1.0f;
            const f32x4 C0 = *(const f32x4*)(ropec + 16 * 128 + colw), C1 = *(const f32x4*)(ropec + 16 * 128 + colw + 4), S0 = *(const f32x4*)(ropes + 16 * 128 + colw), S1 = *(const f32x4*)(ropes + 16 * 128 + colw + 4);
            f32x4 cc0[2], cc1[2], ss0[2], ss1[2];
#pragma unroll
            for (int ai = 0; ai < 2; ++ai) { const int pos0 = (row0 + ai * HALF) & (SEQ - 1);
                cc0[ai] = *(const f32x4*)(ropec + pos0 * 128 + colw); cc1[ai] = *(const f32x4*)(ropec + pos0 * 128 + colw + 4);
                ss0[ai] = *(const f32x4*)(ropes + pos0 * 128 + colw); ss1[ai] = *(const f32x4*)(ropes + pos0 * 128 + colw + 4); }
            asm volatile("" ::: "memory");
#pragma unroll
            for (int ai = 0; ai < 2; ++ai) {
                f32x4 c0 = cc0[ai], c1 = cc1[ai], s0 = ss0[ai], s1 = ss1[ai];
#pragma unroll
                for (int m = 0; m < 4; ++m) { const int r = row0 + ai * HALF + m * 16; const float sc = sc0 * rsl[ai][m];
                    if (m) { const f32x4 n0 = c0 * C0 - s0 * S0, n1 = c1 * C1 - s1 * S1; s0 = s0 * C0 + c0 * S0; s1 = s1 * C1 + c1 * S1; c0 = n0; c1 = n1; }
                    const f32x4 a0 = acc[ai][0][m][0] * ca0, a1 = acc[ai][0][m][1] * ca1, b0 = acc[ai][1][m][0] * cb0, b1 = acc[ai][1][m][1] * cb1;
                    const f32x4 o10 = (a0 * c0 - b0 * s0) * sc, o11 = (a1 * c1 - b1 * s1) * sc, o20 = (a0 * s0 + b0 * c0) * sc, o21 = (a1 * s1 + b1 * c1) * sc;
                    bf16* rowp = proj + (size_t)r * NPROJ + u.pn * BM + colw;
                    u32x4 w; w.x = cvt_pk_bf16(o10[0], o10[1]); w.y = cvt_pk_bf16(o10[2], o10[3]); w.z = cvt_pk_bf16(o11[0], o11[1]); w.w = cvt_pk_bf16(o11[2], o11[3]);
                    *(u32x4*)(rowp) = w;
                    w.x = cvt_pk_bf16(o20[0], o20[1]); w.y = cvt_pk_bf16(o20[2], o20[3]); w.z = cvt_pk_bf16(o21[0], o21[1]); w.w = cvt_pk_bf16(o21[2], o21[3]);
                    *(u32x4*)(rowp + HALF) = w; } }
        } else {
            asm volatile("" ::: "memory");
#pragma unroll
            for (int ai = 0; ai < 2; ++ai)
#pragma unroll
                for (int m = 0; m < 4; ++m) { bf16* rowp = proj + (size_t)(row0 + ai * HALF + m * 16) * NPROJ + u.pn * BM + colw; const float sc = rsl[ai][m];
                    { const f32x4 v0 = acc[ai][0][m][0] * ca0 * sc, v1 = acc[ai][0][m][1] * ca1 * sc;
                      u32x4 w; w.x = cvt_pk_bf16(v0[0], v0[1]); w.y = cvt_pk_bf16(v0[2], v0[3]); w.z = cvt_pk_bf16(v1[0], v1[1]); w.w = cvt_pk_bf16(v1[2], v1[3]); *(u32x4*)(rowp) = w; }
                    { const f32x4 v0 = acc[ai][1][m][0] * cb0 * sc, v1 = acc[ai][1][m][1] * cb1 * sc;
                      u32x4 w; w.x = cvt_pk_bf16(v0[0], v0[1]); w.y = cvt_pk_bf16(v0[2], v0[3]); w.z = cvt_pk_bf16(v1[0], v1[1]); w.w = cvt_pk_bf16(v1[2], v1[3]); *(u32x4*)(rowp + HALF) = w; } }
        }
    }
};
struct EpiSwiGlu {
    static constexpr bool PERM = true;
    static constexpr int NSCALE = 0; __device__ __forceinline__ const float* scale_ptr(const Unit&, int) const { return nullptr; }
    bf16* H; int ldc; const float* rs;
    __device__ __forceinline__ void operator()(const f32x4 (&acc)[2][2][4][2], const Unit& u, int wr, int wc, int fr, int fq, const LAS float* sl) const {
        const int row0 = u.pm * BM + wr * 64 + fr, col0 = u.pn * HALF + wc * 32 + 8 * fq;
#pragma unroll
        for (int ai = 0; ai < 2; ++ai)
#pragma unroll
            for (int m = 0; m < 4; ++m) { bf16* rowp = H + (size_t)(row0 + ai * HALF + m * 16) * ldc + col0; const float sc = rs[row0 + ai * HALF + m * 16];
                f32x4 v0, v1;
#pragma unroll
                for (int j = 0; j < 4; ++j) { v0[j] = silu_f(acc[ai][0][m][0][j] * sc) * (acc[ai][1][m][0][j] * sc); v1[j] = silu_f(acc[ai][0][m][1][j] * sc) * (acc[ai][1][m][1][j] * sc); }
                u32x4 w; w.x = cvt_pk_bf16(v0[0], v0[1]); w.y = cvt_pk_bf16(v0[2], v0[3]); w.z = cvt_pk_bf16(v1[0], v1[1]); w.w = cvt_pk_bf16(v1[2], v1[3]);
                *(u32x4*)(rowp) = w; }
    }
};
struct EpiSwiGluQ {
    static constexpr bool PERM = true;
    static constexpr int NSCALE = 3;
    __device__ __forceinline__ const float* scale_ptr(const Unit& u, int k) const { return k == 0 ? rq + u.pm * BM : (k == 1 ? cmg : cmu) + u.pn * HALF; }
    bf16* H; int ldc; const float* rq; const float* cmg; const float* cmu;
    __device__ __forceinline__ void operator()(const f32x4 (&acc)[2][2][4][2], const Unit& u, int wr, int wc, int fr, int fq, const LAS float* sl) const {
        const int row0 = u.pm * BM + wr * 64 + fr, col0 = u.pn * HALF + wc * 32 + 8 * fq;
        const int cl = wc * 32 + 8 * fq;
        const f32x4 sg0 = *(const LAS f32x4*)(sl + 256 + cl) * (1.0f / 127.0f), sg1 = *(const LAS f32x4*)(sl + 256 + cl + 4) * (1.0f / 127.0f);
        const f32x4 su0 = *(const LAS f32x4*)(sl + 512 + cl) * (1.0f / 127.0f), su1 = *(const LAS f32x4*)(sl + 512 + cl + 4) * (1.0f / 127.0f);
        float rql[2][4];
#pragma unroll
        for (int ai = 0; ai < 2; ++ai)
#pragma unroll
            for (int m = 0; m < 4; ++m) rql[ai][m] = sl[wr * 64 + fr + ai * HALF + m * 16];
        asm volatile("" ::: "memory");
#pragma unroll
        for (int ai = 0; ai < 2; ++ai)
#pragma unroll
            for (int m = 0; m < 4; ++m) { bf16* rowp = H + (size_t)(row0 + ai * HALF + m * 16) * ldc + col0; const float sc = rql[ai][m];
                f32x4 v0, v1;
#pragma unroll
                for (int j = 0; j < 4; ++j) { v0[j] = silu_f(acc[ai][0][m][0][j] * (sc * sg0[j])) * (acc[ai][1][m][0][j] * (sc * su0[j])); v1[j] = silu_f(acc[ai][0][m][1][j] * (sc * sg1[j])) * (acc[ai][1][m][1][j] * (sc * su1[j])); }
                u32x4 w; w.x = cvt_pk_bf16(v0[0], v0[1]); w.y = cvt_pk_bf16(v0[2], v0[3]); w.z = cvt_pk_bf16(v1[0], v1[1]); w.w = cvt_pk_bf16(v1[2], v1[3]);
                *(u32x4*)(rowp) = w; }
    }
};
struct SkipOrder : StaticOrder {
    int skip0, nskip;
    __device__ __forceinline__ bool next(int i, Unit& u) const { if (!StaticOrder::next(i, u)) return false; if (u.pn >= skip0) u.pn += nskip; return true; }
};
struct OneUnit {
    int pm, pn;
    __device__ __forceinline__ bool next(int i, Unit& u) const { if (pm < 0 || i > 0) return false; u.pm = pm; u.pn = pn; return true; }
    __device__ __forceinline__ void a_ready(const Unit&) const {}
    __device__ __forceinline__ void done(const Unit&) const {}
};
struct EpiFourier2 {
    static constexpr bool PERM = false;
    bf16* O; const float* bias; const float* nyq; const float* fa;
    static constexpr int NSCALE = 0; __device__ __forceinline__ const float* scale_ptr(const Unit&, int) const { return nullptr; }
    __device__ __forceinline__ void operator()(const f32x4 (&acc)[2][2][4][2], const Unit& u, int wr, int wc, int fr, int fq, const LAS float* sl) const {
        const int krow0 = (u.pm - 8) * BM + wr * 64 + fr, cbase = (u.pn - 8) * BM + wc * 32 + 4 * fq, b = cbase >> 10, colm0 = cbase & 1023;
#pragma unroll
        for (int ai = 0; ai < 2; ++ai)
#pragma unroll
            for (int m = 0; m < 4; ++m) { const int k = krow0 + ai * HALF + m * 16; const float sg = (k & 1) ? -1.0f : 1.0f;
                const float* ap = fa + (size_t)k * 2048 + cbase;
                bf16* row1 = O + (size_t)(b * SEQ + k) * D + 3072 + colm0; bf16* row2 = O + (size_t)(b * SEQ + ((SEQ - k) & (SEQ - 1))) * D + 3072 + colm0;
#pragma unroll
                for (int bj = 0; bj < 2; ++bj)
#pragma unroll
                    for (int n = 0; n < 2; ++n) { const int off = bj * HALF + n * 16;
                        const f32x4 av = *(const f32x4*)(ap + off); const f32x4 e = *(const f32x4*)(nyq + cbase + off) * sg + *(const f32x4*)(bias + colm0 + off); const f32x4 bv = acc[ai][bj][m][n];
                        const f32x4 p = av + bv + e, qv = av - bv + e;
                        u32x2 w; w.x = cvt_pk_bf16(p[0], p[1]); w.y = cvt_pk_bf16(p[2], p[3]); *(u32x2*)(row1 + off) = w;
                        if (k != 0) { w.x = cvt_pk_bf16(qv[0], qv[1]); w.y = cvt_pk_bf16(qv[2], qv[3]); *(u32x2*)(row2 + off) = w; } }
                asm volatile("" ::: "memory"); }
    }
};

template <class Epi, class Sched, bool ALIGN_EPI = false, bool SP2 = false, bool I8 = false>
__device__ __forceinline__ void gemm_phase(LAS unsigned char* lds, const Gemm g, const Sched& S, const Epi& E) {
    int tid_ = threadIdx.x; asm volatile("" : "+v"(tid_));
    const int tid = tid_, wid = __builtin_amdgcn_readfirstlane(tid >> 6), lane = tid & 63, wr = wid >> 2, wc = wid & 3, fr = lane & 15, fq = lane >> 4;
    const int KB = I8 ? g.K : 2 * g.K, nt = KB / (BK * 2);
    unsigned voffA[2], voffB[2];
#pragma unroll
    for (int i = 0; i < 2; ++i) { int R, C; stage_rc(tid * 16 + i * 8192, R, C); const int Rb = Epi::PERM ? ((R & ~31) + perm32(R & 31)) : R;
        voffA[i] = (unsigned)(R * KB + 2 * C); voffB[i] = (unsigned)(Rb * KB + 2 * C); }
    const size_t kstep = (size_t)(BK * 2);
    const size_t hstep = (size_t)HALF * KB;
    const size_t tstep = 2 * hstep;
    const unsigned ldsw = (unsigned)wid * 1024u;
    const int aoff = lds_byte(wr * 64 + fr, fq * 8), boff = lds_byte(wc * 32 + fr, fq * 8);
#define PG8_SA(b, h) (((b) * 2 + (h)) * HTB)
#define PG8_SB(b, h) ((4 + (b) * 2 + (h)) * HTB)
#define PG8_STAGE(bufoff, gbase, voff) do { _Pragma("unroll") for (int _i = 0; _i < 2; ++_i) \
        __builtin_amdgcn_global_load_lds((const unsigned*)((const char*)(gbase) + (voff)[_i]), (LAS unsigned*)(lds + (bufoff) + ldsw + _i * 8192), 16, 0, 0); } while (0)
#define PG8_LDA(dst, b, h) do { _Pragma("unroll") for (int m = 0; m < 4; ++m) _Pragma("unroll") for (int k = 0; k < 2; ++k) dst[m][k] = *(const LAS bf16x8*)(lds + PG8_SA(b, h) + aoff + m * 2048 + k * 1024); } while (0)
#define PG8_LDB(dst, b, h) do { _Pragma("unroll") for (int n = 0; n < 2; ++n) _Pragma("unroll") for (int k = 0; k < 2; ++k) dst[n][k] = *(const LAS bf16x8*)(lds + PG8_SB(b, h) + boff + n * 2048 + k * 1024); } while (0)
#define PG8_MMA(ai, bj, At, Bt) do { __builtin_amdgcn_s_setprio(1); _Pragma("unroll") for (int m = 0; m < 4; ++m) _Pragma("unroll") for (int n = 0; n < 2; ++n) _Pragma("unroll") for (int k = 0; k < 2; ++k) { \
        if constexpr (I8) acc[ai][bj][m][n] = __builtin_bit_cast(f32x4, __builtin_amdgcn_mfma_i32_16x16x64_i8(__builtin_bit_cast(i32x4, Bt[n][k]), __builtin_bit_cast(i32x4, At[m][k]), __builtin_bit_cast(i32x4, acc[ai][bj][m][n]), 0, 0, 0)); \
        else acc[ai][bj][m][n] = __builtin_amdgcn_mfma_f32_16x16x32_bf16(Bt[n][k], At[m][k], acc[ai][bj][m][n], 0, 0, 0); } __builtin_amdgcn_s_setprio(0); } while (0)
#define PG8_WAIT_V(n) asm volatile("s_waitcnt vmcnt(" #n ")" ::: "memory")
#define PG8_WAIT_L(n) asm volatile("s_waitcnt lgkmcnt(" #n ")" ::: "memory")
#define PG8_BAR __builtin_amdgcn_s_barrier()
#define PG8_SCHED __builtin_amdgcn_sched_barrier(0)
    Unit cur, nxt; int ui = 0;
    if (!S.next(0, cur)) return;
#define PG8_SCALES(unit, par) do { if constexpr (Epi::NSCALE > 0) { if (wid < Epi::NSCALE) { const float* gp_ = E.scale_ptr(unit, wid); \
        if (gp_) __builtin_amdgcn_global_load_lds((const unsigned*)(gp_ + 4 * lane), (LAS unsigned*)(lds + 8 * HTB + (par) * 3072 + wid * 1024), 16, 0, 0); } } } while (0)
    PG8_SCALES(cur, 0);
    f32x4 acc[2][2][4][2];
#pragma unroll
    for (int a = 0; a < 2; ++a)
#pragma unroll
        for (int b = 0; b < 2; ++b)
#pragma unroll
            for (int m = 0; m < 4; ++m)
#pragma unroll
                for (int n = 0; n < 2; ++n) acc[a][b][m][n] = (f32x4){0.f, 0.f, 0.f, 0.f};
    bf16x8 At[4][2], B0[2][2], B1[2][2];
    const char* cA = (const char*)g.A + (size_t)cur.pm * tstep; const char* cB = (const char*)g.Bt + (size_t)cur.pn * tstep;
    S.a_ready(cur);
    if constexpr (SP2) {
        PG8_STAGE(PG8_SB(0, 0), cB, voffB); PG8_STAGE(PG8_SB(0, 1), cB + hstep, voffB); PG8_STAGE(PG8_SA(0, 0), cA, voffA); PG8_STAGE(PG8_SA(0, 1), cA + hstep, voffA);
        if (wr == 1) PG8_BAR;
        PG8_WAIT_V(2); PG8_BAR;
        PG8_STAGE(PG8_SB(1, 0), cB + kstep, voffB); PG8_STAGE(PG8_SA(1, 0), cA + kstep, voffA); PG8_STAGE(PG8_SB(1, 1), cB + hstep + kstep, voffB);
        PG8_WAIT_V(6); PG8_BAR;
    } else {
        PG8_STAGE(PG8_SB(0, 0), cB, voffB); PG8_STAGE(PG8_SA(0, 0), cA, voffA); PG8_STAGE(PG8_SB(0, 1), cB + hstep, voffB); PG8_STAGE(PG8_SA(0, 1), cA + hstep, voffA);
        if (wr == 1) PG8_BAR;
        PG8_WAIT_V(4); PG8_BAR;
        PG8_STAGE(PG8_SB(1, 0), cB + kstep, voffB); PG8_STAGE(PG8_SA(1, 0), cA + kstep, voffA); PG8_STAGE(PG8_SB(1, 1), cB + hstep + kstep, voffB);
        PG8_WAIT_V(6); PG8_BAR;
    }
    for (;;) {
        const bool has_next = S.next(ui + 1, nxt);
        const char* nA = has_next ? (const char*)g.A + (size_t)nxt.pm * tstep : cA; const char* nB = has_next ? (const char*)g.Bt + (size_t)nxt.pn * tstep : cB;
        for (int t = 0; t < nt; t += 2) {
            const bool last = (t == nt - 2);
            const char* a1 = cA + (size_t)(t + 1) * kstep;
            const char* a2 = last ? nA : cA + (size_t)(t + 2) * kstep; const char* b2 = last ? nB : cB + (size_t)(t + 2) * kstep;
            const char* a3 = a2 + kstep; const char* b3 = b2 + kstep;
            if (last && has_next) { S.a_ready(nxt); PG8_SCALES(nxt, (ui + 1) & 1); }
            if constexpr (SP2) {
            PG8_LDB(B0, 0, 0); PG8_LDB(B1, 0, 1); PG8_SCHED; PG8_LDA(At, 0, 0); PG8_STAGE(PG8_SA(1, 1), a1 + hstep, voffA);
            PG8_WAIT_V(8); PG8_WAIT_L(0); PG8_BAR; PG8_MMA(0, 0, At, B0); PG8_MMA(0, 1, At, B1); PG8_BAR; PG8_SCHED;
            PG8_LDA(At, 0, 1); PG8_STAGE(PG8_SB(0, 0), b2, voffB); PG8_STAGE(PG8_SB(0, 1), b2 + hstep, voffB); PG8_STAGE(PG8_SA(0, 0), a2, voffA);
            PG8_WAIT_V(8); PG8_WAIT_L(0); PG8_BAR; PG8_MMA(1, 0, At, B0); PG8_MMA(1, 1, At, B1); PG8_BAR; PG8_SCHED;
            PG8_LDB(B0, 1, 0); PG8_LDB(B1, 1, 1); PG8_SCHED; PG8_LDA(At, 1, 0); PG8_STAGE(PG8_SA(0, 1), a2 + hstep, voffA);
            PG8_WAIT_V(8); PG8_WAIT_L(0); PG8_BAR; PG8_MMA(0, 0, At, B0); PG8_MMA(0, 1, At, B1); PG8_BAR; PG8_SCHED;
            PG8_LDA(At, 1, 1); PG8_STAGE(PG8_SB(1, 0), b3, voffB); PG8_STAGE(PG8_SB(1, 1), b3 + hstep, voffB); PG8_STAGE(PG8_SA(1, 0), a3, voffA);
            PG8_WAIT_V(8); PG8_WAIT_L(0); PG8_BAR; PG8_MMA(1, 0, At, B0); PG8_MMA(1, 1, At, B1); PG8_BAR; PG8_SCHED;
            } else {
            PG8_LDB(B0, 0, 0); PG8_SCHED; PG8_LDA(At, 0, 0); PG8_STAGE(PG8_SA(1, 1), a1 + hstep, voffA);
            PG8_WAIT_L(8); PG8_BAR; PG8_WAIT_L(0); PG8_MMA(0, 0, At, B0); PG8_BAR; PG8_SCHED;
            PG8_LDB(B1, 0, 1); PG8_STAGE(PG8_SB(0, 0), b2, voffB);
            PG8_BAR; PG8_WAIT_L(0); PG8_MMA(0, 1, At, B1); PG8_BAR;
            PG8_LDA(At, 0, 1); PG8_STAGE(PG8_SA(0, 0), a2, voffA);
            PG8_BAR; PG8_WAIT_L(0); PG8_MMA(1, 0, At, B0); PG8_BAR; PG8_SCHED;
            PG8_STAGE(PG8_SB(0, 1), b2 + hstep, voffB);
            PG8_WAIT_V(6); PG8_BAR; PG8_MMA(1, 1, At, B1); PG8_BAR;
            PG8_LDB(B0, 1, 0); PG8_SCHED; PG8_LDA(At, 1, 0); PG8_STAGE(PG8_SA(0, 1), a2 + hstep, voffA);
            PG8_WAIT_L(8); PG8_BAR; PG8_WAIT_L(0); PG8_MMA(0, 0, At, B0); PG8_BAR; PG8_SCHED;
            PG8_LDB(B1, 1, 1); PG8_STAGE(PG8_SB(1, 0), b3, voffB);
            PG8_BAR; PG8_WAIT_L(0); PG8_MMA(0, 1, At, B1); PG8_BAR;
            PG8_LDA(At, 1, 1); PG8_STAGE(PG8_SA(1, 0), a3, voffA);
            PG8_BAR; PG8_WAIT_L(0); PG8_MMA(1, 0, At, B0); PG8_BAR; PG8_SCHED;
            PG8_STAGE(PG8_SB(1, 1), b3 + hstep, voffB);
            PG8_WAIT_V(6); PG8_BAR; PG8_MMA(1, 1, At, B1); PG8_BAR;
            }
        }
        if constexpr (ALIGN_EPI) { if (wr == 0) PG8_BAR; }
        if constexpr (I8) {
#pragma unroll
            for (int a = 0; a < 2; ++a)
#pragma unroll
                for (int b = 0; b < 2; ++b)
#pragma unroll
                    for (int m = 0; m < 4; ++m)
#pragma unroll
                        for (int n = 0; n < 2; ++n) acc[a][b][m][n] = __builtin_convertvector(__builtin_bit_cast(i32x4, acc[a][b][m][n]), f32x4); }
        E(acc, cur, wr, wc, fr, fq, (const LAS float*)(lds + 8 * HTB + (ui & 1) * 3072)); S.done(cur);
        if (!has_next) break;
#pragma unroll
        for (int a = 0; a < 2; ++a)
#pragma unroll
            for (int b = 0; b < 2; ++b)
#pragma unroll
                for (int m = 0; m < 4; ++m)
#pragma unroll
                    for (int n = 0; n < 2; ++n) acc[a][b][m][n] = (f32x4){0.f, 0.f, 0.f, 0.f};
        cur = nxt; cA = nA; cB = nB; ++ui;
        if constexpr (ALIGN_EPI) { if (wr == 1) PG8_BAR; }
    }
    PG8_WAIT_V(0);
    if constexpr (!ALIGN_EPI) { if (wr == 0) PG8_BAR; }
    PG8_BAR;
#undef PG8_SCALES
#undef PG8_SA
#undef PG8_SB
#undef PG8_STAGE
#undef PG8_LDA
#undef PG8_LDB
#undef PG8_MMA
#undef PG8_WAIT_V
#undef PG8_WAIT_L
#undef PG8_BAR
#undef PG8_SCHED
}
}
#define PG8_SP2 true
#define PG8_ALIGN true

#define XB_TMO      128
#define XB_XCNT(j)  (256  + 64 * (j))
#define XB_XSUB(j)  (1280 + 64 * (j))
#define XB_XGEN(j)  (2304 + 64 * (j))
#define XB_TOP      3328
#define XB_TOPGEN   3392
#define XCD_BAR_WORDS 3456
#define XB_SPIN_CAP (1u << 18)
__device__ __forceinline__ unsigned xb_ld(unsigned* p)              { return __hip_atomic_load(p, __ATOMIC_RELAXED, __HIP_MEMORY_SCOPE_AGENT); }
__device__ __forceinline__ unsigned xb_add(unsigned* p, unsigned v) { return __hip_atomic_fetch_add(p, v, __ATOMIC_RELAXED, __HIP_MEMORY_SCOPE_AGENT); }
__device__ __forceinline__ unsigned xb_xcc_id() { return (unsigned)__builtin_amdgcn_s_getreg((3 << 11) | 20) & 0xFu; }
#define XB_SPIN(cond, bar) do { unsigned _sp = 0; while (cond) { __builtin_amdgcn_s_sleep(1); \
    if ((++_sp & 255u) == 0u) { if (xb_ld(&(bar)[XB_TMO])) break; if (_sp > XB_SPIN_CAP) { atomicAdd(&(bar)[XB_TMO], 1u); break; } } } } while (0)
struct XcdBarrier { unsigned* bar; unsigned x; volatile LAS unsigned* st; };
__device__ __forceinline__ XcdBarrier xcd_barrier_post(unsigned* bar, volatile LAS unsigned* st) {
    XcdBarrier b; b.bar = bar; b.x = xb_xcc_id(); b.st = st;
    if (threadIdx.x == 0) (void)xb_add(&bar[XB_XCNT(b.x)], 1u);
    return b;
}
__device__ __forceinline__ void xcd_barrier_complete(unsigned* bar, unsigned x, unsigned& nloc, unsigned& nx) {
    const unsigned G = gridDim.x * gridDim.y * gridDim.z;
    unsigned sum, cnt, mine, sp = 0u;
    for (;;) {
        sum = 0u; cnt = 0u; mine = 0u;
#pragma unroll
        for (unsigned j = 0; j < 16; ++j) { const unsigned c = xb_ld(&bar[XB_XCNT(j)]); sum += c; cnt += (c > 0u) ? 1u : 0u; mine = (j == x) ? c : mine; }
        if (sum == G) break;
        __builtin_amdgcn_s_sleep(1);
        if ((++sp & 255u) == 0u) { if (xb_ld(&bar[XB_TMO])) break; if (sp > XB_SPIN_CAP) { atomicAdd(&bar[XB_TMO], 1u); break; } }
    }
    nloc = mine > 0u ? mine : 1u; nx = cnt > 0u ? cnt : 1u;
}
__device__ __forceinline__ void xcd_barrier(const XcdBarrier& b) {
    asm volatile("s_waitcnt vmcnt(0)" ::: "memory");
    __syncthreads();
    if (threadIdx.x == 0) {
        unsigned* bar = b.bar;
        __builtin_amdgcn_s_waitcnt(0);
        unsigned nloc = b.st[0], nx = b.st[1];
        if (nloc == 0u) { xcd_barrier_complete(bar, b.x, nloc, nx); b.st[0] = nloc; b.st[1] = nx; }
        const unsigned old = xb_add(&bar[XB_XSUB(b.x)], 1u);
        const unsigned gen = old / nloc;
        if (old + 1u == (gen + 1u) * nloc) {
            __builtin_amdgcn_fence(__ATOMIC_RELEASE, "agent");
            asm volatile("s_waitcnt vmcnt(0)" ::: "memory");
            const unsigned og = xb_add(&bar[XB_TOP], 1u);
            const unsigned tg = og / nx;
            if (og + 1u == (tg + 1u) * nx) xb_add(&bar[XB_TOPGEN], 1u);
            else XB_SPIN(xb_ld(&bar[XB_TOPGEN]) == tg, bar);
            __builtin_amdgcn_fence(__ATOMIC_ACQUIRE, "agent");
            xb_add(&bar[XB_XGEN(b.x)], 1u);
            asm volatile("s_waitcnt vmcnt(0)" ::: "memory");
        } else {
            XB_SPIN(xb_ld(&bar[XB_XGEN(b.x)]) == gen, bar);
            __builtin_amdgcn_fence(__ATOMIC_ACQUIRE, "agent");
            asm volatile("s_waitcnt vmcnt(0)" ::: "memory");
        }
    }
    __syncthreads();
}

struct Args { const float* in[23]; float* out; unsigned char* ws; int layer_lo, layer_hi, ph_lo, ph_hi, single, pad; };
struct Frame {
    LAS unsigned char* lds;
    int tid, lane, wave, vcu, G, gw, NGW, bid;
    unsigned char* ws;
};
enum { PH_PRE = 0, PH_CONV, PH_INPROJ, PH_MIXA, PH_MIXB, PH_WOUT, PH_NORM1, PH_XQ, PH_XATT, PH_XWO, PH_NORM2, PH_FFN1, PH_FFN2, PH_NORM3, PH_COUNT };

__device__ __forceinline__ void transpose_item64(const float* W, int K, int N, bf16* WT, int drow0, int k0, int n0, LAS unsigned* scr, int lane, const float* gk) {
    const int m = lane & 15, kp = lane >> 4;
    f32x4 va[8], vb[8];
#pragma unroll
    for (int i = 0; i < 8; ++i) { const float* p = W + (size_t)(k0 + 8 * i + 2 * kp) * N + n0 + 4 * m; va[i] = __builtin_nontemporal_load((const f32x4*)p); vb[i] = __builtin_nontemporal_load((const f32x4*)(p + N)); }
    if (gk) {
#pragma unroll
        for (int i = 0; i < 8; ++i) { const f32x2 g2 = *(const f32x2*)(gk + k0 + 8 * i + 2 * kp); va[i] = va[i] * g2.x; vb[i] = vb[i] * g2.y; } }
#pragma unroll
    for (int i = 0; i < 8; ++i)
#pragma unroll
        for (int j = 0; j < 4; ++j) scr[(4 * m + j) * 33 + 4 * i + kp] = cvt_pk_bf16(va[i][j], vb[i][j]);
    LDS_WAIT(); asm volatile("" ::: "memory");
    const int c = lane & 7;
#pragma unroll
    for (int jj = 0; jj < 8; ++jj) { const int n = (lane >> 3) + 8 * jj; const LAS unsigned* sp = scr + n * 33 + 4 * c;
        u32x4 o; o.x = sp[0]; o.y = sp[1]; o.z = sp[2]; o.w = sp[3];
        __builtin_nontemporal_store(o, (u32x4*)(WT + (size_t)(drow0 + n) * K + k0 + 8 * c)); }
    LDS_WAIT(); asm volatile("" ::: "memory");
}
__device__ __forceinline__ void colmax_pass(Frame& F, const float* W, int K, int N, const float* gk, float* cmax) {
    const int nblk = N / 256, items = (K / 128) * nblk;
    for (int it = F.gw; it < items; it += F.NGW) { const int kb = it / nblk, nb = it - kb * nblk; const float* p = W + (size_t)(kb * 128) * N + nb * 256 + 4 * F.lane;
        f32x4 mx = (f32x4){0.f, 0.f, 0.f, 0.f};
#pragma unroll 8
        for (int kk = 0; kk < 128; ++kk) { const f32x4 w = __builtin_nontemporal_load((const f32x4*)(p + (size_t)kk * N)); const float g = gk[kb * 128 + kk];
            mx.x = fmaxf(mx.x, fabsf(w.x * g)); mx.y = fmaxf(mx.y, fabsf(w.y * g)); mx.z = fmaxf(mx.z, fabsf(w.z * g)); mx.w = fmaxf(mx.w, fabsf(w.w * g)); }
        unsigned* cm = (unsigned*)(cmax + nb * 256 + 4 * F.lane);
        atomicMax(cm + 0, __float_as_uint(mx.x)); atomicMax(cm + 1, __float_as_uint(mx.y)); atomicMax(cm + 2, __float_as_uint(mx.z)); atomicMax(cm + 3, __float_as_uint(mx.w)); }
}
__device__ __forceinline__ unsigned q8(float x) { int v = (int)__builtin_rintf(x); v = v < -127 ? -127 : (v > 127 ? 127 : v); return (unsigned)v & 0xffu; }
__device__ __forceinline__ void transpose_item64_q(const float* W, int K, int N, signed char* WT, int drow0, int k0, int n0, LAS unsigned* scr, int lane, const float* gk, const float* cmax) {
    const int m = lane & 15, kp = lane >> 4;
    f32x4 va[4][4];
#pragma unroll
    for (int i = 0; i < 4; ++i)
#pragma unroll
        for (int kk = 0; kk < 4; ++kk) va[i][kk] = __builtin_nontemporal_load((const f32x4*)(W + (size_t)(k0 + 16 * i + 4 * kp + kk) * N + n0 + 4 * m));
    const f32x4 cm = *(const f32x4*)(cmax + n0 + 4 * m);
    f32x4 inv; inv.x = cm.x > 0.f ? 127.0f / cm.x : 0.f; inv.y = cm.y > 0.f ? 127.0f / cm.y : 0.f; inv.z = cm.z > 0.f ? 127.0f / cm.z : 0.f; inv.w = cm.w > 0.f ? 127.0f / cm.w : 0.f;
#pragma unroll
    for (int i = 0; i < 4; ++i) { const f32x4 g4 = *(const f32x4*)(gk + k0 + 16 * i + 4 * kp);
#pragma unroll
        for (int j = 0; j < 4; ++j) { const float sj = inv[j];
            scr[(4 * m + j) * 17 + 4 * i + kp] = q8(va[i][0][j] * g4.x * sj) | (q8(va[i][1][j] * g4.y * sj) << 8) | (q8(va[i][2][j] * g4.z * sj) << 16) | (q8(va[i][3][j] * g4.w * sj) << 24); } }
    LDS_WAIT(); asm volatile("" ::: "memory");
    const int c = lane & 3;
#pragma unroll
    for (int jj = 0; jj < 4; ++jj) { const int n = (lane >> 2) + 16 * jj; const LAS unsigned* sp = scr + n * 17 + 4 * c;
        u32x4 o; o.x = sp[0]; o.y = sp[1]; o.z = sp[2]; o.w = sp[3];
        __builtin_nontemporal_store(o, (u32x4*)(WT + (size_t)(drow0 + n) * K + k0 + 16 * c)); }
    LDS_WAIT(); asm volatile("" ::: "memory");
}
__device__ __forceinline__ void convert_matrix(Frame& F, const float* W, int K, int N, bf16* WT, int row_off, int mode, LAS unsigned* scr, const float* gk, const float* cmq) {
    const int nblk = N / 64, items = (K / 64) * nblk;
    for (int it = F.gw; it < items; it += F.NGW) {
        const int kb = it / nblk, nb = it % nblk, n0 = 64 * nb;
        const int drow0 = mode == 0 ? row_off + n0 : ((n0 >> 7) * 256 + (mode == 2 ? 128 : 0) + (n0 & 127));
        if (cmq) transpose_item64_q(W, K, N, (signed char*)WT, drow0, 64 * kb, n0, scr, F.lane, gk, cmq);
        else transpose_item64(W, K, N, WT, drow0, 64 * kb, n0, scr, F.lane, gk);
    }
}

constexpr int CV1 = 64 * 64, CV2 = CV1 + 64 * 16, CV3 = CV2 + 64 * 16, CV4 = CV3 + 64 * 16, CV5 = CV4 + 16 * 64, CV6 = CV5 + 64 * 172, CV7 = CV6 + 64 * 172, CV8 = CV7 + 172 * 64;
constexpr int CV9 = CV8 + 64 * 224;
constexpr int CV_PER_ITEM = 32, CV_ITEMS = CV8 / CV_PER_ITEM, CV_ITEMS_ALL = CV9 / CV_PER_ITEM, CV_P_ITEMS = CV5 / CV_PER_ITEM;
static_assert(CV8 % CV_PER_ITEM == 0 && CV5 % CV_PER_ITEM == 0 && CV9 % CV_PER_ITEM == 0, "conversion tiles per item");
struct ConvDst { bf16 *W_out, *W_q, *W_kv, *W_o, *W_gu, *W_dn, *W_in; const float* cmax; const float* cmin; };
__device__ __forceinline__ void convert_tile(const float* const* in_, int layer, int tt, const ConvDst& cd, LAS unsigned* scr, int lane) {
    struct { const float* const* p; __device__ __forceinline__ const float* operator[](int k) const { return (const float*)(GAS const float*)p[k]; } } in{in_};
    const float* W; const float* gk = nullptr; int K, N, row_off = 0, mode = 0, loc; bf16* WT;
    if (tt < CV1)      { W = in[10] + (size_t)layer * D * D;    K = D;   N = D;   WT = cd.W_out; loc = tt; }
    else if (tt < CV2) { W = in[13] + (size_t)layer * D * XW;   K = D;   N = XW;  WT = cd.W_q;  loc = tt - CV1; gk = in[12] + (size_t)layer * D; }
    else if (tt < CV3) { W = in[14] + (size_t)layer * D * XW;   K = D;   N = XW;  WT = cd.W_kv; loc = tt - CV2; }
    else if (tt < CV4) { W = in[15] + (size_t)layer * D * XW;   K = D;   N = XW;  WT = cd.W_kv; loc = tt - CV3; row_off = XW; }
    else if (tt < CV5) { W = in[16] + (size_t)layer * XW * D;   K = XW;  N = D;   WT = cd.W_o;  loc = tt - CV4; }
    else if (tt < CV6) { W = in[19] + (size_t)layer * D * FFH;  K = D;   N = FFH; WT = cd.W_gu; loc = tt - CV5; mode = 1; gk = in[18] + (size_t)layer * D; }
    else if (tt < CV7) { W = in[20] + (size_t)layer * D * FFH;  K = D;   N = FFH; WT = cd.W_gu; loc = tt - CV6; mode = 2; gk = in[18] + (size_t)layer * D; }
    else if (tt < CV8) { W = in[21] + (size_t)layer * FFH * D;  K = FFH; N = D;   WT = cd.W_dn; loc = tt - CV7; }
    else               { W = in[4] + (size_t)(layer + 1) * D * NPROJ; K = D; N = NPROJ; WT = cd.W_in; loc = tt - CV8; gk = in[3] + (size_t)(layer + 1) * D; }
    const int nblk = N / 64, kb = loc / nblk, nb = loc - kb * nblk, n0 = 64 * nb;
    const int drow0 = mode == 0 ? row_off + n0 : ((n0 >> 7) * 256 + (mode == 2 ? 128 : 0) + (n0 & 127));
    if (tt >= CV8) transpose_item64_q(W, K, N, (signed char*)WT, drow0, 64 * kb, n0, scr, lane, gk, cd.cmin + (size_t)(layer + 1) * NPROJ);
    else if (mode != 0) transpose_item64_q(W, K, N, (signed char*)WT, drow0, 64 * kb, n0, scr, lane, gk, cd.cmax + (size_t)layer * 2 * FFH + (mode == 2 ? FFH : 0));
    else transpose_item64(W, K, N, WT, drow0, 64 * kb, n0, scr, lane, gk);
}
__device__ __forceinline__ unsigned conv_next(unsigned* q, unsigned limit, unsigned* stopw, unsigned stopv) {
    if (stopw && __hip_atomic_load(stopw, __ATOMIC_RELAXED, __HIP_MEMORY_SCOPE_AGENT) >= stopv) return 0xffffffffu;
    if (__hip_atomic_load(q, __ATOMIC_RELAXED, __HIP_MEMORY_SCOPE_AGENT) >= limit) return 0xffffffffu;
    return __hip_atomic_fetch_add(q, 1u, __ATOMIC_RELAXED, __HIP_MEMORY_SCOPE_AGENT);
}
__device__ __forceinline__ void conv_pull(Frame& F, const float* const* in, int layer, unsigned* q, int limit, int count, const ConvDst& cd, volatile LAS unsigned* slot, unsigned* stopw, unsigned stopv) {
    LAS unsigned* scr = (LAS unsigned*)(F.lds + F.wave * 16384);
    __syncthreads();
    unsigned nxt = 0xffffffffu;
    if (F.tid == 0) nxt = conv_next(q, (unsigned)limit, stopw, stopv);
    for (;;) {
        if (F.tid == 0) slot[0] = nxt;
        __syncthreads();
        const unsigned cur = slot[0];
        __syncthreads();
        if (cur >= (unsigned)count) break;
        if (F.tid == 0) nxt = conv_next(q, (unsigned)limit, stopw, stopv);
        const int t0 = (int)cur * CV_PER_ITEM + F.wave * (CV_PER_ITEM / NWAVES);
#pragma unroll 1
        for (int e = 0; e < CV_PER_ITEM / NWAVES; ++e) convert_tile(in, layer, t0 + e, cd, scr, F.lane);
    }
}

__device__ __forceinline__ void rms_row_to_bf16(const float* xrow, const float* g, bf16* orow, int lane) {
    const f32x4* xr = (const f32x4*)xrow + lane; const f32x4* gr = (const f32x4*)g + lane;
    f32x4 v[16]; float s = 0.f;
#pragma unroll
    for (int j = 0; j < 16; ++j) { v[j] = xr[64 * j]; s += (v[j].x * v[j].x + v[j].y * v[j].y) + (v[j].z * v[j].z + v[j].w * v[j].w); }
    const float r = 1.0f / sqrtf(wave_sum(s) * (1.0f / D) + RMS_EPS);
    u32x2* o8 = (u32x2*)orow + lane;
#pragma unroll
    for (int j = 0; j < 16; ++j) { const f32x4 gg = gr[64 * j]; u32x2 w; w.x = cvt_pk_bf16(v[j].x * r * gg.x, v[j].y * r * gg.y); w.y = cvt_pk_bf16(v[j].z * r * gg.z, v[j].w * r * gg.w); o8[64 * j] = w; }
}
__device__ __forceinline__ void norm_phase(Frame& F, const bf16* tmp, const float* hin32, bf16* hb, float* out32, const float* gpost, float* rs_out) {
    LAS float* gl = (LAS float*)F.lds;
    __syncthreads();
    for (int i = F.tid; i < D / 4; i += NWAVES * 64) ((LAS f32x4*)gl)[i] = ((const f32x4*)gpost)[i];
    __syncthreads();
    for (int row0 = F.gw; row0 < M; row0 += 2 * F.NGW) {
        f32x4 v[2][16]; float s[2] = {0.f, 0.f};
#pragma unroll
        for (int rr = 0; rr < 2; ++rr) { const int row = row0 + rr * F.NGW; const u32x4* tr = (const u32x4*)(tmp + (size_t)row * D) + F.lane;
#pragma unroll
            for (int j = 0; j < 8; ++j) { const u32x4 w = __builtin_nontemporal_load(tr + 64 * j);
                v[rr][2 * j] = (f32x4){bflo(w.x), bfhi(w.x), bflo(w.y), bfhi(w.y)}; v[rr][2 * j + 1] = (f32x4){bflo(w.z), bfhi(w.z), bflo(w.w), bfhi(w.w)}; }
        }
#pragma unroll
        for (int rr = 0; rr < 2; ++rr)
#pragma unroll
            for (int j = 0; j < 16; ++j) s[rr] += (v[rr][j].x * v[rr][j].x + v[rr][j].y * v[rr][j].y) + (v[rr][j].z * v[rr][j].z + v[rr][j].w * v[rr][j].w);
#pragma unroll
        for (int o = 1; o < 64; o <<= 1) { s[0] += __shfl_xor(s[0], o); s[1] += __shfl_xor(s[1], o); }
        float s2[2] = {0.f, 0.f};
#pragma unroll
        for (int rr = 0; rr < 2; ++rr) { const int row = row0 + rr * F.NGW; const float r = 1.0f / sqrtf(s[rr] * (1.0f / D) + RMS_EPS);
            u32x4* hbr = (u32x4*)(hb + (size_t)row * D) + F.lane;
            u32x4 hw[8];
            if (!hin32) {
#pragma unroll
                for (int j = 0; j < 8; ++j) hw[j] = __builtin_nontemporal_load(hbr + 64 * j); }
            asm volatile("" ::: "memory");
#pragma unroll
            for (int j = 0; j < 8; ++j) { const int off = 8 * F.lane + 512 * j;
                f32x4 h0, h1;
                if (hin32) { h0 = *(const f32x4*)(hin32 + (size_t)row * D + off); h1 = *(const f32x4*)(hin32 + (size_t)row * D + off + 4); }
                else { const u32x4 w = hw[j]; h0 = (f32x4){bflo(w.x), bfhi(w.x), bflo(w.y), bfhi(w.y)}; h1 = (f32x4){bflo(w.z), bfhi(w.z), bflo(w.w), bfhi(w.w)}; }
                const f32x4 g0 = *(const LAS f32x4*)(gl + off), g1 = *(const LAS f32x4*)(gl + off + 4);
                h0 = h0 + v[rr][2 * j] * r * g0; h1 = h1 + v[rr][2 * j + 1] * r * g1;
                s2[rr] += (h0.x * h0.x + h0.y * h0.y) + (h0.z * h0.z + h0.w * h0.w) + (h1.x * h1.x + h1.y * h1.y) + (h1.z * h1.z + h1.w * h1.w);
                if (out32) { *(f32x4*)(out32 + (size_t)row * D + off) = h0; *(f32x4*)(out32 + (size_t)row * D + off + 4) = h1; }
                else { u32x4 w; w.x = cvt_pk_bf16(h0.x, h0.y); w.y = cvt_pk_bf16(h0.z, h0.w); w.z = cvt_pk_bf16(h1.x, h1.y); w.w = cvt_pk_bf16(h1.z, h1.w); hbr[64 * j] = w; } } }
        if (rs_out) {
#pragma unroll
            for (int o = 1; o < 64; o <<= 1) { s2[0] += __shfl_xor(s2[0], o); s2[1] += __shfl_xor(s2[1], o); }
            if (F.lane == 0) { rs_out[row0] = 1.0f / sqrtf(s2[0] * (1.0f / D) + RMS_EPS); rs_out[row0 + F.NGW] = 1.0f / sqrtf(s2[1] * (1.0f / D) + RMS_EPS); }
        }
    }
}
__device__ __forceinline__ void norm_phase_q(Frame& F, const bf16* tmp, bf16* hb, const float* gpost, signed char* hq, float* rq, float* rs_out) {
    LAS float* gl = (LAS float*)F.lds;
    __syncthreads();
    for (int i = F.tid; i < D / 4; i += NWAVES * 64) ((LAS f32x4*)gl)[i] = ((const f32x4*)gpost)[i];
    __syncthreads();
    for (int row0 = F.gw; row0 < M; row0 += 2 * F.NGW) {
        f32x4 v[2][16]; float s[2] = {0.f, 0.f};
#pragma unroll
        for (int rr = 0; rr < 2; ++rr) { const int row = row0 + rr * F.NGW; const u32x4* tr = (const u32x4*)(tmp + (size_t)row * D) + F.lane;
#pragma unroll
            for (int j = 0; j < 8; ++j) { const u32x4 w = __builtin_nontemporal_load(tr + 64 * j);
                v[rr][2 * j] = (f32x4){bflo(w.x), bfhi(w.x), bflo(w.y), bfhi(w.y)}; v[rr][2 * j + 1] = (f32x4){bflo(w.z), bfhi(w.z), bflo(w.w), bfhi(w.w)}; }
        }
#pragma unroll
        for (int rr = 0; rr < 2; ++rr)
#pragma unroll
            for (int j = 0; j < 16; ++j) s[rr] += (v[rr][j].x * v[rr][j].x + v[rr][j].y * v[rr][j].y) + (v[rr][j].z * v[rr][j].z + v[rr][j].w * v[rr][j].w);
#pragma unroll
        for (int o = 1; o < 64; o <<= 1) { s[0] += __shfl_xor(s[0], o); s[1] += __shfl_xor(s[1], o); }
        float s2[2] = {0.f, 0.f}, am[2] = {0.f, 0.f};
#pragma unroll
        for (int rr = 0; rr < 2; ++rr) { const int row = row0 + rr * F.NGW; const float r = 1.0f / sqrtf(s[rr] * (1.0f / D) + RMS_EPS);
            u32x4* hbr = (u32x4*)(hb + (size_t)row * D) + F.lane;
            u32x4 hw[8];
#pragma unroll
            for (int j = 0; j < 8; ++j) hw[j] = __builtin_nontemporal_load(hbr + 64 * j);
            asm volatile("" ::: "memory");
#pragma unroll
            for (int j = 0; j < 8; ++j) { const int off = 8 * F.lane + 512 * j;
                const u32x4 w = hw[j]; f32x4 h0 = (f32x4){bflo(w.x), bfhi(w.x), bflo(w.y), bfhi(w.y)}, h1 = (f32x4){bflo(w.z), bfhi(w.z), bflo(w.w), bfhi(w.w)};
                const f32x4 g0 = *(const LAS f32x4*)(gl + off), g1 = *(const LAS f32x4*)(gl + off + 4);
                h0 = h0 + v[rr][2 * j] * r * g0; h1 = h1 + v[rr][2 * j + 1] * r * g1;
                s2[rr] += (h0.x * h0.x + h0.y * h0.y) + (h0.z * h0.z + h0.w * h0.w) + (h1.x * h1.x + h1.y * h1.y) + (h1.z * h1.z + h1.w * h1.w);
                am[rr] = fmaxf(am[rr], fmaxf(fmaxf(fmaxf(fabsf(h0.x), fabsf(h0.y)), fmaxf(fabsf(h0.z), fabsf(h0.w))), fmaxf(fmaxf(fabsf(h1.x), fabsf(h1.y)), fmaxf(fabsf(h1.z), fabsf(h1.w)))));
                v[rr][2 * j] = h0; v[rr][2 * j + 1] = h1;
                u32x4 wo; wo.x = cvt_pk_bf16(h0.x, h0.y); wo.y = cvt_pk_bf16(h0.z, h0.w); wo.z = cvt_pk_bf16(h1.x, h1.y); wo.w = cvt_pk_bf16(h1.z, h1.w); hbr[64 * j] = wo; } }
#pragma unroll
        for (int o = 1; o < 64; o <<= 1) { s2[0] += __shfl_xor(s2[0], o); s2[1] += __shfl_xor(s2[1], o); am[0] = fmaxf(am[0], __shfl_xor(am[0], o)); am[1] = fmaxf(am[1], __shfl_xor(am[1], o)); }
#pragma unroll
        for (int rr = 0; rr < 2; ++rr) { const int row = row0 + rr * F.NGW; const float inv = am[rr] > 0.f ? 127.0f / am[rr] : 0.f;
            u32x2* qo = (u32x2*)(hq + (size_t)row * D) + F.lane;
#pragma unroll
            for (int j = 0; j < 8; ++j) { const f32x4 a = v[rr][2 * j] * inv, bq = v[rr][2 * j + 1] * inv;
                u32x2 w; w.x = q8(a.x) | (q8(a.y) << 8) | (q8(a.z) << 16) | (q8(a.w) << 24); w.y = q8(bq.x) | (q8(bq.y) << 8) | (q8(bq.z) << 16) | (q8(bq.w) << 24); qo[64 * j] = w; }
            if (F.lane == 0) { const float rsn = 1.0f / sqrtf(s2[rr] * (1.0f / D) + RMS_EPS); rq[row] = rsn * am[rr] * (1.0f / 127.0f); if (rs_out) rs_out[row] = rsn; } }
    }
}
__device__ __forceinline__ void x_to_stream(Frame& F, const float* x, bf16* hb, float* rs_out) {
    for (int row = F.gw; row < M; row += F.NGW) {
        float s2 = 0.f;
#pragma unroll
        for (int j = 0; j < 8; ++j) { const int off = 8 * F.lane + 512 * j; const f32x4 h0 = *(const f32x4*)(x + (size_t)row * D + off), h1 = *(const f32x4*)(x + (size_t)row * D + off + 4);
            s2 += (h0.x * h0.x + h0.y * h0.y) + (h0.z * h0.z + h0.w * h0.w) + (h1.x * h1.x + h1.y * h1.y) + (h1.z * h1.z + h1.w * h1.w);
            u32x4 w; w.x = cvt_pk_bf16(h0.x, h0.y); w.y = cvt_pk_bf16(h0.z, h0.w); w.z = cvt_pk_bf16(h1.x, h1.y); w.w = cvt_pk_bf16(h1.z, h1.w); *((u32x4*)(hb + (size_t)row * D + off)) = w; }
        s2 = wave_sum(s2);
        if (F.lane == 0) rs_out[row] = 1.0f / sqrtf(s2 * (1.0f / D) + RMS_EPS);
    }
}

template <int MT, int NT, bool TR>
__device__ __forceinline__ void wave_mma(f32x4 (&acc)[MT][NT], const LAS bf16* A, int lda, const LAS bf16* Bm, int ldb, int K, int lane) {
    const int r = lane & 15, q = lane >> 4;
    for (int k0 = 0; k0 < K; k0 += 32) {
        bf16x8 a[MT], b[NT];
#pragma unroll
        for (int mt = 0; mt < MT; ++mt) a[mt] = *(const LAS bf16x8*)(A + (mt * 16 + r) * lda + k0 + 8 * q);
#pragma unroll
        for (int nt = 0; nt < NT; ++nt) b[nt] = *(const LAS bf16x8*)(Bm + (nt * 16 + r) * ldb + k0 + 8 * q);
#pragma unroll
        for (int mt = 0; mt < MT; ++mt)
#pragma unroll
            for (int nt = 0; nt < NT; ++nt)
                acc[mt][nt] = TR ? __builtin_amdgcn_mfma_f32_16x16x32_bf16(b[nt], a[mt], acc[mt][nt], 0, 0, 0) : __builtin_amdgcn_mfma_f32_16x16x32_bf16(a[mt], b[nt], acc[mt][nt], 0, 0, 0);
    }
}
__device__ __forceinline__ void stage_tile(LAS bf16* dst, int lld, const bf16* src, size_t gld, int rows, int cols, int tid) {
    const int cpr = cols >> 3, total = rows * cpr;
    for (int i = tid; i < total; i += NWAVES * 64) { const int r = i / cpr, c = i - r * cpr; *(LAS u32x4*)(dst + r * lld + c * 8) = *(const u32x4*)(src + (size_t)r * gld + c * 8); }
}
__device__ __forceinline__ void stage_tile_tr(LAS bf16* dst, int lld, const bf16* src, size_t gld, int rows, int cols, int tid) {
    const int cpr = cols >> 3, total = rows * cpr;
    for (int i = tid; i < total; i += NWAVES * 64) { const int c = i / rows, r = i - c * rows; const u32x4 v = *(const u32x4*)(src + (size_t)r * gld + c * 8);
        LAS bf16* d = dst + (c * 8) * lld + r;
        d[0] = (bf16)(v.x & 0xffff); d[lld] = (bf16)(v.x >> 16); d[2 * lld] = (bf16)(v.y & 0xffff); d[3 * lld] = (bf16)(v.y >> 16);
        d[4 * lld] = (bf16)(v.z & 0xffff); d[5 * lld] = (bf16)(v.z >> 16); d[6 * lld] = (bf16)(v.w & 0xffff); d[7 * lld] = (bf16)(v.w >> 16); }
}

struct NoScale { __device__ __forceinline__ float operator()(int) const { return 1.0f; } static constexpr bool ON = false; };
struct Exp2Scale { float a, b; static constexpr bool ON = true; __device__ __forceinline__ float operator()(int r) const { return exp2f(a + b * (float)r); } };
template <class RS>
__device__ __forceinline__ void stage_tile_tr2(LAS bf16* dst, int lld, const bf16* src, size_t gld, int rows, int cols, int tid, const RS& sc) {
    const int hp = rows >> 1, total = hp * (cols >> 3), ls = lld >> 1;
    for (int i = tid; i < total; i += NWAVES * 64) { const int rp = i % hp, c8 = i / hp;
        const u32x4 a = *(const u32x4*)(src + (size_t)(2 * rp) * gld + c8 * 8), b = *(const u32x4*)(src + (size_t)(2 * rp + 1) * gld + c8 * 8);
        LAS unsigned* d = (LAS unsigned*)(dst + (c8 * 8) * lld + 2 * rp);
        if (RS::ON) { const float s0 = sc(2 * rp), s1 = sc(2 * rp + 1);
            d[0 * ls] = cvt_pk_bf16(bflo(a.x) * s0, bflo(b.x) * s1); d[1 * ls] = cvt_pk_bf16(bfhi(a.x) * s0, bfhi(b.x) * s1);
            d[2 * ls] = cvt_pk_bf16(bflo(a.y) * s0, bflo(b.y) * s1); d[3 * ls] = cvt_pk_bf16(bfhi(a.y) * s0, bfhi(b.y) * s1);
            d[4 * ls] = cvt_pk_bf16(bflo(a.z) * s0, bflo(b.z) * s1); d[5 * ls] = cvt_pk_bf16(bfhi(a.z) * s0, bfhi(b.z) * s1);
            d[6 * ls] = cvt_pk_bf16(bflo(a.w) * s0, bflo(b.w) * s1); d[7 * ls] = cvt_pk_bf16(bfhi(a.w) * s0, bfhi(b.w) * s1);
        } else {
            d[0 * ls] = (a.x & 0xffffu) | (b.x << 16); d[1 * ls] = (a.x >> 16) | (b.x & 0xffff0000u);
            d[2 * ls] = (a.y & 0xffffu) | (b.y << 16); d[3 * ls] = (a.y >> 16) | (b.y & 0xffff0000u);
            d[4 * ls] = (a.z & 0xffffu) | (b.z << 16); d[5 * ls] = (a.z >> 16) | (b.z & 0xffff0000u);
            d[6 * ls] = (a.w & 0xffffu) | (b.w << 16); d[7 * ls] = (a.w >> 16) | (b.w & 0xffff0000u);
        } }
}

typedef short s16x4 __attribute__((ext_vector_type(4)));
__device__ __forceinline__ bf16x8 tr_frag(const LAS bf16* base, int pitch, int lane) {
    const int g = lane >> 4, q = (lane >> 2) & 3, p = lane & 3;
    const LAS bf16* a = base + (8 * g + q) * pitch + 4 * p;
    const s16x4 lo = __builtin_amdgcn_ds_read_tr16_b64_v4i16((LAS s16x4*)a);
    const s16x4 hi = __builtin_amdgcn_ds_read_tr16_b64_v4i16((LAS s16x4*)(a + 4 * pitch));
    return __builtin_shufflevector(lo, hi, 0, 1, 2, 3, 4, 5, 6, 7);
}
template <int MT, int NT, bool TR, bool AT, bool BT>
__device__ __forceinline__ void wave_mma_g(f32x4 (&acc)[MT][NT], const LAS bf16* A, int lda, const LAS bf16* Bm, int ldb, int K, int lane) {
    const int r = lane & 15, q = lane >> 4;
    for (int k0 = 0; k0 < K; k0 += 32) {
        bf16x8 a[MT], b[NT];
#pragma unroll
        for (int mt = 0; mt < MT; ++mt) { if (AT) a[mt] = tr_frag(A + k0 * lda + 16 * mt, lda, lane); else a[mt] = *(const LAS bf16x8*)(A + (mt * 16 + r) * lda + k0 + 8 * q); }
#pragma unroll
        for (int nt = 0; nt < NT; ++nt) { if (BT) b[nt] = tr_frag(Bm + k0 * ldb + 16 * nt, ldb, lane); else b[nt] = *(const LAS bf16x8*)(Bm + (nt * 16 + r) * ldb + k0 + 8 * q); }
#pragma unroll
        for (int mt = 0; mt < MT; ++mt)
#pragma unroll
            for (int nt = 0; nt < NT; ++nt)
                acc[mt][nt] = TR ? __builtin_amdgcn_mfma_f32_16x16x32_bf16(b[nt], a[mt], acc[mt][nt], 0, 0, 0) : __builtin_amdgcn_mfma_f32_16x16x32_bf16(a[mt], b[nt], acc[mt][nt], 0, 0, 0);
    }
}
template <int N> struct Pf { u32x4 r[N]; };
template <int N, int CPR> __device__ __forceinline__ void pf_load(Pf<N>& p, const bf16* src, size_t gld, int tid) {
#pragma unroll
    for (int it = 0; it < N; ++it) { const int i = tid + NWAVES * 64 * it; p.r[it] = *(const u32x4*)(src + (size_t)(i / CPR) * gld + (i % CPR) * 8); }
}
template <int N, int CPR> __device__ __forceinline__ void pf_store(LAS bf16* dst, int lld, int tid, const Pf<N>& p) {
#pragma unroll
    for (int it = 0; it < N; ++it) { const int i = tid + NWAVES * 64 * it; *(LAS u32x4*)(dst + (i / CPR) * lld + (i % CPR) * 8) = p.r[it]; }
}
__device__ __forceinline__ u32x4 scale_bf16x8(u32x4 v, float s) {
    u32x4 o; o.x = cvt_pk_bf16(bflo(v.x) * s, bfhi(v.x) * s); o.y = cvt_pk_bf16(bflo(v.y) * s, bfhi(v.y) * s); o.z = cvt_pk_bf16(bflo(v.z) * s, bfhi(v.z) * s); o.w = cvt_pk_bf16(bflo(v.w) * s, bfhi(v.w) * s); return o;
}

struct RsCtx { const bf16* proj; bf16* st; LAS bf16* kt; LAS bf16* vt; int b, h, bh, dir, e0; float l2g, gC; };
__device__ __forceinline__ void rs_load(Pf<8>& pk, Pf<2>& pv, const RsCtx& c, int ci, int tid) {
    const int ch = c.dir ? 31 - ci : ci; const bf16* rowp = c.proj + (size_t)(c.b * SEQ + ch * 128) * NPROJ;
    pf_load<8, 32>(pk, rowp + C_RK + c.h * RD, NPROJ, tid); pf_load<2, 8>(pv, rowp + C_RV + c.h * RD + c.e0, NPROJ, tid);
}
__device__ __forceinline__ void rs_step(Frame& F, f32x4 (&acc)[4][2], Pf<8>& pk, Pf<2>& pv, const RsCtx& c, int ci) {
    const int r = F.lane & 15, q = F.lane >> 4;
    const int ch = c.dir ? 31 - ci : ci;
    bf16* sp = c.st + ((((size_t)(c.bh * 2 + c.dir) * 32 + ch) * 256 + c.e0) * 256) + 32 * F.wave + 4 * q;
#pragma unroll
    for (int mt = 0; mt < 4; ++mt)
#pragma unroll
        for (int nt = 0; nt < 2; ++nt) { u32x2 w; w.x = cvt_pk_bf16(acc[mt][nt][0], acc[mt][nt][1]); w.y = cvt_pk_bf16(acc[mt][nt][2], acc[mt][nt][3]);
            *(u32x2*)(sp + (size_t)(16 * mt + r) * 256 + 16 * nt) = w; }
    __syncthreads();
    pf_store<8, 32>(c.kt, 272, F.tid, pk);
#pragma unroll
    for (int it = 0; it < 2; ++it) { const int i = F.tid + NWAVES * 64 * it, row = i >> 3;
        const float sc = exp2f(c.l2g * (float)(c.dir ? row : 127 - row)); *(LAS u32x4*)(c.vt + row * 80 + (i & 7) * 8) = scale_bf16x8(pv.r[it], sc); }
    __syncthreads();
    if (ci + 2 < 32) rs_load(pk, pv, c, ci + 2, F.tid);
#pragma unroll
    for (int mt = 0; mt < 4; ++mt)
#pragma unroll
        for (int nt = 0; nt < 2; ++nt) acc[mt][nt] = acc[mt][nt] * c.gC;
    wave_mma_g<4, 2, true, true, true>(acc, c.vt, 80, c.kt + 32 * F.wave, 272, 128, F.lane);
}
__device__ __forceinline__ void ret_state_pass(Frame& F, int first, int stride, const bf16* proj, bf16* st) {
    for (int item = first; item < 128; item += stride) {
        RsCtx c; c.proj = proj; c.st = st; c.kt = (LAS bf16*)F.lds; c.vt = c.kt + 128 * 272;
        const int es = item & 3; c.dir = (item >> 2) & 1; c.bh = item >> 3; c.b = c.bh >> 3; c.h = c.bh & 7; c.e0 = es * 64;
        const int hg = c.dir ? (7 - c.h) : c.h; const float gam = 1.0f - exp2f(-5.0f - (float)hg); c.l2g = log2f(gam); c.gC = exp2f(128.0f * c.l2g);
        f32x4 acc[4][2];
#pragma unroll
        for (int mt = 0; mt < 4; ++mt)
#pragma unroll
            for (int nt = 0; nt < 2; ++nt) acc[mt][nt] = (f32x4){0.f, 0.f, 0.f, 0.f};
        Pf<8> pkA, pkB; Pf<2> pvA, pvB;
        rs_load(pkA, pvA, c, 0, F.tid); rs_load(pkB, pvB, c, 1, F.tid);
        for (int ci = 0; ci < 32; ci += 2) { rs_step(F, acc, pkA, pvA, c, ci); rs_step(F, acc, pkB, pvB, c, ci + 1); }
    }
    __syncthreads();
}
struct RoCtx { const bf16* kbase; const bf16* vbase; const bf16* stf; const bf16* stb; };
template <int S> __device__ __forceinline__ void ro_issue(Pf<4>& pa, Pf<2>& pv, const RoCtx& c, int tid) {
    if constexpr (S < 2) pf_load<4, 32>(pa, c.kbase + (size_t)(64 * S) * NPROJ, NPROJ, tid);
    else if constexpr (S < 14) { constexpr int es = (S - 2) / 3, kind = (S - 2) % 3;
        if constexpr (kind == 0) pf_load<4, 32>(pa, c.stf + (size_t)(64 * es) * 256, 256, tid);
        else if constexpr (kind == 1) pf_load<4, 32>(pa, c.stb + (size_t)(64 * es) * 256, 256, tid);
        else pf_load<2, 8>(pv, c.vbase + 64 * es, NPROJ, tid); }
}
template <int S> __device__ __forceinline__ void ro_round(Frame& F, Pf<4>& pa, Pf<2>& pv, const RoCtx& c, LAS bf16* qs, LAS bf16* ps, LAS bf16* bs, f32x4 (&o)[4][1][4], int n, float l2f, float l2b, float qdf, float qdb) {
    const int q = F.lane >> 4;
    __syncthreads();
    if constexpr (S < 2 || (S - 2) % 3 != 2) pf_store<4, 32>(bs, 264, F.tid, pa); else pf_store<2, 8>(bs, 80, F.tid, pv);
    __syncthreads();
    ro_issue<S + 1>(pa, pv, c, F.tid);
    if constexpr (S < 2) {
        f32x4 s[1][4];
#pragma unroll
        for (int nt = 0; nt < 4; ++nt) s[0][nt] = (f32x4){0.f, 0.f, 0.f, 0.f};
        wave_mma<1, 4, true>(s, qs + F.wave * 16 * 264, 264, bs, 264, 256, F.lane);
#pragma unroll
        for (int nt = 0; nt < 4; ++nt) { float p[4];
#pragma unroll
            for (int j = 0; j < 4; ++j) { const int mkey = 64 * S + 16 * nt + 4 * q + j; const int dist = n - mkey;
                const float w = dist >= 0 ? exp2f((float)dist * l2f) : exp2f((float)(-dist) * l2b); p[j] = s[0][nt][j] * w; }
            u32x2 w2; w2.x = cvt_pk_bf16(p[0], p[1]); w2.y = cvt_pk_bf16(p[2], p[3]);
            *(LAS u32x2*)(ps + n * 136 + 64 * S + 16 * nt + 4 * q) = w2; }
    } else { constexpr int es = (S - 2) / 3, kind = (S - 2) % 3;
        if constexpr (kind < 2) {
            f32x4 t[1][4];
#pragma unroll
            for (int nt = 0; nt < 4; ++nt) t[0][nt] = (f32x4){0.f, 0.f, 0.f, 0.f};
            wave_mma<1, 4, true>(t, qs + F.wave * 16 * 264, 264, bs, 264, 256, F.lane);
#pragma unroll
            for (int nt = 0; nt < 4; ++nt) { if constexpr (kind == 0) o[es][0][nt] = t[0][nt] * qdf; else o[es][0][nt] = o[es][0][nt] + t[0][nt] * qdb; }
        } else {
            wave_mma_g<1, 4, true, false, true>(o[es], ps + F.wave * 16 * 136, 136, bs, 80, 128, F.lane);
        }
    }
}
__device__ __forceinline__ void ret_output_pass(Frame& F, int first, int stride, const bf16* proj, const bf16* st, const float* rng, bf16* mixin) {
    LAS bf16* qs = (LAS bf16*)F.lds;
    LAS bf16* ps = qs + 128 * 264;
    LAS bf16* bs = ps + 128 * 136;
    const int r = F.lane & 15, q = F.lane >> 4;
    for (int item = first; item < 512; item += stride) {
        const int ch = item & 31, bh = item >> 5, b = bh >> 3, h = bh & 7;
        const float l2f = log2f(1.0f - exp2f(-5.0f - (float)h)), l2b = log2f(1.0f - exp2f(-5.0f - (float)(7 - h)));
        const size_t row0 = (size_t)b * SEQ + ch * 128;
        const int n = 16 * F.wave + r;
        RoCtx c; c.kbase = proj + row0 * NPROJ + C_RK + h * RD; c.vbase = proj + row0 * NPROJ + C_RV + h * RD;
        c.stf = st + (((size_t)(bh * 2 + 0) * 32 + ch) * 256) * 256; c.stb = st + (((size_t)(bh * 2 + 1) * 32 + ch) * 256) * 256;
        Pf<4> pa; Pf<2> pv;
        ro_issue<0>(pa, pv, c, F.tid);
        __syncthreads();
        stage_tile(qs, 264, proj + row0 * NPROJ + C_RQ + h * RD, NPROJ, 128, 256, F.tid);
        const float qdf = exp2f((float)(n + 1) * l2f), qdb = exp2f((float)(128 - n) * l2b);
        f32x4 o[4][1][4];
        ro_round<0>(F, pa, pv, c, qs, ps, bs, o, n, l2f, l2b, qdf, qdb); ro_round<1>(F, pa, pv, c, qs, ps, bs, o, n, l2f, l2b, qdf, qdb);
        ro_round<2>(F, pa, pv, c, qs, ps, bs, o, n, l2f, l2b, qdf, qdb); ro_round<3>(F, pa, pv, c, qs, ps, bs, o, n, l2f, l2b, qdf, qdb); ro_round<4>(F, pa, pv, c, qs, ps, bs, o, n, l2f, l2b, qdf, qdb);
        ro_round<5>(F, pa, pv, c, qs, ps, bs, o, n, l2f, l2b, qdf, qdb); ro_round<6>(F, pa, pv, c, qs, ps, bs, o, n, l2f, l2b, qdf, qdb); ro_round<7>(F, pa, pv, c, qs, ps, bs, o, n, l2f, l2b, qdf, qdb);
        ro_round<8>(F, pa, pv, c, qs, ps, bs, o, n, l2f, l2b, qdf, qdb); ro_round<9>(F, pa, pv, c, qs, ps, bs, o, n, l2f, l2b, qdf, qdb); ro_round<10>(F, pa, pv, c, qs, ps, bs, o, n, l2f, l2b, qdf, qdb);
        ro_round<11>(F, pa, pv, c, qs, ps, bs, o, n, l2f, l2b, qdf, qdb); ro_round<12>(F, pa, pv, c, qs, ps, bs, o, n, l2f, l2b, qdf, qdb); ro_round<13>(F, pa, pv, c, qs, ps, bs, o, n, l2f, l2b, qdf, qdb);
        float sm = 0.f;
#pragma unroll
        for (int es = 0; es < 4; ++es)
#pragma unroll
            for (int nt = 0; nt < 4; ++nt) sm += (o[es][0][nt][0] + o[es][0][nt][1]) + (o[es][0][nt][2] + o[es][0][nt][3]);
        sm += __shfl_xor(sm, 16); sm += __shfl_xor(sm, 32);
        const float mu = sm * (1.0f / RD); float sv = 0.f;
#pragma unroll
        for (int es = 0; es < 4; ++es)
#pragma unroll
            for (int nt = 0; nt < 4; ++nt) { const f32x4 dvv = o[es][0][nt] - mu; o[es][0][nt] = dvv; sv += (dvv[0] * dvv[0] + dvv[1] * dvv[1]) + (dvv[2] * dvv[2] + dvv[3] * dvv[3]); }
        sv += __shfl_xor(sv, 16); sv += __shfl_xor(sv, 32);
        const float rs = 1.0f / sqrtf(sv * (1.0f / RD) + GN_EPS);
        const bf16* gp = proj + (row0 + n) * NPROJ + C_RG + h * RD + 4 * q; bf16* op = mixin + (row0 + n) * D + h * RD + 4 * q; const float* gg = rng + h * RD + 4 * q;
#pragma unroll
        for (int es = 0; es < 4; ++es)
#pragma unroll
            for (int nt = 0; nt < 4; ++nt) { const int e = 64 * es + 16 * nt; const u32x2 gt = *(const u32x2*)(gp + e); const f32x4 g4 = *(const f32x4*)(gg + e);
                const f32x4 v = o[es][0][nt] * rs * g4;
                u32x2 w; w.x = cvt_pk_bf16(v[0] * silu_f(bflo(gt.x)), v[1] * silu_f(bfhi(gt.x))); w.y = cvt_pk_bf16(v[2] * silu_f(bflo(gt.y)), v[3] * silu_f(bfhi(gt.y)));
                *(u32x2*)(op + e) = w; }
    }
    __syncthreads();
}

__device__ __forceinline__ float hgrn_lb(const float* lblog, int layer, int dir, int col) {
    if (layer == 0) return 0.f;
    float mx = -1e30f;
    for (int l = 0; l < NL; ++l) mx = fmaxf(mx, lblog[(l * 2 + dir) * HW + col]);
    float den = 0.f, num = 0.f;
    for (int l = 0; l < NL; ++l) { const float ev = __expf(lblog[(l * 2 + dir) * HW + col] - mx); den += ev; if (l >= 1 && l <= layer) num += ev; }
    return num / den;
}
constexpr int HSB = 4;
struct HsCtx { const bf16* proj; const float* gatez; bf16* hst; LAS bf16* kpt; LAS bf16* vt; LAS float* tot; LAS float* adec; int b, h, bh, dir, d0, d, sg; float lb; };
__device__ __forceinline__ void hs_load(float (&zr)[HSB][4], Pf<2> (&pv)[HSB], const HsCtx& c, int cg, int tid) {
#pragma unroll
    for (int cb = 0; cb < HSB; ++cb) { const int ci = cg * HSB + cb, ch = c.dir ? 63 - ci : ci; const size_t row0 = (size_t)c.b * SEQ + ch * 64;
        const bf16* zp = c.proj + (row0 + 4 * c.sg) * NPROJ + C_HFF + c.dir * HW + c.h * HD + c.d0 + c.d;
#pragma unroll
        for (int ii = 0; ii < 4; ++ii) zr[cb][ii] = bf2f(zp[(size_t)ii * NPROJ]);
        pf_load<2, 16>(pv[cb], c.proj + row0 * NPROJ + C_HI + c.h * HD, NPROJ, tid); }
}
__device__ __forceinline__ void hs_step(Frame& F, f32x4 (&acc)[1][2], float (&zr)[HSB][4], Pf<2> (&pv)[HSB], const HsCtx& c, int cg) {
    const int r = F.lane & 15, q = F.lane >> 4, d = c.d, sg = c.sg, dir = c.dir;
    float lf[HSB][4], kk[HSB][4], mytot[HSB];
#pragma unroll
    for (int cb = 0; cb < HSB; ++cb) {
#pragma unroll
        for (int ii = 0; ii < 4; ++ii) { const float f = c.lb + (1.0f - c.lb) * fast_sigmoid(zr[cb][ii]); lf[cb][ii] = __logf(f); kk[cb][ii] = 1.0f - f; }
        if (dir == 0) { lf[cb][1] += lf[cb][0]; lf[cb][2] += lf[cb][1]; lf[cb][3] += lf[cb][2]; } else { lf[cb][2] += lf[cb][3]; lf[cb][1] += lf[cb][2]; lf[cb][0] += lf[cb][1]; }
        mytot[cb] = dir == 0 ? lf[cb][3] : lf[cb][0]; }
    __syncthreads();
#pragma unroll
    for (int cb = 0; cb < HSB; ++cb) { c.tot[cb * 512 + sg * 32 + d] = mytot[cb]; pf_store<2, 16>(c.vt + cb * 64 * 144, 144, F.tid, pv[cb]); }
    __syncthreads();
    if (cg + 2 < 64 / HSB) hs_load(zr, pv, c, cg + 2, F.tid);
#pragma unroll
    for (int cb = 0; cb < HSB; ++cb) {
        float other = 0.f, all = 0.f;
#pragma unroll
        for (int g = 0; g < 16; ++g) { const float tv = c.tot[cb * 512 + g * 32 + d]; all += tv; if (dir == 0 ? (g < sg) : (g > sg)) other += tv; }
        float kv[4];
#pragma unroll
        for (int ii = 0; ii < 4; ++ii) kv[ii] = kk[cb][ii] * __expf(all - (lf[cb][ii] + other));
        { u32x2 w; w.x = cvt_pk_bf16(kv[0], kv[1]); w.y = cvt_pk_bf16(kv[2], kv[3]); *(LAS u32x2*)(c.kpt + cb * 32 * 72 + d * 72 + 4 * sg) = w; }
        if (sg == 0) c.adec[cb * 32 + d] = __expf(all); }
    __syncthreads();
#pragma unroll
    for (int cb = 0; cb < HSB; ++cb) { const int ci = cg * HSB + cb, ch = dir ? 63 - ci : ci;
#pragma unroll
        for (int nt = 0; nt < 2; ++nt) { u32x2 w; w.x = cvt_pk_bf16(acc[0][nt][0], acc[0][nt][1]); w.y = cvt_pk_bf16(acc[0][nt][2], acc[0][nt][3]);
            *(u32x2*)(c.hst + ((((size_t)(c.bh * 2 + dir) * 64 + ch) * 128 + 16 * F.wave + r) * 128) + c.d0 + 16 * nt + 4 * q) = w; }
#pragma unroll
        for (int nt = 0; nt < 2; ++nt) { const f32x4 a4 = *(const LAS f32x4*)(c.adec + cb * 32 + 16 * nt + 4 * q); acc[0][nt] = acc[0][nt] * a4; }
        wave_mma_g<1, 2, true, true, false>(acc, c.vt + cb * 64 * 144 + 16 * F.wave, 144, c.kpt + cb * 32 * 72, 72, 64, F.lane); }
}
__device__ __forceinline__ void hgrn_state_pass(Frame& F, int first, int stride, const bf16* proj, const float* gatez, const float* lblog, int layer, bf16* hst) {
    for (int item = first; item < 128; item += stride) {
        HsCtx c; c.proj = proj; c.gatez = gatez; c.hst = hst;
        c.kpt = (LAS bf16*)F.lds; c.vt = c.kpt + HSB * 32 * 72; c.tot = (LAS float*)(c.vt + HSB * 64 * 144); c.adec = c.tot + HSB * 512;
        const int ds = item & 3; c.dir = (item >> 2) & 1; c.bh = item >> 3; c.b = c.bh >> 3; c.h = c.bh & 7; c.d0 = ds * 32; c.d = F.tid & 31; c.sg = F.tid >> 5;
        c.lb = hgrn_lb(lblog, layer, c.dir, c.h * HD + c.d0 + c.d);
        f32x4 acc[1][2]; acc[0][0] = (f32x4){0.f, 0.f, 0.f, 0.f}; acc[0][1] = (f32x4){0.f, 0.f, 0.f, 0.f};
        float zA[HSB][4], zB[HSB][4]; Pf<2> pvA[HSB], pvB[HSB];
        hs_load(zA, pvA, c, 0, F.tid); hs_load(zB, pvB, c, 1, F.tid);
        for (int cg = 0; cg < 64 / HSB; cg += 2) { hs_step(F, acc, zA, pvA, c, cg); hs_step(F, acc, zB, pvB, c, cg + 1); }
    }
    __syncthreads();
}
__device__ __forceinline__ void hgrn_output_pass(Frame& F, int first, int stride, int last, const bf16* proj, const float* gatez, const float* lblog, int layer, const bf16* hst, const float* hng, bf16* mixin) {
    LAS bf16* qd = (LAS bf16*)F.lds;
    LAS bf16* kd = qd + 64 * 136;
    LAS bf16* qx = kd + 64 * 136;
    LAS bf16* ps = qx + 64 * 136;
    LAS bf16* vt = ps + 64 * 72;
    LAS bf16* sT = vt + 64 * 144;
    LAS float* tot = (LAS float*)(sT + 128 * 136);
    LAS float* rsq = tot + 512;
    const int r = F.lane & 15, q = F.lane >> 4, rg = F.wave & 3, eh = F.wave >> 2;
    const int d = F.tid & 127, sq = F.tid >> 7;
    const int nitems = first < last ? (last - first + stride - 1) / stride : 0, nunits = 2 * nitems;
    if (nunits == 0) return;
    float zr[16]; unsigned short qr[16]; Pf<4> pst; Pf<2> pvv;
#define HO_ISSUE(u_) do { const int it_ = first + ((u_) >> 1) * stride, dr_ = (u_) & 1; const int ch_ = it_ & 63, bh_ = it_ >> 6, b_ = bh_ >> 3, h_ = bh_ & 7; const size_t r0_ = (size_t)b_ * SEQ + ch_ * 64; \
        const bf16* zp_ = proj + (r0_ + 16 * sq) * NPROJ + C_HFF + dr_ * HW + h_ * HD + d; const bf16* qp_ = proj + (r0_ + 16 * sq) * NPROJ + C_HQ + h_ * HD + d; \
        _Pragma("unroll") for (int ii = 0; ii < 16; ++ii) { zr[ii] = bf2f(zp_[(size_t)ii * NPROJ]); qr[ii] = qp_[(size_t)ii * NPROJ]; } \
        pf_load<4, 16>(pst, hst + (((size_t)(bh_ * 2 + dr_) * 64 + ch_) * 128) * 128, 128, F.tid); \
        if (dr_ == 0) pf_load<2, 16>(pvv, proj + r0_ * NPROJ + C_HI + h_ * HD, NPROJ, F.tid); } while (0)
    HO_ISSUE(0);
    f32x4 o[1][4];
    for (int u = 0; u < nunits; ++u) {
        const int item = first + (u >> 1) * stride, dir = u & 1;
        const int ch = item & 63, bh = item >> 6, b = bh >> 3, h = bh & 7; const size_t row0 = (size_t)b * SEQ + ch * 64;
        if (dir == 0) {
#pragma unroll
            for (int nt = 0; nt < 4; ++nt) o[0][nt] = (f32x4){0.f, 0.f, 0.f, 0.f};
        }
        const float lb = hgrn_lb(lblog, layer, dir, h * HD + d);
        float lf[16], kk[16], qv[16];
#pragma unroll
        for (int ii = 0; ii < 16; ++ii) { const float f = lb + (1.0f - lb) * fast_sigmoid(zr[ii]); lf[ii] = __logf(f); kk[ii] = 1.0f - f; qv[ii] = bf2f(qr[ii]) * 0.08838834764831845f; }
        if (dir == 0) {
#pragma unroll
            for (int ii = 1; ii < 16; ++ii) lf[ii] += lf[ii - 1];
        } else {
#pragma unroll
            for (int ii = 14; ii >= 0; --ii) lf[ii] += lf[ii + 1];
        }
        const float mytot = dir == 0 ? lf[15] : lf[0];
        __syncthreads();
        tot[sq * 128 + d] = mytot;
        if (dir == 0) pf_store<2, 16>(vt, 144, F.tid, pvv);
        pf_store<4, 16>(sT, 136, F.tid, pst);
        __syncthreads();
        if (u + 1 < nunits) HO_ISSUE(u + 1);
        const float t0 = tot[d], t1 = tot[128 + d], t2 = tot[256 + d], t3 = tot[384 + d];
        float other, R;
        if (dir == 0) { other = sq == 0 ? 0.f : (sq == 1 ? t0 : (sq == 2 ? t0 + t1 : t0 + t1 + t2)); R = t0 + t1; }
        else { other = sq == 3 ? 0.f : (sq == 2 ? t3 : (sq == 1 ? t3 + t2 : t3 + t2 + t1)); R = t3 + t2; }
#pragma unroll
        for (int ii = 0; ii < 16; ++ii) { const float cum = lf[ii] + other; const int t = 16 * sq + ii;
            const float ea = __expf(cum - R), eb = __expf(R - cum), ec = __expf(cum);
            qd[t * 136 + d] = (bf16)(cvt_pk_bf16(qv[ii] * ea, 0.f) & 0xffffu); kd[t * 136 + d] = (bf16)(cvt_pk_bf16(kk[ii] * eb, 0.f) & 0xffffu); qx[t * 136 + d] = (bf16)(cvt_pk_bf16(qv[ii] * ec, 0.f) & 0xffffu); }
        __syncthreads();
        { f32x4 s[1][2]; s[0][0] = (f32x4){0.f, 0.f, 0.f, 0.f}; s[0][1] = (f32x4){0.f, 0.f, 0.f, 0.f};
          wave_mma<1, 2, true>(s, qd + rg * 16 * 136, 136, kd + eh * 32 * 136, 136, 128, F.lane);
          const int t = 16 * rg + r;
#pragma unroll
          for (int nt = 0; nt < 2; ++nt) { float p[4];
#pragma unroll
              for (int j = 0; j < 4; ++j) { const int sk = 32 * eh + 16 * nt + 4 * q + j; const bool keep = dir == 0 ? (sk <= t) : (sk >= t); p[j] = keep ? s[0][nt][j] : 0.f; }
              u32x2 w; w.x = cvt_pk_bf16(p[0], p[1]); w.y = cvt_pk_bf16(p[2], p[3]);
              *(LAS u32x2*)(ps + t * 72 + 32 * eh + 16 * nt + 4 * q) = w; } }
        __syncthreads();
        wave_mma_g<1, 4, true, false, true>(o, ps + rg * 16 * 72, 72, vt + eh * 64, 144, 64, F.lane);
        wave_mma<1, 4, true>(o, qx + rg * 16 * 136, 136, sT + eh * 64 * 136, 136, 128, F.lane);
        if (dir == 1) {
            float ss = 0.f;
#pragma unroll
            for (int nt = 0; nt < 4; ++nt) ss += (o[0][nt][0] * o[0][nt][0] + o[0][nt][1] * o[0][nt][1]) + (o[0][nt][2] * o[0][nt][2] + o[0][nt][3] * o[0][nt][3]);
            ss += __shfl_xor(ss, 16); ss += __shfl_xor(ss, 32);
            const int t = 16 * rg + r;
            if (q == 0) rsq[t * 2 + eh] = ss;
            __syncthreads();
            const float rs = 1.0f / sqrtf((rsq[t * 2] + rsq[t * 2 + 1]) * (1.0f / HD) + RMS_EPS);
            const bf16* gp = proj + (row0 + t) * NPROJ + C_HG + h * HD + 64 * eh + 4 * q; bf16* op = mixin + (row0 + t) * D + RW + h * HD + 64 * eh + 4 * q; const float* gg = hng + h * HD + 64 * eh + 4 * q;
#pragma unroll
            for (int nt = 0; nt < 4; ++nt) { const u32x2 gt = *(const u32x2*)(gp + 16 * nt); const f32x4 g4 = *(const f32x4*)(gg + 16 * nt); const f32x4 v = o[0][nt] * rs * g4;
                u32x2 w; w.x = cvt_pk_bf16(v[0] * silu_f(bflo(gt.x)), v[1] * silu_f(bfhi(gt.x))); w.y = cvt_pk_bf16(v[2] * silu_f(bflo(gt.y)), v[3] * silu_f(bfhi(gt.y)));
                *(u32x2*)(op + 16 * nt) = w; }
        }
    }
#undef HO_ISSUE
    __syncthreads();
}

__device__ __forceinline__ void fourier_ut2(Frame& F, int bid, const bf16* proj, const bf16* fwt, bf16* ut2, float* nyq) {
    LAS bf16* zc = (LAS bf16*)F.lds;
    LAS bf16* zs = zc + 128 * 136;
    LAS bf16* ws = zs + 128 * 136;
    const int g = bid & 7, nb = (bid >> 3) & 15, b = bid >> 7;
    const bf16* zb = proj + (size_t)(b * SEQ) * NPROJ + C_FZ + g * FD;
    u32x4 ra[4], rb[4];
#pragma unroll
    for (int it = 0; it < 4; ++it) { const int i = F.tid + NWAVES * 64 * it, row = i >> 4, ch = i & 15, n = nb * 128 + row; const int mrow = (SEQ - n) & (SEQ - 1);
        ra[it] = *(const u32x4*)(zb + (size_t)n * NPROJ + ch * 8); rb[it] = *(const u32x4*)(zb + (size_t)mrow * NPROJ + ch * 8); }
    __syncthreads();
    stage_tile(ws, 136, fwt + (size_t)g * 256 * 128, 128, 256, 128, F.tid);
#pragma unroll
    for (int it = 0; it < 4; ++it) { const int i = F.tid + NWAVES * 64 * it, row = i >> 4, ch = i & 15, n = nb * 128 + row; const float k0 = n == 0 ? 0.f : 1.f;
        const u32x4 a = ra[it], m = rb[it]; u32x4 sc, sd;
        sc.x = cvt_pk_bf16(bflo(a.x) + k0 * bflo(m.x), bfhi(a.x) + k0 * bfhi(m.x)); sd.x = cvt_pk_bf16(k0 * (bflo(a.x) - bflo(m.x)), k0 * (bfhi(a.x) - bfhi(m.x)));
        sc.y = cvt_pk_bf16(bflo(a.y) + k0 * bflo(m.y), bfhi(a.y) + k0 * bfhi(m.y)); sd.y = cvt_pk_bf16(k0 * (bflo(a.y) - bflo(m.y)), k0 * (bfhi(a.y) - bfhi(m.y)));
        sc.z = cvt_pk_bf16(bflo(a.z) + k0 * bflo(m.z), bfhi(a.z) + k0 * bfhi(m.z)); sd.z = cvt_pk_bf16(k0 * (bflo(a.z) - bflo(m.z)), k0 * (bfhi(a.z) - bfhi(m.z)));
        sc.w = cvt_pk_bf16(bflo(a.w) + k0 * bflo(m.w), bfhi(a.w) + k0 * bfhi(m.w)); sd.w = cvt_pk_bf16(k0 * (bflo(a.w) - bflo(m.w)), k0 * (bfhi(a.w) - bfhi(m.w)));
        *(LAS u32x4*)(zc + row * 136 + ch * 8) = sc; *(LAS u32x4*)(zs + row * 136 + ch * 8) = sd; }
    __syncthreads();
    const int r = F.lane & 15, q = F.lane >> 4; const int n = nb * 128 + F.wave * 16 + 4 * q;
#pragma unroll
    for (int part = 0; part < 2; ++part) {
        f32x4 acc[1][8];
#pragma unroll
        for (int nt = 0; nt < 8; ++nt) acc[0][nt] = (f32x4){0.f, 0.f, 0.f, 0.f};
        wave_mma<1, 8, false>(acc, (part ? zs : zc) + F.wave * 16 * 136, 136, ws + part * 128 * 136, 136, 128, F.lane);
#pragma unroll
        for (int nt = 0; nt < 8; ++nt) { const int d = nt * 16 + r;
            u32x2 w; w.x = cvt_pk_bf16(acc[0][nt][0], acc[0][nt][1]); w.y = cvt_pk_bf16(acc[0][nt][2], acc[0][nt][3]);
            *(u32x2*)(ut2 + (size_t)(part * 2048 + b * FW + g * FD + d) * 2048 + n) = w; }
    }
    if (nb == 0 && F.tid < 128) {
        const int d = F.tid; const bf16* zr = zb + (size_t)2048 * NPROJ; float acc = 0.f;
        for (int c8 = 0; c8 < 16; ++c8) { const u32x4 zv = *(const u32x4*)(zr + c8 * 8); const u32x4 wv = *(const LAS u32x4*)(ws + d * 136 + c8 * 8);
            acc += bflo(zv.x) * bflo(wv.x) + bfhi(zv.x) * bfhi(wv.x) + bflo(zv.y) * bflo(wv.y) + bfhi(zv.y) * bfhi(wv.y) + bflo(zv.z) * bflo(wv.z) + bfhi(zv.z) * bfhi(wv.z) + bflo(zv.w) * bflo(wv.w) + bfhi(zv.w) * bfhi(wv.w); }
        nyq[b * FW + g * FD + d] = acc;
    }
    __syncthreads();
}
__device__ __forceinline__ void fourier_mid_row(Frame& F, int first_wave, int nwaves, const bf16* ut2, const float* nyq, const float* bias, bf16* mixin) {
    for (int c = first_wave; c < NB * FW; c += nwaves) {
        const u32x4* rowp = (const u32x4*)(ut2 + (size_t)c * 2048) + F.lane; float sacc = 0.f;
#pragma unroll
        for (int j = 0; j < 4; ++j) { const u32x4 v = rowp[64 * j]; sacc += (bflo(v.x) - bfhi(v.x)) + (bflo(v.y) - bfhi(v.y)) + (bflo(v.z) - bfhi(v.z)) + (bflo(v.w) - bfhi(v.w)); }
        sacc = wave_sum(sacc);
        if (F.lane == 0) { const int b = c >> 10, colm = c & 1023; const float y = sacc + nyq[c] + bias[colm];
            mixin[(size_t)(b * SEQ + 2048) * D + 3072 + colm] = (bf16)(cvt_pk_bf16(y, 0.f) & 0xffffu); }
    }
}

__device__ __forceinline__ void xattn_phase(Frame& F, const bf16* xq, const bf16* kvmem, bf16* xo) {
    LAS bf16* ra = (LAS bf16*)F.lds;
    LAS bf16* rb = ra + 128 * 264;
    for (int item = F.vcu; item < NB * XH * 32; item += F.G) {
        const int qb = item & 31, hd = (item >> 5) & 3, b = item >> 7;
        __syncthreads();
        stage_tile(ra, 264, xq + (size_t)(b * SEQ + qb * 128) * XW + hd * XD, XW, 128, 256, F.tid);
        f32x4 s[2][8];
#pragma unroll
        for (int hf = 0; hf < 2; ++hf) {
            if (hf) __syncthreads();
            stage_tile(rb, 264, kvmem + (size_t)(b * MEMT + hf * 128) * 2048 + hd * XD, 2048, 128, 256, F.tid);
            __syncthreads();
            f32x4 acc[1][8];
#pragma unroll
            for (int nt = 0; nt < 8; ++nt) acc[0][nt] = (f32x4){0.f, 0.f, 0.f, 0.f};
            wave_mma<1, 8, true>(acc, ra + F.wave * 16 * 264, 264, rb, 264, 256, F.lane);
#pragma unroll
            for (int nt = 0; nt < 8; ++nt) s[hf][nt] = acc[0][nt];
        }
        float mx = -1e30f;
#pragma unroll
        for (int hf = 0; hf < 2; ++hf)
#pragma unroll
            for (int nt = 0; nt < 8; ++nt)
#pragma unroll
                for (int j = 0; j < 4; ++j) mx = fmaxf(mx, s[hf][nt][j]);
        mx = fmaxf(mx, __shfl_xor(mx, 16)); mx = fmaxf(mx, __shfl_xor(mx, 32));
        float sum = 0.f;
#pragma unroll
        for (int hf = 0; hf < 2; ++hf)
#pragma unroll
            for (int nt = 0; nt < 8; ++nt)
#pragma unroll
                for (int j = 0; j < 4; ++j) { const float p = __expf(s[hf][nt][j] - mx); s[hf][nt][j] = p; sum += p; }
        sum += __shfl_xor(sum, 16); sum += __shfl_xor(sum, 32);
        const float inv = 1.0f / sum;
        __syncthreads();
        { const int r = F.lane & 15, q = F.lane >> 4; LAS bf16* prow = ra + (F.wave * 16 + r) * 264;
#pragma unroll
          for (int hf = 0; hf < 2; ++hf)
#pragma unroll
              for (int nt = 0; nt < 8; ++nt) { u32x2 w; w.x = cvt_pk_bf16(s[hf][nt][0], s[hf][nt][1]); w.y = cvt_pk_bf16(s[hf][nt][2], s[hf][nt][3]);
                  *(LAS u32x2*)(prow + hf * 128 + nt * 16 + 4 * q) = w; } }
        f32x4 o[1][16];
#pragma unroll
        for (int nt = 0; nt < 16; ++nt) o[0][nt] = (f32x4){0.f, 0.f, 0.f, 0.f};
#pragma unroll
        for (int hf = 0; hf < 2; ++hf) {
            if (hf) __syncthreads();
            stage_tile(rb, 272, kvmem + (size_t)(b * MEMT + hf * 128) * 2048 + 1024 + hd * XD, 2048, 128, 256, F.tid);
            __syncthreads();
            wave_mma_g<1, 16, true, false, true>(o, ra + F.wave * 16 * 264 + hf * 128, 264, rb, 272, 128, F.lane);
        }
        { const int r = F.lane & 15, q = F.lane >> 4; bf16* orow = xo + (size_t)(b * SEQ + qb * 128 + F.wave * 16 + r) * XW + hd * XD + 4 * q;
#pragma unroll
          for (int nt = 0; nt < 16; ++nt) { u32x2 w; w.x = cvt_pk_bf16(o[0][nt][0] * inv, o[0][nt][1] * inv); w.y = cvt_pk_bf16(o[0][nt][2] * inv, o[0][nt][3] * inv); *(u32x2*)(orow + nt * 16) = w; } }
    }
    __syncthreads();
}

#define AIN(k) ((const float*)(GAS const float*)args.in[k])
#define x_in (AIN(0))
#define mem (AIN(1))
#define mem_g (AIN(2))
#define W_in ((bf16*)(wsp + WS_WIN))
#define W_out ((bf16*)(wsp + WS_WOUT))
#define W_q ((bf16*)(wsp + WS_WQ))
#define W_kv ((bf16*)(wsp + WS_WKV))
#define W_o ((bf16*)(wsp + WS_WO))
#define W_gu ((bf16*)(wsp + WS_WGU))
#define W_dn ((bf16*)(wsp + WS_WDN))
#define anorm ((bf16*)(wsp + WS_ANORM))
#define proj ((bf16*)(wsp + WS_PROJ))
#define hid ((bf16*)(wsp + WS_PROJ))
#define gatez ((float*)(wsp + WS_GATEZ))
#define mixin ((bf16*)(wsp + WS_MIXIN))
#define tmpb ((bf16*)(wsp + WS_TMP))
#define rst ((bf16*)(wsp + WS_SCR))
#define hst ((bf16*)(wsp + WS_SCR + 128 * MiB))
#define dft ((bf16*)(wsp + WS_DFT))
#define ut ((bf16*)(wsp + WS_UT))
#define xq ((bf16*)(wsp + WS_XQ))
#define xo ((bf16*)(wsp + WS_XO))
#define kvmem ((bf16*)(wsp + WS_KVMEM))
#define memn ((bf16*)(wsp + WS_MEMN))
#define ropec ((float*)(wsp + WS_ROPE))
#define ropes ((float*)(wsp + WS_ROPE) + SEQ * 128)
#define fwt ((bf16*)(wsp + (layer == 0 ? WS_FWT : WS_FWT1)))
#define nyq ((float*)(wsp + WS_FWT + 640 * 1024))
#define rsv ((float*)(wsp + WS_FWT + 768 * 1024))
#define rqv ((float*)(wsp + WS_FWT + 832 * 1024))
#define hq ((signed char*)(wsp + WS_GATEZ))
#define cmaxf ((float*)(wsp + WS_CTL + 256 * 1024))
#define cminf ((float*)(wsp + WS_CTL + 448 * 1024))
#define hout ((float*)(GAS float*)args.out)
#define cq ((unsigned*)(wsp + WS_CTL) + CW_CONVQ)
#define cd (ConvDst{W_out, W_q, W_kv, W_o, W_gu, W_dn, W_in, cmaxf, cminf})
__global__ void __launch_bounds__(NWAVES * 64, 2) fwd_kernel(Args args) {
    extern __shared__ __attribute__((aligned(16))) unsigned char lds[];
    Frame F;
    F.lds = (LAS unsigned char*)lds;
    F.tid = threadIdx.x; F.lane = F.tid & 63; F.wave = __builtin_amdgcn_readfirstlane(F.tid >> 6);
    F.bid = blockIdx.x; F.G = gridDim.x; { const int bx = blockIdx.x; F.vcu = (F.G % 8 == 0) ? (bx % 8) * (F.G / 8) + bx / 8 : bx; }
    F.gw = F.vcu * NWAVES + F.wave; F.NGW = F.G * NWAVES;
    unsigned char* ws = (unsigned char*)(GAS unsigned char*)args.ws; F.ws = ws;
    volatile LAS unsigned* MISC = (volatile LAS unsigned*)(F.lds + MISC_OFF);
    for (int u = F.tid; u < (LDS_BYTES - LDSCTL_OFF) / 4; u += NWAVES * 64) ((LAS unsigned*)(F.lds + LDSCTL_OFF))[u] = 0u;
    __syncthreads();
    XcdBarrier bar; bar.bar = (unsigned*)(ws + WS_CTL) + CW_BAR; bar.x = 0; bar.st = nullptr;
    if (args.single) bar = xcd_barrier_post((unsigned*)(ws + WS_CTL) + CW_BAR, MISC + 8);
#define GRID_BAR() do { if (args.single) xcd_barrier(bar); } while (0)
#define RELAUNDER() do { { int b_ = blockIdx.x; asm volatile("" : "+s"(b_)); F.bid = b_; } wsp = (GAS unsigned char*)args.ws; asm volatile("" : "+s"(wsp)); int t_ = threadIdx.x; asm volatile("" : "+v"(t_)); F.tid = t_; F.lane = t_ & 63; F.wave = __builtin_amdgcn_readfirstlane(t_ >> 6); F.gw = F.vcu * NWAVES + F.wave; } while (0)

    GAS unsigned char* wsp = (GAS unsigned char*)args.ws;
    const int lo = args.ph_lo, hi = args.ph_hi;
#ifndef PHASE_MASK
#define PHASE_MASK 0xffffffffu
#endif
#define IN(k) (((PHASE_MASK >> (k)) & 1u) && lo <= (k) && (k) < hi)

    for (int layer = args.layer_lo; layer < args.layer_hi; ++layer) {
        const int cv_total = layer + 1 < NL ? CV_ITEMS_ALL : CV_ITEMS;
        if (IN(PH_PRE) && layer == 0) {
            RELAUNDER();
            const int gt = F.vcu * (NWAVES * 64) + F.tid, NT = F.G * NWAVES * 64;
            for (int i = gt; i < SEQ * 128; i += NT) { const int pos = i >> 7, j = i & 127;
                const float inv = exp2f(-(float)j * (13.287712379549449f / 128.0f)); const float ang = (float)pos * inv;
                const double rev = (double)ang * 0.15915494309189535; const float fr = (float)(rev - __builtin_rint(rev));
                ropec[i] = __builtin_amdgcn_cosf(fr); ropes[i] = __builtin_amdgcn_sinf(fr); }
            for (int i = gt; i < SEQ * 2048 / 8; i += NT) { const int k = i >> 8, c8 = (i & 255) * 8; const int sn = k >> 11, kk = k & 2047;
                float v[8];
#pragma unroll
                for (int j = 0; j < 8; ++j) { const int mm = (kk * (c8 + j)) & 4095; const float fr = (float)mm * (1.0f / 4096.0f); v[j] = sn ? __builtin_amdgcn_sinf(fr) : __builtin_amdgcn_cosf(fr); }
                u32x4 w; w.x = cvt_pk_bf16(v[0], v[1]); w.y = cvt_pk_bf16(v[2], v[3]); w.z = cvt_pk_bf16(v[4], v[5]); w.w = cvt_pk_bf16(v[6], v[7]);
                *(u32x4*)(dft + (size_t)k * 2048 + c8) = w; }
            for (int row = F.gw; row < NB * MEMT; row += F.NGW) rms_row_to_bf16(mem + (size_t)row * D, mem_g, memn + (size_t)row * D, F.lane);
            for (int l = 0; l < NL; ++l) { colmax_pass(F, AIN(19) + (size_t)l * D * FFH, D, FFH, AIN(18) + (size_t)l * D, cmaxf + (size_t)l * 2 * FFH);
                colmax_pass(F, AIN(20) + (size_t)l * D * FFH, D, FFH, AIN(18) + (size_t)l * D, cmaxf + (size_t)l * 2 * FFH + FFH);
                if (l >= 1) colmax_pass(F, AIN(4) + (size_t)l * D * NPROJ, D, NPROJ, AIN(3) + (size_t)l * D, cminf + (size_t)l * NPROJ); }
            { const int gt2 = F.vcu * (NWAVES * 64) + F.tid; if (gt2 < NPROJ) cminf[gt2] = 127.0f; }
        }
        if (IN(PH_CONV) && layer == 0) {
            RELAUNDER();
            LAS unsigned* scr = (LAS unsigned*)(F.lds + F.wave * 16384);
            convert_matrix(F, AIN(4), D, NPROJ, W_in, 0, 0, scr, AIN(3), nullptr);
            { const int gt = F.vcu * (NWAVES * 64) + F.tid, NT = F.G * NWAVES * 64;
              for (int i = gt; i < NL * FG * 32 * 128; i += NT) { const int c = i & 127, d4 = (i >> 7) & 31, g = (i >> 12) & (FG - 1), l = i >> 15;
                  const float* fw = AIN(8) + (size_t)l * FG * FD * FD + (size_t)g * FD * FD + 4 * d4;
                  f32x4 ac = (f32x4){0.f, 0.f, 0.f, 0.f}, as = ac;
#pragma unroll 16
                  for (int cp = 0; cp < 128; ++cp) { const float fr = (float)((c * cp) & 127) * (1.0f / 128.0f); const f32x4 w = *(const f32x4*)(fw + cp * FD); ac = ac + w * __builtin_amdgcn_cosf(fr); as = as - w * __builtin_amdgcn_sinf(fr); }
                  bf16* fo = (bf16*)(wsp + (l == 0 ? WS_FWT : WS_FWT1)) + ((size_t)g * 256 + 4 * d4) * 128 + c;
#pragma unroll
                  for (int jd = 0; jd < 4; ++jd) { fo[jd * 128] = (bf16)(cvt_pk_bf16(ac[jd] * 0.0013810679320049757f, 0.f) & 0xffff); fo[128 * 128 + jd * 128] = (bf16)(cvt_pk_bf16(as[jd] * 0.0013810679320049757f, 0.f) & 0xffff); } } }
            x_to_stream(F, x_in, anorm, rsv);
            __syncthreads();
            GRID_BAR();
        }
        if (IN(PH_INPROJ)) {
            RELAUNDER();
            if (layer == 0) { pg8::Gemm g{anorm, W_in, M, NPROJ, D}; pg8::StaticOrder S; S.init(M, NPROJ, F.G, F.bid);
              pg8::EpiInProj E{proj, ropec, ropes, rsv, cminf};
              pg8::gemm_phase<pg8::EpiInProj, pg8::StaticOrder, PG8_ALIGN, PG8_SP2, false>(F.lds, g, S, E); }
            else { pg8::Gemm g{(const bf16*)hq, W_in, M, NPROJ, D}; pg8::StaticOrder S; S.init(M, NPROJ, F.G, F.bid);
              pg8::EpiInProj E{proj, ropec, ropes, rqv, cminf + (size_t)layer * NPROJ};
              pg8::gemm_phase<pg8::EpiInProj, pg8::StaticOrder, PG8_ALIGN, PG8_SP2, true>(F.lds, g, S, E); }
            GRID_BAR();
        }
        if (IN(PH_MIXA)) {
            RELAUNDER();
            const int bid = F.bid;
            unsigned* donew = cq + 64 * (layer * 2 + 1);
            if (bid < 128) ret_state_pass(F, bid, 128, proj, rst);
            else hgrn_state_pass(F, bid - 128, 128, proj, gatez, AIN(6), layer, hst);
            RELAUNDER();
            fourier_ut2(F, bid, proj, fwt, ut, nyq);
            { VM_WAIT(); __syncthreads(); if (F.tid == 0) __hip_atomic_fetch_add(donew, 1u, __ATOMIC_RELAXED, __HIP_MEMORY_SCOPE_AGENT); }
            conv_pull(F, args.in, layer, cq + 64 * (layer * 2 + 0), cv_total, cv_total, cd, MISC + 16, donew, 256u);
            GRID_BAR();
        }
        if (IN(PH_MIXB)) {
            RELAUNDER();
            const int bid = F.bid; const float* hng = AIN(7) + (size_t)layer * HW; const float* fbias = AIN(9) + (size_t)layer * FW;
            if (bid < 64) {
                pg8::Gemm g{dft, ut, SEQ, SEQ, 2048};
                { pg8::OneUnit S{bid >> 3, bid & 7}; pg8::EpiF32 E{(float*)(ws + WS_TMP), 2048};
                  pg8::gemm_phase<pg8::EpiF32, pg8::OneUnit, PG8_ALIGN, PG8_SP2>(F.lds, g, S, E); }
                RELAUNDER();
                { pg8::OneUnit S{8 + (bid >> 3), 8 + (bid & 7)}; pg8::EpiFourier2 E{mixin, fbias, nyq, (const float*)(ws + WS_TMP)};
                  pg8::gemm_phase<pg8::EpiFourier2, pg8::OneUnit, PG8_ALIGN, PG8_SP2>(F.lds, g, S, E); }
                RELAUNDER();
                hgrn_output_pass(F, 832 + bid, 64, 1024, proj, gatez, AIN(6), layer, hst, hng, mixin);
            } else {
                const int idx = bid - 64;
                if (idx < 64) fourier_mid_row(F, idx * NWAVES + F.wave, 64 * NWAVES, ut, nyq, fbias, mixin);
                ret_output_pass(F, idx, 192, proj, rst, AIN(5) + (size_t)layer * RW, mixin);
                if (idx < 128) hgrn_output_pass(F, idx, 128, 384, proj, gatez, AIN(6), layer, hst, hng, mixin);
                else hgrn_output_pass(F, 384 + (idx - 128), 64, 832, proj, gatez, AIN(6), layer, hst, hng, mixin);
            }
            conv_pull(F, args.in, layer, cq + 64 * (layer * 2 + 0), CV_P_ITEMS, cv_total, cd, MISC + 16, nullptr, 0u);
            GRID_BAR();
        }
        if (IN(PH_WOUT)) {
            RELAUNDER();
            pg8::Gemm g{mixin, W_out, M, D, D}; pg8::StaticOrder S; S.init(M, D, F.G, F.bid);
            pg8::EpiBf16 E{tmpb, D, 1.0f, nullptr};
            pg8::gemm_phase<pg8::EpiBf16, pg8::StaticOrder, PG8_ALIGN, PG8_SP2>(F.lds, g, S, E);
            GRID_BAR();
        }
        if (IN(PH_NORM1)) {
            RELAUNDER();
            norm_phase(F, tmpb, layer == 0 ? x_in : nullptr, anorm, nullptr, AIN(11) + (size_t)layer * D, rsv);
            GRID_BAR();
        }
        if (IN(PH_XQ)) {
            RELAUNDER();
            { pg8::Gemm g{anorm, W_q, M, XW, D}; pg8::StaticOrder S; S.init(M, XW, F.G, F.bid);
              pg8::EpiBf16 E{xq, XW, 0.0625f, rsv};
              pg8::gemm_phase<pg8::EpiBf16, pg8::StaticOrder, PG8_ALIGN, PG8_SP2>(F.lds, g, S, E); }
            { pg8::Gemm g{memn, W_kv, NB * MEMT, 2 * XW, D}; pg8::StaticOrder S; S.init(NB * MEMT, 2 * XW, F.G, F.bid - 128);
              pg8::EpiBf16 E{kvmem, 2 * XW, 1.0f, nullptr};
              pg8::gemm_phase<pg8::EpiBf16, pg8::StaticOrder, PG8_ALIGN, PG8_SP2>(F.lds, g, S, E); }
            { unsigned* donex = cq + 64 * (4 + layer);
              if (F.bid < 144) { VM_WAIT(); __syncthreads(); if (F.tid == 0) __hip_atomic_fetch_add(donex, 1u, __ATOMIC_RELAXED, __HIP_MEMORY_SCOPE_AGENT); }
              conv_pull(F, args.in, layer, cq + 64 * (layer * 2 + 0), cv_total, cv_total, cd, MISC + 16, donex, 144u); }
            GRID_BAR();
        }
        if (IN(PH_XATT)) {
            RELAUNDER();
            xattn_phase(F, xq, kvmem, xo);
            GRID_BAR();
        }
        if (IN(PH_XWO)) {
            RELAUNDER();
            pg8::Gemm g{xo, W_o, M, D, XW}; pg8::StaticOrder S; S.init(M, D, F.G, F.bid);
            pg8::EpiBf16 E{tmpb, D, 1.0f, nullptr};
            pg8::gemm_phase<pg8::EpiBf16, pg8::StaticOrder, PG8_ALIGN, PG8_SP2>(F.lds, g, S, E);
            GRID_BAR();
        }
        if (IN(PH_NORM2)) {
            RELAUNDER();
            norm_phase_q(F, tmpb, anorm, AIN(17) + (size_t)layer * D, hq, rqv, nullptr);
            conv_pull(F, args.in, layer, cq + 64 * (layer * 2 + 0), CV_ITEMS, cv_total, cd, MISC + 16, nullptr, 0u);
            GRID_BAR();
        }
        if (IN(PH_FFN1)) {
            RELAUNDER();
            pg8::Gemm g{(const bf16*)hq, W_gu, M, 2 * FFH, D}; pg8::StaticOrder S; S.init(M, 2 * FFH, F.G, F.bid);
            pg8::EpiSwiGluQ E{hid, FFH, rqv, cmaxf + (size_t)layer * 2 * FFH, cmaxf + (size_t)layer * 2 * FFH + FFH};
            pg8::gemm_phase<pg8::EpiSwiGluQ, pg8::StaticOrder, PG8_ALIGN, PG8_SP2, true>(F.lds, g, S, E);
            if (layer + 1 < NL) {
                unsigned* donef = cq + 64 * (8 + layer);
                VM_WAIT(); __syncthreads(); if (F.tid == 0) __hip_atomic_fetch_add(donef, 1u, __ATOMIC_RELAXED, __HIP_MEMORY_SCOPE_AGENT);
                conv_pull(F, args.in, layer, cq + 64 * (layer * 2 + 0), cv_total, cv_total, cd, MISC + 16, donef, (unsigned)F.G);
            }
            GRID_BAR();
        }
        if (IN(PH_FFN2)) {
            RELAUNDER();
            pg8::Gemm g{hid, W_dn, M, D, FFH}; pg8::StaticOrder S; S.init(M, D, F.G, F.bid);
            pg8::EpiBf16 E{tmpb, D, 1.0f, nullptr};
            pg8::gemm_phase<pg8::EpiBf16, pg8::StaticOrder, PG8_ALIGN, PG8_SP2>(F.lds, g, S, E);
            GRID_BAR();
        }
        if (IN(PH_NORM3)) {
            RELAUNDER();
            const bool more = layer + 1 < NL;
            if (more) norm_phase_q(F, tmpb, anorm, AIN(22) + (size_t)layer * D, hq, rqv, rsv);
            else norm_phase(F, tmpb, nullptr, anorm, hout, AIN(22) + (size_t)layer * D, nullptr);
            if (more) conv_pull(F, args.in, layer, cq + 64 * (layer * 2 + 0), cv_total, cv_total, cd, MISC + 16, nullptr, 0u);
            if (more) GRID_BAR();
        }
    }
#undef IN
#undef GRID_BAR
}

#undef x_in
#undef mem
#undef mem_g
#undef W_in
#undef W_out
#undef W_q
#undef W_kv
#undef W_o
#undef W_gu
#undef W_dn
#undef anorm
#undef proj
#undef hid
#undef gatez
#undef mixin
#undef tmpb
#undef rst
#undef hst
#undef dft
#undef ut
#undef xq
#undef xo
#undef kvmem
#undef memn
#undef ropec
#undef ropes
#undef fwt
#undef nyq
#undef rsv
#undef rqv
#undef hq
#undef cmaxf
#undef cminf
#undef hout
#undef cq
#undef cd
extern "C" void kernel_launch(void* const* d_in, const int* in_sizes, int n_in, void* d_out, int out_size, void* d_ws, size_t ws_size, hipStream_t stream) {
    static int grid = 0;
    if (grid == 0) {
        if (n_in != 23 || out_size != M * D || ws_size < WS_END) { fprintf(stderr, "kernel_launch: unexpected shapes (n_in %d, out %d, ws %zu < %zu)\n", n_in, out_size, ws_size, (size_t)WS_END); grid = -1; return; }
        int dev = 0, cus = 0, per_cu = 0;
        if (hipGetDevice(&dev) != hipSuccess || hipDeviceGetAttribute(&cus, hipDeviceAttributeMultiprocessorCount, dev) != hipSuccess) { grid = -1; return; }
        if (hipFuncSetAttribute((const void*)fwd_kernel, hipFuncAttributeMaxDynamicSharedMemorySize, LDS_BYTES) != hipSuccess) { fprintf(stderr, "kernel_launch: hipFuncSetAttribute failed\n"); grid = -1; return; }
        if (hipOccupancyMaxActiveBlocksPerMultiprocessor(&per_cu, (const void*)fwd_kernel, NWAVES * 64, LDS_BYTES) != hipSuccess || per_cu < 1) fprintf(stderr, "kernel_launch: occupancy query reports %d\n", per_cu);
        (void)hipGetLastError();
        grid = cus;
    }
    if (grid < 0) return;
    (void)in_sizes;
    if (hipMemsetAsync((char*)d_ws + WS_CTL, 0, CTL_ZERO_BYTES, stream) != hipSuccess) return;
    Args a{};
    for (int i = 0; i < 23; ++i) a.in[i] = (const float*)d_in[i];
    a.out = (float*)d_out; a.ws = (unsigned char*)d_ws; a.pad = 0;
#if ONE_LAUNCH
    a.layer_lo = 0; a.layer_hi = NL; a.ph_lo = 0; a.ph_hi = PH_COUNT; a.single = 1;
    hipLaunchKernelGGL(fwd_kernel, dim3(grid), dim3(NWAVES * 64), LDS_BYTES, stream, a);
#else
    a.single = 0;
    for (int layer = 0; layer < NL; ++layer)
        for (int ph = (layer == 0 ? PH_PRE : PH_CONV); ph < PH_COUNT; ++ph) {
            a.layer_lo = layer; a.layer_hi = layer + 1; a.ph_lo = ph; a.ph_hi = ph + 1;
            hipLaunchKernelGGL(fwd_kernel, dim3(grid), dim3(NWAVES * 64), LDS_BYTES, stream, a);
        }
#endif
}
```

```cpp
#include <hip/hip_runtime.h>
#include <cstdio>
#include <cstdint>

#ifndef ONE_LAUNCH
#define ONE_LAUNCH 1
#endif

#define LAS __attribute__((address_space(3)))
#define GAS __attribute__((address_space(1)))
typedef unsigned short bf16;
typedef short bf16x8 __attribute__((ext_vector_type(8)));
typedef float f32x4 __attribute__((ext_vector_type(4)));
typedef float f32x2 __attribute__((ext_vector_type(2)));
typedef unsigned u32x4 __attribute__((ext_vector_type(4)));
typedef unsigned u32x2 __attribute__((ext_vector_type(2)));
typedef int i32x4 __attribute__((ext_vector_type(4)));

constexpr int D = 4096, NB = 2, SEQ = 4096, NL = 2, M = NB * SEQ;
constexpr int RW = 2048, RH = 8, RD = 256;
constexpr int HW = 1024, HH = 8, HD = 128;
constexpr int FW = 1024, FG = 8, FD = 128;
constexpr int NPROJ = 14336;
constexpr int XW = 1024, XH = 4, XD = 256, MEMT = 256;
constexpr int FFH = 11008;
constexpr int C_RQ = 0, C_RK = 2048, C_RV = 4096, C_RG = 6144, C_HQ = 8192, C_HFF = 9216, C_HFB = 10240, C_HI = 11264, C_HG = 12288, C_FZ = 13312;
constexpr float RMS_EPS = 1e-6f, GN_EPS = 1e-5f;

constexpr size_t MiB = 1u << 20;
constexpr size_t WS_CTL = 0, CTL_ZERO_BYTES = 1 * MiB;
constexpr size_t WS_WIN = 1 * MiB;
constexpr size_t WS_WOUT = 113 * MiB;
constexpr size_t WS_WQ = 145 * MiB;
constexpr size_t WS_WKV = 153 * MiB;
constexpr size_t WS_WO = 169 * MiB;
constexpr size_t WS_WGU = 177 * MiB;
constexpr size_t WS_WDN = 349 * MiB;
constexpr size_t WS_ANORM = 435 * MiB;
constexpr size_t WS_PROJ = 499 * MiB;
constexpr size_t WS_GATEZ = 723 * MiB;
constexpr size_t WS_MIXIN = 787 * MiB;
constexpr size_t WS_TMP = 851 * MiB;
constexpr size_t WS_SCR = 979 * MiB;
constexpr size_t WS_DFT = 1171 * MiB;
constexpr size_t WS_UT = 1235 * MiB;
constexpr size_t WS_XQ = 1267 * MiB;
constexpr size_t WS_XO = 1283 * MiB;
constexpr size_t WS_KVMEM = 1299 * MiB;
constexpr size_t WS_MEMN = 1301 * MiB;
constexpr size_t WS_ROPE = 1305 * MiB;
constexpr size_t WS_FWT = 1309 * MiB;
constexpr size_t WS_FWT1 = 1310 * MiB;
constexpr size_t WS_END = 1311 * MiB;
constexpr int CW_BAR = 4096, CW_CONVQ = 8192;

constexpr int LDS_BYTES = 147456;
constexpr int LDSCTL_OFF = LDS_BYTES - 512, MISC_OFF = LDSCTL_OFF + 320;
constexpr int NWAVES = 8;

typedef __bf16 bf16x2_t __attribute__((ext_vector_type(2)));
__device__ __forceinline__ unsigned cvt_pk_bf16(float lo, float hi) { const f32x2 v = {lo, hi}; return __builtin_bit_cast(unsigned, __builtin_convertvector(v, bf16x2_t)); }
__device__ __forceinline__ float bf2f(unsigned b) { return __uint_as_float(b << 16); }
__device__ __forceinline__ float bflo(unsigned w) { return __uint_as_float(w << 16); }
__device__ __forceinline__ float bfhi(unsigned w) { return __uint_as_float(w & 0xffff0000u); }
__device__ __forceinline__ float wave_sum(float v) {
#pragma unroll
    for (int o = 1; o < 64; o <<= 1) v += __shfl_xor(v, o);
    return v;
}
__device__ __forceinline__ float fast_sigmoid(float x) { return __builtin_amdgcn_rcpf(1.0f + __expf(-x)); }
__device__ __forceinline__ float silu_f(float x) { return x * fast_sigmoid(x); }
#define LDS_WAIT() asm volatile("s_waitcnt lgkmcnt(0)" ::: "memory")
#define VM_WAIT() asm volatile("s_waitcnt vmcnt(0)" ::: "memory")

namespace pg8 {
constexpr int BM = 256, BK = 64, HALF = 128, HTB = HALF * BK * 2, STAGE_BYTES = 8 * HTB, NXCD = 8, WGM = 8;
__host__ __device__ __forceinline__ int lds_byte(int r, int c) { const int st = (r >> 4) * 2 + (c >> 5), rr = r & 15, cc = c & 31, ob = rr * 64 + cc * 2; return st * 1024 + (ob ^ (((ob >> 9) & 1) << 5)); }
__host__ __device__ __forceinline__ void stage_rc(int b, int& R, int& C) { const int st = b / 1024, sb = b % 1024, swz = sb ^ (((sb >> 9) & 1) << 5); R = (st >> 1) * 16 + swz / 64; C = (st & 1) * 32 + (swz % 64) / 2; }
__host__ __device__ __forceinline__ int perm32(int rho) { const int n = rho >> 4, i = rho & 15; return 8 * (i >> 2) + 4 * n + (i & 3); }
struct Unit { int pm, pn; };
struct Gemm { const bf16* A; const bf16* Bt; int M, N, K; };
struct StaticOrder {
    int nM, nN, nwg, G, c;
    __host__ __device__ void init(int M_, int N_, int G_, int c_) { nM = M_ / BM; nN = N_ / BM; nwg = nM * nN; G = G_; c = c_; }
    __host__ __device__ bool next(int i, Unit& u) const {
        if (c < 0) return false;
        const long Lx = (long)i * G + c; if (Lx >= nwg) return false;
        int wgid = (int)Lx; { const int q = nwg / NXCD, r = nwg % NXCD, xcd = wgid % NXCD, off = wgid / NXCD; wgid = (xcd < r ? xcd * (q + 1) : r * (q + 1) + (xcd - r) * q) + off; }
        const int nig = WGM * nN, gid = wgid / nig, fm = gid * WGM, gsz = (nM - fm) < WGM ? (nM - fm) : WGM;
        u.pm = fm + ((wgid % nig) % gsz); u.pn = (wgid % nig) / gsz; return true;
    }
    __device__ __forceinline__ void a_ready(const Unit&) const {}
    __device__ __forceinline__ void done(const Unit&) const {}
};

struct EpiF32 {
    static constexpr bool PERM = false;
    static constexpr int NSCALE = 0; __device__ __forceinline__ const float* scale_ptr(const Unit&, int) const { return nullptr; }
    float* C; int ldc;
    __device__ __forceinline__ void operator()(const f32x4 (&acc)[2][2][4][2], const Unit& u, int wr, int wc, int fr, int fq, const LAS float* sl) const {
        const int row0 = u.pm * BM + wr * 64 + fr, col0 = u.pn * BM + wc * 32 + 4 * fq;
#pragma unroll
        for (int ai = 0; ai < 2; ++ai)
#pragma unroll
            for (int m = 0; m < 4; ++m) { float* rowp = C + (size_t)(row0 + ai * HALF + m * 16) * ldc + col0;
#pragma unroll
                for (int bj = 0; bj < 2; ++bj)
#pragma unroll
                    for (int n = 0; n < 2; ++n) *(f32x4*)(rowp + bj * HALF + n * 16) = acc[ai][bj][m][n]; }
    }
};
struct EpiBf16 {
    static constexpr bool PERM = true;
    static constexpr int NSCALE = 1;
    __device__ __forceinline__ const float* scale_ptr(const Unit& u, int) const { return rs ? rs + u.pm * BM : nullptr; }
    bf16* O; int ldc; float scale; const float* rs;
    __device__ __forceinline__ void operator()(const f32x4 (&acc)[2][2][4][2], const Unit& u, int wr, int wc, int fr, int fq, const LAS float* sl) const {
        const int row0 = u.pm * BM + wr * 64 + fr, col0 = u.pn * BM + wc * 32 + 8 * fq;
        float scv[2][4];
#pragma unroll
        for (int ai = 0; ai < 2; ++ai)
#pragma unroll
            for (int m = 0; m < 4; ++m) scv[ai][m] = rs ? scale * sl[wr * 64 + fr + ai * HALF + m * 16] : scale;
        asm volatile("" ::: "memory");
#pragma unroll
        for (int ai = 0; ai < 2; ++ai)
#pragma unroll
            for (int m = 0; m < 4; ++m) { bf16* rowp = O + (size_t)(row0 + ai * HALF + m * 16) * ldc + col0; const float sc = scv[ai][m];
#pragma unroll
                for (int bj = 0; bj < 2; ++bj) { const f32x4 v0 = acc[ai][bj][m][0] * sc, v1 = acc[ai][bj][m][1] * sc;
                    u32x4 w; w.x = cvt_pk_bf16(v0[0], v0[1]); w.y = cvt_pk_bf16(v0[2], v0[3]); w.z = cvt_pk_bf16(v1[0], v1[1]); w.w = cvt_pk_bf16(v1[2], v1[3]);
                    *(u32x4*)(rowp + bj * HALF) = w; } }
    }
};
struct EpiInProj {
    static constexpr bool PERM = true;
    static constexpr int NSCALE = 2;
    __device__ __forceinline__ const float* scale_ptr(const Unit& u, int k) const { return k == 0 ? rs + u.pm * BM : cm + u.pn * BM; }
    bf16* proj; const float* ropec; const float* ropes; const float* rs; const float* cm;
    __device__ __forceinline__ void operator()(const f32x4 (&acc)[2][2][4][2], const Unit& u, int wr, int wc, int fr, int fq, const LAS float* sl) const {
        const int row0 = u.pm * BM + wr * 64 + fr, colw = wc * 32 + 8 * fq;
        const LAS float* cp = sl + 256 + colw;
        const f32x4 ca0 = *(const LAS f32x4*)(cp) * (1.0f / 127.0f), ca1 = *(const LAS f32x4*)(cp + 4) * (1.0f / 127.0f), cb0 = *(const LAS f32x4*)(cp + HALF) * (1.0f / 127.0f), cb1 = *(const LAS f32x4*)(cp + HALF + 4) * (1.0f / 127.0f);
        float rsl[2][4];
#pragma unroll
        for (int ai = 0; ai < 2; ++ai)
#pragma unroll
            for (int m = 0; m < 4; ++m) rsl[ai][m] = sl[wr * 64 + fr + ai * HALF + m * 16];
        if (u.pn < 16) {
            const float sc0 = u.pn < 8 ? 0.0625f : 1.0f;
            const f32x4 C0 = *(const f32x4*)(ropec + 16 * 128 + colw), C1 = *(const f32x4*)(ropec + 16 * 128 + colw + 4), S0 = *(const f32x4*)(ropes + 16 * 128 + colw), S1 = *(const f32x4*)(ropes + 16 * 128 + colw + 4);
            f32x4 cc0[2], cc1[2], ss0[2], ss1[2];
#pragma unroll
            for (int ai = 0; ai < 2; ++ai) { const int pos0 = (row0 + ai * HALF) & (SEQ - 1);
                cc0[ai] = *(const f32x4*)(ropec + pos0 * 128 + colw); cc1[ai] = *(const f32x4*)(ropec + pos0 * 128 + colw + 4);
                ss0[ai] = *(const f32x4*)(ropes + pos0 * 128 + colw); ss1[ai] = *(const f32x4*)(ropes + pos0 * 128 + colw + 4); }
            asm volatile("" ::: "memory");
#pragma unroll
            for (int ai = 0; ai < 2; ++ai) {
                f32x4 c0 = cc0[ai], c1 = cc1[ai], s0 = ss0[ai], s1 = ss1[ai];
#pragma unroll
                for (int m = 0; m < 4; ++m) { const int r = row0 + ai * HALF + m * 16; const float sc = sc0 * rsl[ai][m];
                    if (m) { const f32x4 n0 = c0 * C0 - s0 * S0, n1 = c1 * C1 - s1 * S1; s0 = s0 * C0 + c0 * S0; s1 = s1 * C1 + c1 * S1; c0 = n0; c1 = n1; }
                    const f32x4 a0 = acc[ai][0][m][0] * ca0, a1 = acc[ai][0][m][1] * ca1, b0 = acc[ai][1][m][0] * cb0, b1 = acc[ai][1][m][1] * cb1;
                    const f32x4 o10 = (a0 * c0 - b0 * s0) * sc, o11 = (a1 * c1 - b1 * s1) * sc, o20 = (a0 * s0 + b0 * c0) * sc, o21 = (a1 * s1 + b1 * c1) * sc;
                    bf16* rowp = proj + (size_t)r * NPROJ + u.pn * BM + colw;
                    u32x4 w; w.x = cvt_pk_bf16(o10[0], o10[1]); w.y = cvt_pk_bf16(o10[2], o10[3]); w.z = cvt_pk_bf16(o11[0], o11[1]); w.w = cvt_pk_bf16(o11[2], o11[3]);
                    *(u32x4*)(rowp) = w;
                    w.x = cvt_pk_bf16(o20[0], o20[1]); w.y = cvt_pk_bf16(o20[2], o20[3]); w.z = cvt_pk_bf16(o21[0], o21[1]); w.w = cvt_pk_bf16(o21[2], o21[3]);
                    *(u32x4*)(rowp + HALF) = w; } }
        } else {
            asm volatile("" ::: "memory");
#pragma unroll
            for (int ai = 0; ai < 2; ++ai)
#pragma unroll
                for (int m = 0; m < 4; ++m) { bf16* rowp = proj + (size_t)(row0 + ai * HALF + m * 16) * NPROJ + u.pn * BM + colw; const float sc = rsl[ai][m];
                    { const f32x4 v0 = acc[ai][0][m][0] * ca0 * sc, v1 = acc[ai][0][m][1] * ca1 * sc;
                      u32x4 w; w.x = cvt_pk_bf16(v0[0], v0[1]); w.y = cvt_pk_bf16(v0[2], v0[3]); w.z = cvt_pk_bf16(v1[0], v1[1]); w.w = cvt_pk_bf16(v1[2], v1[3]); *(u32x4*)(rowp) = w; }
                    { const f32x4 v0 = acc[ai][1][m][0] * cb0 * sc, v1 = acc[ai][1][m][1] * cb1 * sc;
                      u32x4 w; w.x = cvt_pk_bf16(v0[0], v0[1]); w.y = cvt_pk_bf16(v0[2], v0[3]); w.z = cvt_pk_bf16(v1[0], v1[1]); w.w = cvt_pk_bf16(v1[2], v1[3]); *(u32x4*)(rowp + HALF) = w; } }
        }
    }
};
struct EpiSwiGlu {
    static constexpr bool PERM = true;
    static constexpr int NSCALE = 0; __device__ __forceinline__ const float* scale_ptr(const Unit&, int) const { return nullptr; }
    bf16* H; int ldc; const float* rs;
    __device__ __forceinline__ void operator()(const f32x4 (&acc)[2][2][4][2], const Unit& u, int wr, int wc, int fr, int fq, const LAS float* sl) const {
        const int row0 = u.pm * BM + wr * 64 + fr, col0 = u.pn * HALF + wc * 32 + 8 * fq;
#pragma unroll
        for (int ai = 0; ai < 2; ++ai)
#pragma unroll
            for (int m = 0; m < 4; ++m) { bf16* rowp = H + (size_t)(row0 + ai * HALF + m * 16) * ldc + col0; const float sc = rs[row0 + ai * HALF + m * 16];
                f32x4 v0, v1;
#pragma unroll
                for (int j = 0; j < 4; ++j) { v0[j] = silu_f(acc[ai][0][m][0][j] * sc) * (acc[ai][1][m][0][j] * sc); v1[j] = silu_f(acc[ai][0][m][1][j] * sc) * (acc[ai][1][m][1][j] * sc); }
                u32x4 w; w.x = cvt_pk_bf16(v0[0], v0[1]); w.y = cvt_pk_bf16(v0[2], v0[3]); w.z = cvt_pk_bf16(v1[0], v1[1]); w.w = cvt_pk_bf16(v1[2], v1[3]);
                *(u32x4*)(rowp) = w; }
    }
};
struct EpiSwiGluQ {
    static constexpr bool PERM = true;
    static constexpr int NSCALE = 3;
    __device__ __forceinline__ const float* scale_ptr(const Unit& u, int k) const { return k == 0 ? rq + u.pm * BM : (k == 1 ? cmg : cmu) + u.pn * HALF; }
    bf16* H; int ldc; const float* rq; const float* cmg; const float* cmu;
    __device__ __forceinline__ void operator()(const f32x4 (&acc)[2][2][4][2], const Unit& u, int wr, int wc, int fr, int fq, const LAS float* sl) const {
        const int row0 = u.pm * BM + wr * 64 + fr, col0 = u.pn * HALF + wc * 32 + 8 * fq;
        const int cl = wc * 32 + 8 * fq;
        const f32x4 sg0 = *(const LAS f32x4*)(sl + 256 + cl) * (1.0f / 127.0f), sg1 = *(const LAS f32x4*)(sl + 256 + cl + 4) * (1.0f / 127.0f);
        const f32x4 su0 = *(const LAS f32x4*)(sl + 512 + cl) * (1.0f / 127.0f), su1 = *(const LAS f32x4*)(sl + 512 + cl + 4) * (1.0f / 127.0f);
        float rql[2][4];
#pragma unroll
        for (int ai = 0; ai < 2; ++ai)
#pragma unroll
            for (int m = 0; m < 4; ++m) rql[ai][m] = sl[wr * 64 + fr + ai * HALF + m * 16];
        asm volatile("" ::: "memory");
#pragma unroll
        for (int ai = 0; ai < 2; ++ai)
#pragma unroll
            for (int m = 0; m < 4; ++m) { bf16* rowp = H + (size_t)(row0 + ai * HALF + m * 16) * ldc + col0; const float sc = rql[ai][m];
                f32x4 v0, v1;
#pragma unroll
                for (int j = 0; j < 4; ++j) { v0[j] = silu_f(acc[ai][0][m][0][j] * (sc * sg0[j])) * (acc[ai][1][m][0][j] * (sc * su0[j])); v1[j] = silu_f(acc[ai][0][m][1][j] * (sc * sg1[j])) * (acc[ai][1][m][1][j] * (sc * su1[j])); }
                u32x4 w; w.x = cvt_pk_bf16(v0[0], v0[1]); w.y = cvt_pk_bf16(v0[2], v0[3]); w.z = cvt_pk_bf16(v1[0], v1[1]); w.w = cvt_pk_bf16(v1[2], v1[3]);
                *(u32x4*)(rowp) = w; }
    }
};
struct SkipOrder : StaticOrder {
    int skip0, nskip;
    __device__ __forceinline__ bool next(int i, Unit& u) const { if (!StaticOrder::next(i, u)) return false; if (u.pn >= skip0) u.pn += nskip; return true; }
};
struct OneUnit {
    int pm, pn;
    __device__ __forceinline__ bool next(int i, Unit& u) const { if (pm < 0 || i > 0) return false; u.pm = pm; u.pn = pn; return true; }
    __device__ __forceinline__ void a_ready(const Unit&) const {}
    __device__ __forceinline__ void done(const Unit&) const {}
};
struct EpiFourier2 {
    static constexpr bool PERM = false;
    bf16* O; const float* bias; const float* nyq; const float* fa;
    static constexpr int NSCALE = 0; __device__ __forceinline__ const float* scale_ptr(const Unit&, int) const { return nullptr; }
    __device__ __forceinline__ void operator()(const f32x4 (&acc)[2][2][4][2], const Unit& u, int wr, int wc, int fr, int fq, const LAS float* sl) const {
        const int krow0 = (u.pm - 8) * BM + wr * 64 + fr, cbase = (u.pn - 8) * BM + wc * 32 + 4 * fq, b = cbase >> 10, colm0 = cbase & 1023;
#pragma unroll
        for (int ai = 0; ai < 2; ++ai)
#pragma unroll
            for (int m = 0; m < 4; ++m) { const int k = krow0 + ai * HALF + m * 16; const float sg = (k & 1) ? -1.0f : 1.0f;
                const float* ap = fa + (size_t)k * 2048 + cbase;
                bf16* row1 = O + (size_t)(b * SEQ + k) * D + 3072 + colm0; bf16* row2 = O + (size_t)(b * SEQ + ((SEQ - k) & (SEQ - 1))) * D + 3072 + colm0;
#pragma unroll
                for (int bj = 0; bj < 2; ++bj)
#pragma unroll
                    for (int n = 0; n < 2; ++n) { const int off = bj * HALF + n * 16;
                        const f32x4 av = *(const f32x4*)(ap + off); const f32x4 e = *(const f32x4*)(nyq + cbase + off) * sg + *(const f32x4*)(bias + colm0 + off); const f32x4 bv = acc[ai][bj][m][n];
                        const f32x4 p = av + bv + e, qv = av - bv + e;
                        u32x2 w; w.x = cvt_pk_bf16(p[0], p[1]); w.y = cvt_pk_bf16(p[2], p[3]); *(u32x2*)(row1 + off) = w;
                        if (k != 0) { w.x = cvt_pk_bf16(qv[0], qv[1]); w.y = cvt_pk_bf16(qv[2], qv[3]); *(u32x2*)(row2 + off) = w; } }
                asm volatile("" ::: "memory"); }
    }
};

template <class Epi, class Sched, bool ALIGN_EPI = false, bool SP2 = false, bool I8 = false>
__device__ __forceinline__ void gemm_phase(LAS unsigned char* lds, const Gemm g, const Sched& S, const Epi& E) {
    int tid_ = threadIdx.x; asm volatile("" : "+v"(tid_));
    const int tid = tid_, wid = __builtin_amdgcn_readfirstlane(tid >> 6), lane = tid & 63, wr = wid >> 2, wc = wid & 3, fr = lane & 15, fq = lane >> 4;
    const int KB = I8 ? g.K : 2 * g.K, nt = KB / (BK * 2);
    unsigned voffA[2], voffB[2];
#pragma unroll
    for (int i = 0; i < 2; ++i) { int R, C; stage_rc(tid * 16 + i * 8192, R, C); const int Rb = Epi::PERM ? ((R & ~31) + perm32(R & 31)) : R;
        voffA[i] = (unsigned)(R * KB + 2 * C); voffB[i] = (unsigned)(Rb * KB + 2 * C); }
    const size_t kstep = (size_t)(BK * 2);
    const size_t hstep = (size_t)HALF * KB;
    const size_t tstep = 2 * hstep;
    const unsigned ldsw = (unsigned)wid * 1024u;
    const int aoff = lds_byte(wr * 64 + fr, fq * 8), boff = lds_byte(wc * 32 + fr, fq * 8);
#define PG8_SA(b, h) (((b) * 2 + (h)) * HTB)
#define PG8_SB(b, h) ((4 + (b) * 2 + (h)) * HTB)
#define PG8_STAGE(bufoff, gbase, voff) do { _Pragma("unroll") for (int _i = 0; _i < 2; ++_i) \
        __builtin_amdgcn_global_load_lds((const unsigned*)((const char*)(gbase) + (voff)[_i]), (LAS unsigned*)(lds + (bufoff) + ldsw + _i * 8192), 16, 0, 0); } while (0)
#define PG8_LDA(dst, b, h) do { _Pragma("unroll") for (int m = 0; m < 4; ++m) _Pragma("unroll") for (int k = 0; k < 2; ++k) dst[m][k] = *(const LAS bf16x8*)(lds + PG8_SA(b, h) + aoff + m * 2048 + k * 1024); } while (0)
#define PG8_LDB(dst, b, h) do { _Pragma("unroll") for (int n = 0; n < 2; ++n) _Pragma("unroll") for (int k = 0; k < 2; ++k) dst[n][k] = *(const LAS bf16x8*)(lds + PG8_SB(b, h) + boff + n * 2048 + k * 1024); } while (0)
#define PG8_MMA(ai, bj, At, Bt) do { __builtin_amdgcn_s_setprio(1); _Pragma("unroll") for (int m = 0; m < 4; ++m) _Pragma("unroll") for (int n = 0; n < 2; ++n) _Pragma("unroll") for (int k = 0; k < 2; ++k) { \
        if constexpr (I8) acc[ai][bj][m][n] = __builtin_bit_cast(f32x4, __builtin_amdgcn_mfma_i32_16x16x64_i8(__builtin_bit_cast(i32x4, Bt[n][k]), __builtin_bit_cast(i32x4, At[m][k]), __builtin_bit_cast(i32x4, acc[ai][bj][m][n]), 0, 0, 0)); \
        else acc[ai][bj][m][n] = __builtin_amdgcn_mfma_f32_16x16x32_bf16(Bt[n][k], At[m][k], acc[ai][bj][m][n], 0, 0, 0); } __builtin_amdgcn_s_setprio(0); } while (0)
#define PG8_WAIT_V(n) asm volatile("s_waitcnt vmcnt(" #n ")" ::: "memory")
#define PG8_WAIT_L(n) asm volatile("s_waitcnt lgkmcnt(" #n ")" ::: "memory")
#define PG8_BAR __builtin_amdgcn_s_barrier()
#define PG8_SCHED __builtin_amdgcn_sched_barrier(0)
    Unit cur, nxt; int ui = 0;
    if (!S.next(0, cur)) return;
#define PG8_SCALES(unit, par) do { if constexpr (Epi::NSCALE > 0) { if (wid < Epi::NSCALE) { const float* gp_ = E.scale_ptr(unit, wid); \
        if (gp_) __builtin_amdgcn_global_load_lds((const unsigned*)(gp_ + 4 * lane), (LAS unsigned*)(lds + 8 * HTB + (par) * 3072 + wid * 1024), 16, 0, 0); } } } while (0)
    PG8_SCALES(cur, 0);
    f32x4 acc[2][2][4][2];
#pragma unroll
    for (int a = 0; a < 2; ++a)
#pragma unroll
        for (int b = 0; b < 2; ++b)
#pragma unroll
            for (int m = 0; m < 4; ++m)
#pragma unroll
                for (int n = 0; n < 2; ++n) acc[a][b][m][n] = (f32x4){0.f, 0.f, 0.f, 0.f};
    bf16x8 At[4][2], B0[2][2], B1[2][2];
    const char* cA = (const char*)g.A + (size_t)cur.pm * tstep; const char* cB = (const char*)g.Bt + (size_t)cur.pn * tstep;
    S.a_ready(cur);
    if constexpr (SP2) {
        PG8_STAGE(PG8_SB(0, 0), cB, voffB); PG8_STAGE(PG8_SB(0, 1), cB + hstep, voffB); PG8_STAGE(PG8_SA(0, 0), cA, voffA); PG8_STAGE(PG8_SA(0, 1), cA + hstep, voffA);
        if (wr == 1) PG8_BAR;
        PG8_WAIT_V(2); PG8_BAR;
        PG8_STAGE(PG8_SB(1, 0), cB + kstep, voffB); PG8_STAGE(PG8_SA(1, 0), cA + kstep, voffA); PG8_STAGE(PG8_SB(1, 1), cB + hstep + kstep, voffB);
        PG8_WAIT_V(6); PG8_BAR;
    } else {
        PG8_STAGE(PG8_SB(0, 0), cB, voffB); PG8_STAGE(PG8_SA(0, 0), cA, voffA); PG8_STAGE(PG8_SB(0, 1), cB + hstep, voffB); PG8_STAGE(PG8_SA(0, 1), cA + hstep, voffA);
        if (wr == 1) PG8_BAR;
        PG8_WAIT_V(4); PG8_BAR;
        PG8_STAGE(PG8_SB(1, 0), cB + kstep, voffB); PG8_STAGE(PG8_SA(1, 0), cA + kstep, voffA); PG8_STAGE(PG8_SB(1, 1), cB + hstep + kstep, voffB);
        PG8_WAIT_V(6); PG8_BAR;
    }
    for (;;) {
        const bool has_next = S.next(ui + 1, nxt);
        const char* nA = has_next ? (const char*)g.A + (size_t)nxt.pm * tstep : cA; const char* nB = has_next ? (const char*)g.Bt + (size_t)nxt.pn * tstep : cB;
        for (int t = 0; t < nt; t += 2) {
            const bool last = (t == nt - 2);
            const char* a1 = cA + (size_t)(t + 1) * kstep;
            const char* a2 = last ? nA : cA + (size_t)(t + 2) * kstep; const char* b2 = last ? nB : cB + (size_t)(t + 2) * kstep;
            const char* a3 = a2 + kstep; const char* b3 = b2 + kstep;
            if (last && has_next) { S.a_ready(nxt); PG8_SCALES(nxt, (ui + 1) & 1); }
            if constexpr (SP2) {
            PG8_LDB(B0, 0, 0); PG8_LDB(B1, 0, 1); PG8_SCHED; PG8_LDA(At, 0, 0); PG8_STAGE(PG8_SA(1, 1), a1 + hstep, voffA);
            PG8_WAIT_V(8); PG8_WAIT_L(0); PG8_BAR; PG8_MMA(0, 0, At, B0); PG8_MMA(0, 1, At, B1); PG8_BAR; PG8_SCHED;
            PG8_LDA(At, 0, 1); PG8_STAGE(PG8_SB(0, 0), b2, voffB); PG8_STAGE(PG8_SB(0, 1), b2 + hstep, voffB); PG8_STAGE(PG8_SA(0, 0), a2, voffA);
            PG8_WAIT_V(8); PG8_WAIT_L(0); PG8_BAR; PG8_MMA(1, 0, At, B0); PG8_MMA(1, 1, At, B1); PG8_BAR; PG8_SCHED;
            PG8_LDB(B0, 1, 0); PG8_LDB(B1, 1, 1); PG8_SCHED; PG8_LDA(At, 1, 0); PG8_STAGE(PG8_SA(0, 1), a2 + hstep, voffA);
            PG8_WAIT_V(8); PG8_WAIT_L(0); PG8_BAR; PG8_MMA(0, 0, At, B0); PG8_MMA(0, 1, At, B1); PG8_BAR; PG8_SCHED;
            PG8_LDA(At, 1, 1); PG8_STAGE(PG8_SB(1, 0), b3, voffB); PG8_STAGE(PG8_SB(1, 1), b3 + hstep, voffB); PG8_STAGE(PG8_SA(1, 0), a3, voffA);
            PG8_WAIT_V(8); PG8_WAIT_L(0); PG8_BAR; PG8_MMA(1, 0, At, B0); PG8_MMA(1, 1, At, B1); PG8_BAR; PG8_SCHED;
            } else {
            PG8_LDB(B0, 0, 0); PG8_SCHED; PG8_LDA(At, 0, 0); PG8_STAGE(PG8_SA(1, 1), a1 + hstep, voffA);
            PG8_WAIT_L(8); PG8_BAR; PG8_WAIT_L(0); PG8_MMA(0, 0, At, B0); PG8_BAR; PG8_SCHED;
            PG8_LDB(B1, 0, 1); PG8_STAGE(PG8_SB(0, 0), b2, voffB);
            PG8_BAR; PG8_WAIT_L(0); PG8_MMA(0, 1, At, B1); PG8_BAR;
            PG8_LDA(At, 0, 1); PG8_STAGE(PG8_SA(0, 0), a2, voffA);
            PG8_BAR; PG8_WAIT_L(0); PG8_MMA(1, 0, At, B0); PG8_BAR; PG8_SCHED;
            PG8_STAGE(PG8_SB(0, 1), b2 + hstep, voffB);
            PG8_WAIT_V(6); PG8_BAR; PG8_MMA(1, 1, At, B1); PG8_BAR;
            PG8_LDB(B0, 1, 0); PG8_SCHED; PG8_LDA(At, 1, 0); PG8_STAGE(PG8_SA(0, 1), a2 + hstep, voffA);
            PG8_WAIT_L(8); PG8_BAR; PG8_WAIT_L(0); PG8_MMA(0, 0, At, B0); PG8_BAR; PG8_SCHED;
            PG8_LDB(B1, 1, 1); PG8_STAGE(PG8_SB(1, 0), b3, voffB);
            PG8_BAR; PG8_WAIT_L(0); PG8_MMA(0, 1, At, B1); PG8_BAR;
            PG8_LDA(At, 1, 1); PG8_STAGE(PG8_SA(1, 0), a3, voffA);
            PG8_BAR; PG8_WAIT_L(0); PG8_MMA(1, 0, At, B0); PG8_BAR; PG8_SCHED;
            PG8_STAGE(PG8_SB(1, 1), b3 + hstep, voffB);
            PG8_WAIT_V(6); PG8_BAR; PG8_MMA(1, 1, At, B1); PG8_BAR;
            }
        }
        if constexpr (ALIGN_EPI) { if (wr == 0) PG8_BAR; }
        if constexpr (I8) {
#pragma unroll
            for (int a = 0; a < 2; ++a)
#pragma unroll
                for (int b = 0; b < 2; ++b)
#pragma unroll
                    for (int m = 0; m < 4; ++m)
#pragma unroll
                        for (int n = 0; n < 2; ++n) acc[a][b][m][n] = __builtin_convertvector(__builtin_bit_cast(i32x4, acc[a][b][m][n]), f32x4); }
        E(acc, cur, wr, wc, fr, fq, (const LAS float*)(lds + 8 * HTB + (ui & 1) * 3072)); S.done(cur);
        if (!has_next) break;
#pragma unroll
        for (int a = 0; a < 2; ++a)
#pragma unroll
            for (int b = 0; b < 2; ++b)
#pragma unroll
                for (int m = 0; m < 4; ++m)
#pragma unroll
                    for (int n = 0; n < 2; ++n) acc[a][b][m][n] = (f32x4){0.f, 0.f, 0.f, 0.f};
        cur = nxt; cA = nA; cB = nB; ++ui;
        if constexpr (ALIGN_EPI) { if (wr == 1) PG8_BAR; }
    }
    PG8_WAIT_V(0);
    if constexpr (!ALIGN_EPI) { if (wr == 0) PG8_BAR; }
    PG8_BAR;
#undef PG8_SCALES
#undef PG8_SA
#undef PG8_SB
#undef PG8_STAGE
#undef PG8_LDA
#undef PG8_LDB
#undef PG8_MMA
#undef PG8_WAIT_V
#undef PG8_WAIT_L
#undef PG8_BAR
#undef PG8_SCHED
}
}
#define PG8_SP2 true
#define PG8_ALIGN true

#define XB_TMO      128
#define XB_XCNT(j)  (256  + 64 * (j))
#define XB_XSUB(j)  (1280 + 64 * (j))
#define XB_XGEN(j)  (2304 + 64 * (j))
#define XB_TOP      3328
#define XB_TOPGEN   3392
#define XCD_BAR_WORDS 3456
#define XB_SPIN_CAP (1u << 18)
__device__ __forceinline__ unsigned xb_ld(unsigned* p)              { return __hip_atomic_load(p, __ATOMIC_RELAXED, __HIP_MEMORY_SCOPE_AGENT); }
__device__ __forceinline__ unsigned xb_add(unsigned* p, unsigned v) { return __hip_atomic_fetch_add(p, v, __ATOMIC_RELAXED, __HIP_MEMORY_SCOPE_AGENT); }
__device__ __forceinline__ unsigned xb_xcc_id() { return (unsigned)__builtin_amdgcn_s_getreg((3 << 11) | 20) & 0xFu; }
#define XB_SPIN(cond, bar) do { unsigned _sp = 0; while (cond) { __builtin_amdgcn_s_sleep(1); \
    if ((++_sp & 255u) == 0u) { if (xb_ld(&(bar)[XB_TMO])) break; if (_sp > XB_SPIN_CAP) { atomicAdd(&(bar)[XB_TMO], 1u); break; } } } } while (0)
struct XcdBarrier { unsigned* bar; unsigned x; volatile LAS unsigned* st; };
__device__ __forceinline__ XcdBarrier xcd_barrier_post(unsigned* bar, volatile LAS unsigned* st) {
    XcdBarrier b; b.bar = bar; b.x = xb_xcc_id(); b.st = st;
    if (threadIdx.x == 0) (void)xb_add(&bar[XB_XCNT(b.x)], 1u);
    return b;
}
__device__ __forceinline__ void xcd_barrier_complete(unsigned* bar, unsigned x, unsigned& nloc, unsigned& nx) {
    const unsigned G = gridDim.x * gridDim.y * gridDim.z;
    unsigned sum, cnt, mine, sp = 0u;
    for (;;) {
        sum = 0u; cnt = 0u; mine = 0u;
#pragma unroll
        for (unsigned j = 0; j < 16; ++j) { const unsigned c = xb_ld(&bar[XB_XCNT(j)]); sum += c; cnt += (c > 0u) ? 1u : 0u; mine = (j == x) ? c : mine; }
        if (sum == G) break;
        __builtin_amdgcn_s_sleep(1);
        if ((++sp & 255u) == 0u) { if (xb_ld(&bar[XB_TMO])) break; if (sp > XB_SPIN_CAP) { atomicAdd(&bar[XB_TMO], 1u); break; } }
    }
    nloc = mine > 0u ? mine : 1u; nx = cnt > 0u ? cnt : 1u;
}
__device__ __forceinline__ void xcd_barrier(const XcdBarrier& b) {
    asm volatile("s_waitcnt vmcnt(0)" ::: "memory");
    __syncthreads();
    if (threadIdx.x == 0) {
        unsigned* bar = b.bar;
        __builtin_amdgcn_s_waitcnt(0);
        unsigned nloc = b.st[0], nx = b.st[1];
        if (nloc == 0u) { xcd_barrier_complete(bar, b.x, nloc, nx); b.st[0] = nloc; b.st[1] = nx; }
        const unsigned old = xb_add(&bar[XB_XSUB(b.x)], 1u);
        const unsigned gen = old / nloc;
        if (old + 1u == (gen + 1u) * nloc) {
            __builtin_amdgcn_fence(__ATOMIC_RELEASE, "agent");
            asm volatile("s_waitcnt vmcnt(0)" ::: "memory");
            const unsigned og = xb_add(&bar[XB_TOP], 1u);
            const unsigned tg = og / nx;
            if (og + 1u == (tg + 1u) * nx) xb_add(&bar[XB_TOPGEN], 1u);
            else XB_SPIN(xb_ld(&bar[XB_TOPGEN]) == tg, bar);
            __builtin_amdgcn_fence(__ATOMIC_ACQUIRE, "agent");
            xb_add(&bar[XB_XGEN(b.x)], 1u);
            asm volatile("s_waitcnt vmcnt(0)" ::: "memory");
        } else {
            XB_SPIN(xb_ld(&bar[XB_XGEN(b.x)]) == gen, bar);
            __builtin_amdgcn_fence(__ATOMIC_ACQUIRE, "agent");
            asm volatile("s_waitcnt vmcnt(0)" ::: "memory");
        }
    }
    __syncthreads();
}

struct Args { const float* in[23]; float* out; unsigned char* ws; int layer_lo, layer_hi, ph_lo, ph_hi, single, pad; };
struct Frame {
    LAS unsigned char* lds;
    int tid, lane, wave, vcu, G, gw, NGW, bid;
    unsigned char* ws;
};
enum { PH_PRE = 0, PH_CONV, PH_INPROJ, PH_MIXA, PH_MIXB, PH_WOUT, PH_NORM1, PH_XQ, PH_XATT, PH_XWO, PH_NORM2, PH_FFN1, PH_FFN2, PH_NORM3, PH_COUNT };

__device__ __forceinline__ void transpose_item64(const float* W, int K, int N, bf16* WT, int drow0, int k0, int n0, LAS unsigned* scr, int lane, const float* gk) {
    const int m = lane & 15, kp = lane >> 4;
    f32x4 va[8], vb[8];
#pragma unroll
    for (int i = 0; i < 8; ++i) { const float* p = W + (size_t)(k0 + 8 * i + 2 * kp) * N + n0 + 4 * m; va[i] = __builtin_nontemporal_load((const f32x4*)p); vb[i] = __builtin_nontemporal_load((const f32x4*)(p + N)); }
    if (gk) {
#pragma unroll
        for (int i = 0; i < 8; ++i) { const f32x2 g2 = *(const f32x2*)(gk + k0 + 8 * i + 2 * kp); va[i] = va[i] * g2.x; vb[i] = vb[i] * g2.y; } }
#pragma unroll
    for (int i = 0; i < 8; ++i)
#pragma unroll
        for (int j = 0; j < 4; ++j) scr[(4 * m + j) * 33 + 4 * i + kp] = cvt_pk_bf16(va[i][j], vb[i][j]);
    LDS_WAIT(); asm volatile("" ::: "memory");
    const int c = lane & 7;
#pragma unroll
    for (int jj = 0; jj < 8; ++jj) { const int n = (lane >> 3) + 8 * jj; const LAS unsigned* sp = scr + n * 33 + 4 * c;
        u32x4 o; o.x = sp[0]; o.y = sp[1]; o.z = sp[2]; o.w = sp[3];
        __builtin_nontemporal_store(o, (u32x4*)(WT + (size_t)(drow0 + n) * K + k0 + 8 * c)); }
    LDS_WAIT(); asm volatile("" ::: "memory");
}
__device__ __forceinline__ void colmax_pass(Frame& F, const float* W, int K, int N, const float* gk, float* cmax) {
    const int nblk = N / 256, items = (K / 128) * nblk;
    for (int it = F.gw; it < items; it += F.NGW) { const int kb = it / nblk, nb = it - kb * nblk; const float* p = W + (size_t)(kb * 128) * N + nb * 256 + 4 * F.lane;
        f32x4 mx = (f32x4){0.f, 0.f, 0.f, 0.f};
#pragma unroll 8
        for (int kk = 0; kk < 128; ++kk) { const f32x4 w = __builtin_nontemporal_load((const f32x4*)(p + (size_t)kk * N)); const float g = gk[kb * 128 + kk];
            mx.x = fmaxf(mx.x, fabsf(w.x * g)); mx.y = fmaxf(mx.y, fabsf(w.y * g)); mx.z = fmaxf(mx.z, fabsf(w.z * g)); mx.w = fmaxf(mx.w, fabsf(w.w * g)); }
        unsigned* cm = (unsigned*)(cmax + nb * 256 + 4 * F.lane);
        atomicMax(cm + 0, __float_as_uint(mx.x)); atomicMax(cm + 1, __float_as_uint(mx.y)); atomicMax(cm + 2, __float_as_uint(mx.z)); atomicMax(cm + 3, __float_as_uint(mx.w)); }
}
__device__ __forceinline__ unsigned q8(float x) { int v = (int)__builtin_rintf(x); v = v < -127 ? -127 : (v > 127 ? 127 : v); return (unsigned)v & 0xffu; }
__device__ __forceinline__ void transpose_item64_q(const float* W, int K, int N, signed char* WT, int drow0, int k0, int n0, LAS unsigned* scr, int lane, const float* gk, const float* cmax) {
    const int m = lane & 15, kp = lane >> 4;
    f32x4 va[4][4];
#pragma unroll
    for (int i = 0; i < 4; ++i)
#pragma unroll
        for (int kk = 0; kk < 4; ++kk) va[i][kk] = __builtin_nontemporal_load((const f32x4*)(W + (size_t)(k0 + 16 * i + 4 * kp + kk) * N + n0 + 4 * m));
    const f32x4 cm = *(const f32x4*)(cmax + n0 + 4 * m);
    f32x4 inv; inv.x = cm.x > 0.f ? 127.0f / cm.x : 0.f; inv.y = cm.y > 0.f ? 127.0f / cm.y : 0.f; inv.z = cm.z > 0.f ? 127.0f / cm.z : 0.f; inv.w = cm.w > 0.f ? 127.0f / cm.w : 0.f;
#pragma unroll
    for (int i = 0; i < 4; ++i) { const f32x4 g4 = *(const f32x4*)(gk + k0 + 16 * i + 4 * kp);
#pragma unroll
        for (int j = 0; j < 4; ++j) { const float sj = inv[j];
            scr[(4 * m + j) * 17 + 4 * i + kp] = q8(va[i][0][j] * g4.x * sj) | (q8(va[i][1][j] * g4.y * sj) << 8) | (q8(va[i][2][j] * g4.z * sj) << 16) | (q8(va[i][3][j] * g4.w * sj) << 24); } }
    LDS_WAIT(); asm volatile("" ::: "memory");
    const int c = lane & 3;
#pragma unroll
    for (int jj = 0; jj < 4; ++jj) { const int n = (lane >> 2) + 16 * jj; const LAS unsigned* sp = scr + n * 17 + 4 * c;
        u32x4 o; o.x = sp[0]; o.y = sp[1]; o.z = sp[2]; o.w = sp[3];
        __builtin_nontemporal_store(o, (u32x4*)(WT + (size_t)(drow0 + n) * K + k0 + 16 * c)); }
    LDS_WAIT(); asm volatile("" ::: "memory");
}
__device__ __forceinline__ void convert_matrix(Frame& F, const float* W, int K, int N, bf16* WT, int row_off, int mode, LAS unsigned* scr, const float* gk, const float* cmq) {
    const int nblk = N / 64, items = (K / 64) * nblk;
    for (int it = F.gw; it < items; it += F.NGW) {
        const int kb = it / nblk, nb = it % nblk, n0 = 64 * nb;
        const int drow0 = mode == 0 ? row_off + n0 : ((n0 >> 7) * 256 + (mode == 2 ? 128 : 0) + (n0 & 127));
        if (cmq) transpose_item64_q(W, K, N, (signed char*)WT, drow0, 64 * kb, n0, scr, F.lane, gk, cmq);
        else transpose_item64(W, K, N, WT, drow0, 64 * kb, n0, scr, F.lane, gk);
    }
}

constexpr int CV1 = 64 * 64, CV2 = CV1 + 64 * 16, CV3 = CV2 + 64 * 16, CV4 = CV3 + 64 * 16, CV5 = CV4 + 16 * 64, CV6 = CV5 + 64 * 172, CV7 = CV6 + 64 * 172, CV8 = CV7 + 172 * 64;
constexpr int CV9 = CV8 + 64 * 224;
constexpr int CV_PER_ITEM = 32, CV_ITEMS = CV8 / CV_PER_ITEM, CV_ITEMS_ALL = CV9 / CV_PER_ITEM, CV_P_ITEMS = CV5 / CV_PER_ITEM;
static_assert(CV8 % CV_PER_ITEM == 0 && CV5 % CV_PER_ITEM == 0 && CV9 % CV_PER_ITEM == 0, "conversion tiles per item");
struct ConvDst { bf16 *W_out, *W_q, *W_kv, *W_o, *W_gu, *W_dn, *W_in; const float* cmax; const float* cmin; };
__device__ __forceinline__ void convert_tile(const float* const* in_, int layer, int tt, const ConvDst& cd, LAS unsigned* scr, int lane) {
    struct { const float* const* p; __device__ __forceinline__ const float* operator[](int k) const { return (const float*)(GAS const float*)p[k]; } } in{in_};
    const float* W; const float* gk = nullptr; int K, N, row_off = 0, mode = 0, loc; bf16* WT;
    if (tt < CV1)      { W = in[10] + (size_t)layer * D * D;    K = D;   N = D;   WT = cd.W_out; loc = tt; }
    else if (tt < CV2) { W = in[13] + (size_t)layer * D * XW;   K = D;   N = XW;  WT = cd.W_q;  loc = tt - CV1; gk = in[12] + (size_t)layer * D; }
    else if (tt < CV3) { W = in[14] + (size_t)layer * D * XW;   K = D;   N = XW;  WT = cd.W_kv; loc = tt - CV2; }
    else if (tt < CV4) { W = in[15] + (size_t)layer * D * XW;   K = D;   N = XW;  WT = cd.W_kv; loc = tt - CV3; row_off = XW; }
    else if (tt < CV5) { W = in[16] + (size_t)layer * XW * D;   K = XW;  N = D;   WT = cd.W_o;  loc = tt - CV4; }
    else if (tt < CV6) { W = in[19] + (size_t)layer * D * FFH;  K = D;   N = FFH; WT = cd.W_gu; loc = tt - CV5; mode = 1; gk = in[18] + (size_t)layer * D; }
    else if (tt < CV7) { W = in[20] + (size_t)layer * D * FFH;  K = D;   N = FFH; WT = cd.W_gu; loc = tt - CV6; mode = 2; gk = in[18] + (size_t)layer * D; }
    else if (tt < CV8) { W = in[21] + (size_t)layer * FFH * D;  K = FFH; N = D;   WT = cd.W_dn; loc = tt - CV7; }
    else               { W = in[4] + (size_t)(layer + 1) * D * NPROJ; K = D; N = NPROJ; WT = cd.W_in; loc = tt - CV8; gk = in[3] + (size_t)(layer + 1) * D; }
    const int nblk = N / 64, kb = loc / nblk, nb = loc - kb * nblk, n0 = 64 * nb;
    const int drow0 = mode == 0 ? row_off + n0 : ((n0 >> 7) * 256 + (mode == 2 ? 128 : 0) + (n0 & 127));
    if (tt >= CV8) transpose_item64_q(W, K, N, (signed char*)WT, drow0, 64 * kb, n0, scr, lane, gk, cd.cmin + (size_t)(layer + 1) * NPROJ);
    else if (mode != 0) transpose_item64_q(W, K, N, (signed char*)WT, drow0, 64 * kb, n0, scr, lane, gk, cd.cmax + (size_t)layer * 2 * FFH + (mode == 2 ? FFH : 0));
    else transpose_item64(W, K, N, WT, drow0, 64 * kb, n0, scr, lane, gk);
}
__device__ __forceinline__ unsigned conv_next(unsigned* q, unsigned limit, unsigned* stopw, unsigned stopv) {
    if (stopw && __hip_atomic_load(stopw, __ATOMIC_RELAXED, __HIP_MEMORY_SCOPE_AGENT) >= stopv) return 0xffffffffu;
    if (__hip_atomic_load(q, __ATOMIC_RELAXED, __HIP_MEMORY_SCOPE_AGENT) >= limit) return 0xffffffffu;
    return __hip_atomic_fetch_add(q, 1u, __ATOMIC_RELAXED, __HIP_MEMORY_SCOPE_AGENT);
}
__device__ __forceinline__ void conv_pull(Frame& F, const float* const* in, int layer, unsigned* q, int limit, int count, const ConvDst& cd, volatile LAS unsigned* slot, unsigned* stopw, unsigned stopv) {
    LAS unsigned* scr = (LAS unsigned*)(F.lds + F.wave * 16384);
    __syncthreads();
    unsigned nxt = 0xffffffffu;
    if (F.tid == 0) nxt = conv_next(q, (unsigned)limit, stopw, stopv);
    for (;;) {
        if (F.tid == 0) slot[0] = nxt;
        __syncthreads();
        const unsigned cur = slot[0];
        __syncthreads();
        if (cur >= (unsigned)count) break;
        if (F.tid == 0) {
            if (limit < count) nxt = conv_next(q, (unsigned)limit, stopw, stopv);
            else if (stopw && __hip_atomic_load(stopw, __ATOMIC_RELAXED, __HIP_MEMORY_SCOPE_AGENT) >= stopv) nxt = 0xffffffffu;
            else nxt = __hip_atomic_fetch_add(q, 1u, __ATOMIC_RELAXED, __HIP_MEMORY_SCOPE_AGENT);
        }
        const int t0 = (int)cur * CV_PER_ITEM + F.wave * (CV_PER_ITEM / NWAVES);
#pragma unroll 1
        for (int e = 0; e < CV_PER_ITEM / NWAVES; ++e) convert_tile(in, layer, t0 + e, cd, scr, F.lane);
    }
}

__device__ __forceinline__ void rms_row_to_bf16(const float* xrow, const float* g, bf16* orow, int lane) {
    const f32x4* xr = (const f32x4*)xrow + lane; const f32x4* gr = (const f32x4*)g + lane;
    f32x4 v[16]; float s = 0.f;
#pragma unroll
    for (int j = 0; j < 16; ++j) { v[j] = xr[64 * j]; s += (v[j].x * v[j].x + v[j].y * v[j].y) + (v[j].z * v[j].z + v[j].w * v[j].w); }
    const float r = 1.0f / sqrtf(wave_sum(s) * (1.0f / D) + RMS_EPS);
    u32x2* o8 = (u32x2*)orow + lane;
#pragma unroll
    for (int j = 0; j < 16; ++j) { const f32x4 gg = gr[64 * j]; u32x2 w; w.x = cvt_pk_bf16(v[j].x * r * gg.x, v[j].y * r * gg.y); w.y = cvt_pk_bf16(v[j].z * r * gg.z, v[j].w * r * gg.w); o8[64 * j] = w; }
}
__device__ __forceinline__ void norm_phase(Frame& F, const bf16* tmp, const float* hin32, bf16* hb, float* out32, const float* gpost, float* rs_out) {
    LAS float* gl = (LAS float*)F.lds;
    __syncthreads();
    for (int i = F.tid; i < D / 4; i += NWAVES * 64) ((LAS f32x4*)gl)[i] = ((const f32x4*)gpost)[i];
    __syncthreads();
    for (int row0 = F.gw; row0 < M; row0 += 2 * F.NGW) {
        f32x4 v[2][16]; float s[2] = {0.f, 0.f};
#pragma unroll
        for (int rr = 0; rr < 2; ++rr) { const int row = row0 + rr * F.NGW; const u32x4* tr = (const u32x4*)(tmp + (size_t)row * D) + F.lane;
#pragma unroll
            for (int j = 0; j < 8; ++j) { const u32x4 w = __builtin_nontemporal_load(tr + 64 * j);
                v[rr][2 * j] = (f32x4){bflo(w.x), bfhi(w.x), bflo(w.y), bfhi(w.y)}; v[rr][2 * j + 1] = (f32x4){bflo(w.z), bfhi(w.z), bflo(w.w), bfhi(w.w)}; }
        }
#pragma unroll
        for (int rr = 0; rr < 2; ++rr)
#pragma unroll
            for (int j = 0; j < 16; ++j) s[rr] += (v[rr][j].x * v[rr][j].x + v[rr][j].y * v[rr][j].y) + (v[rr][j].z * v[rr][j].z + v[rr][j].w * v[rr][j].w);
#pragma unroll
        for (int o = 1; o < 64; o <<= 1) { s[0] += __shfl_xor(s[0], o); s[1] += __shfl_xor(s[1], o); }
        float s2[2] = {0.f, 0.f};
#pragma unroll
        for (int rr = 0; rr < 2; ++rr) { const int row = row0 + rr * F.NGW; const float r = 1.0f / sqrtf(s[rr] * (1.0f / D) + RMS_EPS);
            u32x4* hbr = (u32x4*)(hb + (size_t)row * D) + F.lane;
            u32x4 hw[8];
            if (!hin32) {
#pragma unroll
                for (int j = 0; j < 8; ++j) hw[j] = __builtin_nontemporal_load(hbr + 64 * j); }
            asm volatile("" ::: "memory");
#pragma unroll
            for (int j = 0; j < 8; ++j) { const int off = 8 * F.lane + 512 * j;
                f32x4 h0, h1;
                if (hin32) { h0 = *(const f32x4*)(hin32 + (size_t)row * D + off); h1 = *(const f32x4*)(hin32 + (size_t)row * D + off + 4); }
                else { const u32x4 w = hw[j]; h0 = (f32x4){bflo(w.x), bfhi(w.x), bflo(w.y), bfhi(w.y)}; h1 = (f32x4){bflo(w.z), bfhi(w.z), bflo(w.w), bfhi(w.w)}; }
                const f32x4 g0 = *(const LAS f32x4*)(gl + off), g1 = *(const LAS f32x4*)(gl + off + 4);
                h0 = h0 + v[rr][2 * j] * r * g0; h1 = h1 + v[rr][2 * j + 1] * r * g1;
                s2[rr] += (h0.x * h0.x + h0.y * h0.y) + (h0.z * h0.z + h0.w * h0.w) + (h1.x * h1.x + h1.y * h1.y) + (h1.z * h1.z + h1.w * h1.w);
                if (out32) { *(f32x4*)(out32 + (size_t)row * D + off) = h0; *(f32x4*)(out32 + (size_t)row * D + off + 4) = h1; }
                else { u32x4 w; w.x = cvt_pk_bf16(h0.x, h0.y); w.y = cvt_pk_bf16(h0.z, h0.w); w.z = cvt_pk_bf16(h1.x, h1.y); w.w = cvt_pk_bf16(h1.z, h1.w); hbr[64 * j] = w; } } }
        if (rs_out) {
#pragma unroll
            for (int o = 1; o < 64; o <<= 1) { s2[0] += __shfl_xor(s2[0], o); s2[1] += __shfl_xor(s2[1], o); }
            if (F.lane == 0) { rs_out[row0] = 1.0f / sqrtf(s2[0] * (1.0f / D) + RMS_EPS); rs_out[row0 + F.NGW] = 1.0f / sqrtf(s2[1] * (1.0f / D) + RMS_EPS); }
        }
    }
}
__device__ __forceinline__ void norm_phase_q(Frame& F, const bf16* tmp, bf16* hb, const float* gpost, signed char* hq, float* rq, float* rs_out) {
    LAS float* gl = (LAS float*)F.lds;
    __syncthreads();
    for (int i = F.tid; i < D / 4; i += NWAVES * 64) ((LAS f32x4*)gl)[i] = ((const f32x4*)gpost)[i];
    __syncthreads();
    for (int row0 = F.gw; row0 < M; row0 += 2 * F.NGW) {
        f32x4 v[2][16]; float s[2] = {0.f, 0.f};
#pragma unroll
        for (int rr = 0; rr < 2; ++rr) { const int row = row0 + rr * F.NGW; const u32x4* tr = (const u32x4*)(tmp + (size_t)row * D) + F.lane;
#pragma unroll
            for (int j = 0; j < 8; ++j) { const u32x4 w = __builtin_nontemporal_load(tr + 64 * j);
                v[rr][2 * j] = (f32x4){bflo(w.x), bfhi(w.x), bflo(w.y), bfhi(w.y)}; v[rr][2 * j + 1] = (f32x4){bflo(w.z), bfhi(w.z), bflo(w.w), bfhi(w.w)}; }
        }
#pragma unroll
        for (int rr = 0; rr < 2; ++rr)
#pragma unroll
            for (int j = 0; j < 16; ++j) s[rr] += (v[rr][j].x * v[rr][j].x + v[rr][j].y * v[rr][j].y) + (v[rr][j].z * v[rr][j].z + v[rr][j].w * v[rr][j].w);
#pragma unroll
        for (int o = 1; o < 64; o <<= 1) { s[0] += __shfl_xor(s[0], o); s[1] += __shfl_xor(s[1], o); }
        float s2[2] = {0.f, 0.f}, am[2] = {0.f, 0.f};
#pragma unroll
        for (int rr = 0; rr < 2; ++rr) { const int row = row0 + rr * F.NGW; const float r = 1.0f / sqrtf(s[rr] * (1.0f / D) + RMS_EPS);
            u32x4* hbr = (u32x4*)(hb + (size_t)row * D) + F.lane;
            u32x4 hw[8];
#pragma unroll
            for (int j = 0; j < 8; ++j) hw[j] = __builtin_nontemporal_load(hbr + 64 * j);
            asm volatile("" ::: "memory");
#pragma unroll
            for (int j = 0; j < 8; ++j) { const int off = 8 * F.lane + 512 * j;
                const u32x4 w = hw[j]; f32x4 h0 = (f32x4){bflo(w.x), bfhi(w.x), bflo(w.y), bfhi(w.y)}, h1 = (f32x4){bflo(w.z), bfhi(w.z), bflo(w.w), bfhi(w.w)};
                const f32x4 g0 = *(const LAS f32x4*)(gl + off), g1 = *(const LAS f32x4*)(gl + off + 4);
                h0 = h0 + v[rr][2 * j] * r * g0; h1 = h1 + v[rr][2 * j + 1] * r * g1;
                s2[rr] += (h0.x * h0.x + h0.y * h0.y) + (h0.z * h0.z + h0.w * h0.w) + (h1.x * h1.x + h1.y * h1.y) + (h1.z * h1.z + h1.w * h1.w);
                am[rr] = fmaxf(am[rr], fmaxf(fmaxf(fmaxf(fabsf(h0.x), fabsf(h0.y)), fmaxf(fabsf(h0.z), fabsf(h0.w))), fmaxf(fmaxf(fabsf(h1.x), fabsf(h1.y)), fmaxf(fabsf(h1.z), fabsf(h1.w)))));
                v[rr][2 * j] = h0; v[rr][2 * j + 1] = h1;
                u32x4 wo; wo.x = cvt_pk_bf16(h0.x, h0.y); wo.y = cvt_pk_bf16(h0.z, h0.w); wo.z = cvt_pk_bf16(h1.x, h1.y); wo.w = cvt_pk_bf16(h1.z, h1.w); hbr[64 * j] = wo; } }
#pragma unroll
        for (int o = 1; o < 64; o <<= 1) { s2[0] += __shfl_xor(s2[0], o); s2[1] += __shfl_xor(s2[1], o); am[0] = fmaxf(am[0], __shfl_xor(am[0], o)); am[1] = fmaxf(am[1], __shfl_xor(am[1], o)); }
#pragma unroll
        for (int rr = 0; rr < 2; ++rr) { const int row = row0 + rr * F.NGW; const float inv = am[rr] > 0.f ? 127.0f / am[rr] : 0.f;
            u32x2* qo = (u32x2*)(hq + (size_t)row * D) + F.lane;
#pragma unroll
            for (int j = 0; j < 8; ++j) { const f32x4 a = v[rr][2 * j] * inv, bq = v[rr][2 * j + 1] * inv;
                u32x2 w; w.x = q8(a.x) | (q8(a.y) << 8) | (q8(a.z) << 16) | (q8(a.w) << 24); w.y = q8(bq.x) | (q8(bq.y) << 8) | (q8(bq.z) << 16) | (q8(bq.w) << 24); qo[64 * j] = w; }
            if (F.lane == 0) { const float rsn = 1.0f / sqrtf(s2[rr] * (1.0f / D) + RMS_EPS); rq[row] = rsn * am[rr] * (1.0f / 127.0f); if (rs_out) rs_out[row] = rsn; } }
    }
}
__device__ __forceinline__ void x_to_stream(Frame& F, const float* x, bf16* hb, float* rs_out) {
    for (int row = F.gw; row < M; row += F.NGW) {
        float s2 = 0.f;
#pragma unroll
        for (int j = 0; j < 8; ++j) { const int off = 8 * F.lane + 512 * j; const f32x4 h0 = *(const f32x4*)(x + (size_t)row * D + off), h1 = *(const f32x4*)(x + (size_t)row * D + off + 4);
            s2 += (h0.x * h0.x + h0.y * h0.y) + (h0.z * h0.z + h0.w * h0.w) + (h1.x * h1.x + h1.y * h1.y) + (h1.z * h1.z + h1.w * h1.w);
            u32x4 w; w.x = cvt_pk_bf16(h0.x, h0.y); w.y = cvt_pk_bf16(h0.z, h0.w); w.z = cvt_pk_bf16(h1.x, h1.y); w.w = cvt_pk_bf16(h1.z, h1.w); *((u32x4*)(hb + (size_t)row * D + off)) = w; }
        s2 = wave_sum(s2);
        if (F.lane == 0) rs_out[row] = 1.0f / sqrtf(s2 * (1.0f / D) + RMS_EPS);
    }
}

template <int MT, int NT, bool TR>
__device__ __forceinline__ void wave_mma(f32x4 (&acc)[MT][NT], const LAS bf16* A, int lda, const LAS bf16* Bm, int ldb, int K, int lane) {
    const int r = lane & 15, q = lane >> 4;
    for (int k0 = 0; k0 < K; k0 += 32) {
        bf16x8 a[MT], b[NT];
#pragma unroll
        for (int mt = 0; mt < MT; ++mt) a[mt] = *(const LAS bf16x8*)(A + (mt * 16 + r) * lda + k0 + 8 * q);
#pragma unroll
        for (int nt = 0; nt < NT; ++nt) b[nt] = *(const LAS bf16x8*)(Bm + (nt * 16 + r) * ldb + k0 + 8 * q);
#pragma unroll
        for (int mt = 0; mt < MT; ++mt)
#pragma unroll
            for (int nt = 0; nt < NT; ++nt)
                acc[mt][nt] = TR ? __builtin_amdgcn_mfma_f32_16x16x32_bf16(b[nt], a[mt], acc[mt][nt], 0, 0, 0) : __builtin_amdgcn_mfma_f32_16x16x32_bf16(a[mt], b[nt], acc[mt][nt], 0, 0, 0);
    }
}
__device__ __forceinline__ void stage_tile(LAS bf16* dst, int lld, const bf16* src, size_t gld, int rows, int cols, int tid) {
    const int cpr = cols >> 3, total = rows * cpr;
    for (int i = tid; i < total; i += NWAVES * 64) { const int r = i / cpr, c = i - r * cpr; *(LAS u32x4*)(dst + r * lld + c * 8) = *(const u32x4*)(src + (size_t)r * gld + c * 8); }
}
__device__ __forceinline__ void stage_tile_tr(LAS bf16* dst, int lld, const bf16* src, size_t gld, int rows, int cols, int tid) {
    const int cpr = cols >> 3, total = rows * cpr;
    for (int i = tid; i < total; i += NWAVES * 64) { const int c = i / rows, r = i - c * rows; const u32x4 v = *(const u32x4*)(src + (size_t)r * gld + c * 8);
        LAS bf16* d = dst + (c * 8) * lld + r;
        d[0] = (bf16)(v.x & 0xffff); d[lld] = (bf16)(v.x >> 16); d[2 * lld] = (bf16)(v.y & 0xffff); d[3 * lld] = (bf16)(v.y >> 16);
        d[4 * lld] = (bf16)(v.z & 0xffff); d[5 * lld] = (bf16)(v.z >> 16); d[6 * lld] = (bf16)(v.w & 0xffff); d[7 * lld] = (bf16)(v.w >> 16); }
}

struct NoScale { __device__ __forceinline__ float operator()(int) const { return 1.0f; } static constexpr bool ON = false; };
struct Exp2Scale { float a, b; static constexpr bool ON = true; __device__ __forceinline__ float operator()(int r) const { return exp2f(a + b * (float)r); } };
template <class RS>
__device__ __forceinline__ void stage_tile_tr2(LAS bf16* dst, int lld, const bf16* src, size_t gld, int rows, int cols, int tid, const RS& sc) {
    const int hp = rows >> 1, total = hp * (cols >> 3), ls = lld >> 1;
    for (int i = tid; i < total; i += NWAVES * 64) { const int rp = i % hp, c8 = i / hp;
        const u32x4 a = *(const u32x4*)(src + (size_t)(2 * rp) * gld + c8 * 8), b = *(const u32x4*)(src + (size_t)(2 * rp + 1) * gld + c8 * 8);
        LAS unsigned* d = (LAS unsigned*)(dst + (c8 * 8) * lld + 2 * rp);
        if (RS::ON) { const float s0 = sc(2 * rp), s1 = sc(2 * rp + 1);
            d[0 * ls] = cvt_pk_bf16(bflo(a.x) * s0, bflo(b.x) * s1); d[1 * ls] = cvt_pk_bf16(bfhi(a.x) * s0, bfhi(b.x) * s1);
            d[2 * ls] = cvt_pk_bf16(bflo(a.y) * s0, bflo(b.y) * s1); d[3 * ls] = cvt_pk_bf16(bfhi(a.y) * s0, bfhi(b.y) * s1);
            d[4 * ls] = cvt_pk_bf16(bflo(a.z) * s0, bflo(b.z) * s1); d[5 * ls] = cvt_pk_bf16(bfhi(a.z) * s0, bfhi(b.z) * s1);
            d[6 * ls] = cvt_pk_bf16(bflo(a.w) * s0, bflo(b.w) * s1); d[7 * ls] = cvt_pk_bf16(bfhi(a.w) * s0, bfhi(b.w) * s1);
        } else {
            d[0 * ls] = (a.x & 0xffffu) | (b.x << 16); d[1 * ls] = (a.x >> 16) | (b.x & 0xffff0000u);
            d[2 * ls] = (a.y & 0xffffu) | (b.y << 16); d[3 * ls] = (a.y >> 16) | (b.y & 0xffff0000u);
            d[4 * ls] = (a.z & 0xffffu) | (b.z << 16); d[5 * ls] = (a.z >> 16) | (b.z & 0xffff0000u);
            d[6 * ls] = (a.w & 0xffffu) | (b.w << 16); d[7 * ls] = (a.w >> 16) | (b.w & 0xffff0000u);
        } }
}

typedef short s16x4 __attribute__((ext_vector_type(4)));
__device__ __forceinline__ bf16x8 tr_frag(const LAS bf16* base, int pitch, int lane) {
    const int g = lane >> 4, q = (lane >> 2) & 3, p = lane & 3;
    const LAS bf16* a = base + (8 * g + q) * pitch + 4 * p;
    const s16x4 lo = __builtin_amdgcn_ds_read_tr16_b64_v4i16((LAS s16x4*)a);
    const s16x4 hi = __builtin_amdgcn_ds_read_tr16_b64_v4i16((LAS s16x4*)(a + 4 * pitch));
    return __builtin_shufflevector(lo, hi, 0, 1, 2, 3, 4, 5, 6, 7);
}
template <int MT, int NT, bool TR, bool AT, bool BT>
__device__ __forceinline__ void wave_mma_g(f32x4 (&acc)[MT][NT], const LAS bf16* A, int lda, const LAS bf16* Bm, int ldb, int K, int lane) {
    const int r = lane & 15, q = lane >> 4;
    for (int k0 = 0; k0 < K; k0 += 32) {
        bf16x8 a[MT], b[NT];
#pragma unroll
        for (int mt = 0; mt < MT; ++mt) { if (AT) a[mt] = tr_frag(A + k0 * lda + 16 * mt, lda, lane); else a[mt] = *(const LAS bf16x8*)(A + (mt * 16 + r) * lda + k0 + 8 * q); }
#pragma unroll
        for (int nt = 0; nt < NT; ++nt) { if (BT) b[nt] = tr_frag(Bm + k0 * ldb + 16 * nt, ldb, lane); else b[nt] = *(const LAS bf16x8*)(Bm + (nt * 16 + r) * ldb + k0 + 8 * q); }
#pragma unroll
        for (int mt = 0; mt < MT; ++mt)
#pragma unroll
            for (int nt = 0; nt < NT; ++nt)
                acc[mt][nt] = TR ? __builtin_amdgcn_mfma_f32_16x16x32_bf16(b[nt], a[mt], acc[mt][nt], 0, 0, 0) : __builtin_amdgcn_mfma_f32_16x16x32_bf16(a[mt], b[nt], acc[mt][nt], 0, 0, 0);
    }
}
template <int N> struct Pf { u32x4 r[N]; };
template <int N, int CPR> __device__ __forceinline__ void pf_load(Pf<N>& p, const bf16* src, size_t gld, int tid) {
#pragma unroll
    for (int it = 0; it < N; ++it) { const int i = tid + NWAVES * 64 * it; p.r[it] = *(const u32x4*)(src + (size_t)(i / CPR) * gld + (i % CPR) * 8); }
}
template <int N, int CPR> __device__ __forceinline__ void pf_store(LAS bf16* dst, int lld, int tid, const Pf<N>& p) {
#pragma unroll
    for (int it = 0; it < N; ++it) { const int i = tid + NWAVES * 64 * it; *(LAS u32x4*)(dst + (i / CPR) * lld + (i % CPR) * 8) = p.r[it]; }
}
__device__ __forceinline__ u32x4 scale_bf16x8(u32x4 v, float s) {
    u32x4 o; o.x = cvt_pk_bf16(bflo(v.x) * s, bfhi(v.x) * s); o.y = cvt_pk_bf16(bflo(v.y) * s, bfhi(v.y) * s); o.z = cvt_pk_bf16(bflo(v.z) * s, bfhi(v.z) * s); o.w = cvt_pk_bf16(bflo(v.w) * s, bfhi(v.w) * s); return o;
}

struct RsCtx { const bf16* proj; bf16* st; LAS bf16* kt; LAS bf16* vt; int b, h, bh, dir, e0; float l2g, gC; };
__device__ __forceinline__ void rs_load(Pf<8>& pk, Pf<2>& pv, const RsCtx& c, int ci, int tid) {
    const int ch = c.dir ? 31 - ci : ci; const bf16* rowp = c.proj + (size_t)(c.b * SEQ + ch * 128) * NPROJ;
    pf_load<8, 32>(pk, rowp + C_RK + c.h * RD, NPROJ, tid); pf_load<2, 8>(pv, rowp + C_RV + c.h * RD + c.e0, NPROJ, tid);
}
__device__ __forceinline__ void rs_step(Frame& F, f32x4 (&acc)[4][2], Pf<8>& pk, Pf<2>& pv, const RsCtx& c, int ci) {
    const int r = F.lane & 15, q = F.lane >> 4;
    const int ch = c.dir ? 31 - ci : ci;
    bf16* sp = c.st + ((((size_t)(c.bh * 2 + c.dir) * 32 + ch) * 256 + c.e0) * 256) + 32 * F.wave + 4 * q;
#pragma unroll
    for (int mt = 0; mt < 4; ++mt)
#pragma unroll
        for (int nt = 0; nt < 2; ++nt) { u32x2 w; w.x = cvt_pk_bf16(acc[mt][nt][0], acc[mt][nt][1]); w.y = cvt_pk_bf16(acc[mt][nt][2], acc[mt][nt][3]);
            *(u32x2*)(sp + (size_t)(16 * mt + r) * 256 + 16 * nt) = w; }
    __syncthreads();
    pf_store<8, 32>(c.kt, 272, F.tid, pk);
#pragma unroll
    for (int it = 0; it < 2; ++it) { const int i = F.tid + NWAVES * 64 * it, row = i >> 3;
        const float sc = exp2f(c.l2g * (float)(c.dir ? row : 127 - row)); *(LAS u32x4*)(c.vt + row * 80 + (i & 7) * 8) = scale_bf16x8(pv.r[it], sc); }
    __syncthreads();
    if (ci + 2 < 32) rs_load(pk, pv, c, ci + 2, F.tid);
#pragma unroll
    for (int mt = 0; mt < 4; ++mt)
#pragma unroll
        for (int nt = 0; nt < 2; ++nt) acc[mt][nt] = acc[mt][nt] * c.gC;
    wave_mma_g<4, 2, true, true, true>(acc, c.vt, 80, c.kt + 32 * F.wave, 272, 128, F.lane);
}
__device__ __forceinline__ void ret_state_pass(Frame& F, int first, int stride, const bf16* proj, bf16* st) {
    for (int item = first; item < 128; item += stride) {
        RsCtx c; c.proj = proj; c.st = st; c.kt = (LAS bf16*)F.lds; c.vt = c.kt + 128 * 272;
        const int es = item & 3; c.dir = (item >> 2) & 1; c.bh = item >> 3; c.b = c.bh >> 3; c.h = c.bh & 7; c.e0 = es * 64;
        const int hg = c.dir ? (7 - c.h) : c.h; const float gam = 1.0f - exp2f(-5.0f - (float)hg); c.l2g = log2f(gam); c.gC = exp2f(128.0f * c.l2g);
        f32x4 acc[4][2];
#pragma unroll
        for (int mt = 0; mt < 4; ++mt)
#pragma unroll
            for (int nt = 0; nt < 2; ++nt) acc[mt][nt] = (f32x4){0.f, 0.f, 0.f, 0.f};
        Pf<8> pkA, pkB; Pf<2> pvA, pvB;
        rs_load(pkA, pvA, c, 0, F.tid); rs_load(pkB, pvB, c, 1, F.tid);
        for (int ci = 0; ci < 32; ci += 2) { rs_step(F, acc, pkA, pvA, c, ci); rs_step(F, acc, pkB, pvB, c, ci + 1); }
    }
    __syncthreads();
}
struct RoCtx { const bf16* kbase; const bf16* vbase; const bf16* stf; const bf16* stb; };
template <int S> __device__ __forceinline__ void ro_issue(Pf<4>& pa, Pf<2>& pv, const RoCtx& c, int tid) {
    if constexpr (S < 2) pf_load<4, 32>(pa, c.kbase + (size_t)(64 * S) * NPROJ, NPROJ, tid);
    else if constexpr (S < 14) { constexpr int es = (S - 2) / 3, kind = (S - 2) % 3;
        if constexpr (kind == 0) pf_load<4, 32>(pa, c.stf + (size_t)(64 * es) * 256, 256, tid);
        else if constexpr (kind == 1) pf_load<4, 32>(pa, c.stb + (size_t)(64 * es) * 256, 256, tid);
        else pf_load<2, 8>(pv, c.vbase + 64 * es, NPROJ, tid); }
}
template <int S> __device__ __forceinline__ void ro_round(Frame& F, Pf<4>& pa, Pf<2>& pv, const RoCtx& c, LAS bf16* qs, LAS bf16* ps, LAS bf16* bs, f32x4 (&o)[4][1][4], int n, float l2f, float l2b, float qdf, float qdb) {
    const int q = F.lane >> 4;
    __syncthreads();
    if constexpr (S < 2 || (S - 2) % 3 != 2) pf_store<4, 32>(bs, 264, F.tid, pa); else pf_store<2, 8>(bs, 80, F.tid, pv);
    __syncthreads();
    ro_issue<S + 1>(pa, pv, c, F.tid);
    if constexpr (S < 2) {
        f32x4 s[1][4];
#pragma unroll
        for (int nt = 0; nt < 4; ++nt) s[0][nt] = (f32x4){0.f, 0.f, 0.f, 0.f};
        wave_mma<1, 4, true>(s, qs + F.wave * 16 * 264, 264, bs, 264, 256, F.lane);
#pragma unroll
        for (int nt = 0; nt < 4; ++nt) { float p[4];
#pragma unroll
            for (int j = 0; j < 4; ++j) { const int mkey = 64 * S + 16 * nt + 4 * q + j; const int dist = n - mkey;
                const float w = dist >= 0 ? exp2f((float)dist * l2f) : exp2f((float)(-dist) * l2b); p[j] = s[0][nt][j] * w; }
            u32x2 w2; w2.x = cvt_pk_bf16(p[0], p[1]); w2.y = cvt_pk_bf16(p[2], p[3]);
            *(LAS u32x2*)(ps + n * 136 + 64 * S + 16 * nt + 4 * q) = w2; }
    } else { constexpr int es = (S - 2) / 3, kind = (S - 2) % 3;
        if constexpr (kind < 2) {
            f32x4 t[1][4];
#pragma unroll
            for (int nt = 0; nt < 4; ++nt) t[0][nt] = (f32x4){0.f, 0.f, 0.f, 0.f};
            wave_mma<1, 4, true>(t, qs + F.wave * 16 * 264, 264, bs, 264, 256, F.lane);
#pragma unroll
            for (int nt = 0; nt < 4; ++nt) { if constexpr (kind == 0) o[es][0][nt] = t[0][nt] * qdf; else o[es][0][nt] = o[es][0][nt] + t[0][nt] * qdb; }
        } else {
            wave_mma_g<1, 4, true, false, true>(o[es], ps + F.wave * 16 * 136, 136, bs, 80, 128, F.lane);
        }
    }
}
__device__ __forceinline__ void ret_output_pass(Frame& F, int first, int stride, const bf16* proj, const bf16* st, const float* rng, bf16* mixin) {
    LAS bf16* qs = (LAS bf16*)F.lds;
    LAS bf16* ps = qs + 128 * 264;
    LAS bf16* bs = ps + 128 * 136;
    const int r = F.lane & 15, q = F.lane >> 4;
    for (int item = first; item < 512; item += stride) {
        const int ch = item & 31, bh = item >> 5, b = bh >> 3, h = bh & 7;
        const float l2f = log2f(1.0f - exp2f(-5.0f - (float)h)), l2b = log2f(1.0f - exp2f(-5.0f - (float)(7 - h)));
        const size_t row0 = (size_t)b * SEQ + ch * 128;
        const int n = 16 * F.wave + r;
        RoCtx c; c.kbase = proj + row0 * NPROJ + C_RK + h * RD; c.vbase = proj + row0 * NPROJ + C_RV + h * RD;
        c.stf = st + (((size_t)(bh * 2 + 0) * 32 + ch) * 256) * 256; c.stb = st + (((size_t)(bh * 2 + 1) * 32 + ch) * 256) * 256;
        Pf<4> pa; Pf<2> pv;
        ro_issue<0>(pa, pv, c, F.tid);
        __syncthreads();
        stage_tile(qs, 264, proj + row0 * NPROJ + C_RQ + h * RD, NPROJ, 128, 256, F.tid);
        const float qdf = exp2f((float)(n + 1) * l2f), qdb = exp2f((float)(128 - n) * l2b);
        f32x4 o[4][1][4];
        ro_round<0>(F, pa, pv, c, qs, ps, bs, o, n, l2f, l2b, qdf, qdb); ro_round<1>(F, pa, pv, c, qs, ps, bs, o, n, l2f, l2b, qdf, qdb);
        ro_round<2>(F, pa, pv, c, qs, ps, bs, o, n, l2f, l2b, qdf, qdb); ro_round<3>(F, pa, pv, c, qs, ps, bs, o, n, l2f, l2b, qdf, qdb); ro_round<4>(F, pa, pv, c, qs, ps, bs, o, n, l2f, l2b, qdf, qdb);
        ro_round<5>(F, pa, pv, c, qs, ps, bs, o, n, l2f, l2b, qdf, qdb); ro_round<6>(F, pa, pv, c, qs, ps, bs, o, n, l2f, l2b, qdf, qdb); ro_round<7>(F, pa, pv, c, qs, ps, bs, o, n, l2f, l2b, qdf, qdb);
        ro_round<8>(F, pa, pv, c, qs, ps, bs, o, n, l2f, l2b, qdf, qdb); ro_round<9>(F, pa, pv, c, qs, ps, bs, o, n, l2f, l2b, qdf, qdb); ro_round<10>(F, pa, pv, c, qs, ps, bs, o, n, l2f, l2b, qdf, qdb);
        ro_round<11>(F, pa, pv, c, qs, ps, bs, o, n, l2f, l2b, qdf, qdb); ro_round<12>(F, pa, pv, c, qs, ps, bs, o, n, l2f, l2b, qdf, qdb); ro_round<13>(F, pa, pv, c, qs, ps, bs, o, n, l2f, l2b, qdf, qdb);
        float sm = 0.f;
#pragma unroll
        for (int es = 0; es < 4; ++es)
#pragma unroll
            for (int nt = 0; nt < 4; ++nt) sm += (o[es][0][nt][0] + o[es][0][nt][1]) + (o[es][0][nt][2] + o[es][0][nt][3]);
        sm += __shfl_xor(sm, 16); sm += __shfl_xor(sm, 32);
        const float mu = sm * (1.0f / RD); float sv = 0.f;
#pragma unroll
        for (int es = 0; es < 4; ++es)
#pragma unroll
            for (int nt = 0; nt < 4; ++nt) { const f32x4 dvv = o[es][0][nt] - mu; o[es][0][nt] = dvv; sv += (dvv[0] * dvv[0] + dvv[1] * dvv[1]) + (dvv[2] * dvv[2] + dvv[3] * dvv[3]); }
        sv += __shfl_xor(sv, 16); sv += __shfl_xor(sv, 32);
        const float rs = 1.0f / sqrtf(sv * (1.0f / RD) + GN_EPS);
        const bf16* gp = proj + (row0 + n) * NPROJ + C_RG + h * RD + 4 * q; bf16* op = mixin + (row0 + n) * D + h * RD + 4 * q; const float* gg = rng + h * RD + 4 * q;
#pragma unroll
        for (int es = 0; es < 4; ++es)
#pragma unroll
            for (int nt = 0; nt < 4; ++nt) { const int e = 64 * es + 16 * nt; const u32x2 gt = *(const u32x2*)(gp + e); const f32x4 g4 = *(const f32x4*)(gg + e);
                const f32x4 v = o[es][0][nt] * rs * g4;
                u32x2 w; w.x = cvt_pk_bf16(v[0] * silu_f(bflo(gt.x)), v[1] * silu_f(bfhi(gt.x))); w.y = cvt_pk_bf16(v[2] * silu_f(bflo(gt.y)), v[3] * silu_f(bfhi(gt.y)));
                *(u32x2*)(op + e) = w; }
    }
    __syncthreads();
}

__device__ __forceinline__ float hgrn_lb(const float* lblog, int layer, int dir, int col) {
    if (layer == 0) return 0.f;
    float mx = -1e30f;
    for (int l = 0; l < NL; ++l) mx = fmaxf(mx, lblog[(l * 2 + dir) * HW + col]);
    float den = 0.f, num = 0.f;
    for (int l = 0; l < NL; ++l) { const float ev = __expf(lblog[(l * 2 + dir) * HW + col] - mx); den += ev; if (l >= 1 && l <= layer) num += ev; }
    return num / den;
}
constexpr int HSB = 4;
struct HsCtx { const bf16* proj; const float* gatez; bf16* hst; LAS bf16* kpt; LAS bf16* vt; LAS float* tot; LAS float* adec; int b, h, bh, dir, d0, d, sg; float lb; };
__device__ __forceinline__ void hs_load(float (&zr)[HSB][4], Pf<2> (&pv)[HSB], const HsCtx& c, int cg, int tid) {
#pragma unroll
    for (int cb = 0; cb < HSB; ++cb) { const int ci = cg * HSB + cb, ch = c.dir ? 63 - ci : ci; const size_t row0 = (size_t)c.b * SEQ + ch * 64;
        const bf16* zp = c.proj + (row0 + 4 * c.sg) * NPROJ + C_HFF + c.dir * HW + c.h * HD + c.d0 + c.d;
#pragma unroll
        for (int ii = 0; ii < 4; ++ii) zr[cb][ii] = bf2f(zp[(size_t)ii * NPROJ]);
        pf_load<2, 16>(pv[cb], c.proj + row0 * NPROJ + C_HI + c.h * HD, NPROJ, tid); }
}
__device__ __forceinline__ void hs_step(Frame& F, f32x4 (&acc)[1][2], float (&zr)[HSB][4], Pf<2> (&pv)[HSB], const HsCtx& c, int cg) {
    const int r = F.lane & 15, q = F.lane >> 4, d = c.d, sg = c.sg, dir = c.dir;
    float lf[HSB][4], kk[HSB][4], mytot[HSB];
#pragma unroll
    for (int cb = 0; cb < HSB; ++cb) {
#pragma unroll
        for (int ii = 0; ii < 4; ++ii) { const float f = c.lb + (1.0f - c.lb) * fast_sigmoid(zr[cb][ii]); lf[cb][ii] = __logf(f); kk[cb][ii] = 1.0f - f; }
        if (dir == 0) { lf[cb][1] += lf[cb][0]; lf[cb][2] += lf[cb][1]; lf[cb][3] += lf[cb][2]; } else { lf[cb][2] += lf[cb][3]; lf[cb][1] += lf[cb][2]; lf[cb][0] += lf[cb][1]; }
        mytot[cb] = dir == 0 ? lf[cb][3] : lf[cb][0]; }
    __syncthreads();
#pragma unroll
    for (int cb = 0; cb < HSB; ++cb) { c.tot[cb * 512 + sg * 32 + d] = mytot[cb]; pf_store<2, 16>(c.vt + cb * 64 * 144, 144, F.tid, pv[cb]); }
    __syncthreads();
    if (cg + 2 < 64 / HSB) hs_load(zr, pv, c, cg + 2, F.tid);
#pragma unroll
    for (int cb = 0; cb < HSB; ++cb) {
        float other = 0.f, all = 0.f;
#pragma unroll
        for (int g = 0; g < 16; ++g) { const float tv = c.tot[cb * 512 + g * 32 + d]; all += tv; if (dir == 0 ? (g < sg) : (g > sg)) other += tv; }
        float kv[4];
#pragma unroll
        for (int ii = 0; ii < 4; ++ii) kv[ii] = kk[cb][ii] * __expf(all - (lf[cb][ii] + other));
        { u32x2 w; w.x = cvt_pk_bf16(kv[0], kv[1]); w.y = cvt_pk_bf16(kv[2], kv[3]); *(LAS u32x2*)(c.kpt + cb * 32 * 72 + d * 72 + 4 * sg) = w; }
        if (sg == 0) c.adec[cb * 32 + d] = __expf(all); }
    __syncthreads();
#pragma unroll
    for (int cb = 0; cb < HSB; ++cb) { const int ci = cg * HSB + cb, ch = dir ? 63 - ci : ci;
#pragma unroll
        for (int nt = 0; nt < 2; ++nt) { u32x2 w; w.x = cvt_pk_bf16(acc[0][nt][0], acc[0][nt][1]); w.y = cvt_pk_bf16(acc[0][nt][2], acc[0][nt][3]);
            *(u32x2*)(c.hst + ((((size_t)(c.bh * 2 + dir) * 64 + ch) * 128 + 16 * F.wave + r) * 128) + c.d0 + 16 * nt + 4 * q) = w; }
#pragma unroll
        for (int nt = 0; nt < 2; ++nt) { const f32x4 a4 = *(const LAS f32x4*)(c.adec + cb * 32 + 16 * nt + 4 * q); acc[0][nt] = acc[0][nt] * a4; }
        wave_mma_g<1, 2, true, true, false>(acc, c.vt + cb * 64 * 144 + 16 * F.wave, 144, c.kpt + cb * 32 * 72, 72, 64, F.lane); }
}
__device__ __forceinline__ void hgrn_state_pass(Frame& F, int first, int stride, const bf16* proj, const float* gatez, const float* lblog, int layer, bf16* hst) {
    for (int item = first; item < 128; item += stride) {
        HsCtx c; c.proj = proj; c.gatez = gatez; c.hst = hst;
        c.kpt = (LAS bf16*)F.lds; c.vt = c.kpt + HSB * 32 * 72; c.tot = (LAS float*)(c.vt + HSB * 64 * 144); c.adec = c.tot + HSB * 512;
        const int ds = item & 3; c.dir = (item >> 2) & 1; c.bh = item >> 3; c.b = c.bh >> 3; c.h = c.bh & 7; c.d0 = ds * 32; c.d = F.tid & 31; c.sg = F.tid >> 5;
        c.lb = hgrn_lb(lblog, layer, c.dir, c.h * HD + c.d0 + c.d);
        f32x4 acc[1][2]; acc[0][0] = (f32x4){0.f, 0.f, 0.f, 0.f}; acc[0][1] = (f32x4){0.f, 0.f, 0.f, 0.f};
        float zA[HSB][4], zB[HSB][4]; Pf<2> pvA[HSB], pvB[HSB];
        hs_load(zA, pvA, c, 0, F.tid); hs_load(zB, pvB, c, 1, F.tid);
        for (int cg = 0; cg < 64 / HSB; cg += 2) { hs_step(F, acc, zA, pvA, c, cg); hs_step(F, acc, zB, pvB, c, cg + 1); }
    }
    __syncthreads();
}
__device__ __forceinline__ void hgrn_output_pass(Frame& F, int first, int stride, int last, const bf16* proj, const float* gatez, const float* lblog, int layer, const bf16* hst, const float* hng, bf16* mixin) {
    LAS bf16* qd = (LAS bf16*)F.lds;
    LAS bf16* kd = qd + 64 * 136;
    LAS bf16* qx = kd + 64 * 136;
    LAS bf16* ps = qx + 64 * 136;
    LAS bf16* vt = ps + 64 * 72;
    LAS bf16* sT = vt + 64 * 144;
    LAS float* tot = (LAS float*)(sT + 128 * 136);
    LAS float* rsq = tot + 512;
    const int r = F.lane & 15, q = F.lane >> 4, rg = F.wave & 3, eh = F.wave >> 2;
    const int d = F.tid & 127, sq = F.tid >> 7;
    const int nitems = first < last ? (last - first + stride - 1) / stride : 0, nunits = 2 * nitems;
    if (nunits == 0) return;
    float zr[16]; unsigned short qr[16]; Pf<4> pst; Pf<2> pvv;
#define HO_ISSUE(u_) do { const int it_ = first + ((u_) >> 1) * stride, dr_ = (u_) & 1; const int ch_ = it_ & 63, bh_ = it_ >> 6, b_ = bh_ >> 3, h_ = bh_ & 7; const size_t r0_ = (size_t)b_ * SEQ + ch_ * 64; \
        const bf16* zp_ = proj + (r0_ + 16 * sq) * NPROJ + C_HFF + dr_ * HW + h_ * HD + d; const bf16* qp_ = proj + (r0_ + 16 * sq) * NPROJ + C_HQ + h_ * HD + d; \
        _Pragma("unroll") for (int ii = 0; ii < 16; ++ii) { zr[ii] = bf2f(zp_[(size_t)ii * NPROJ]); qr[ii] = qp_[(size_t)ii * NPROJ]; } \
        pf_load<4, 16>(pst, hst + (((size_t)(bh_ * 2 + dr_) * 64 + ch_) * 128) * 128, 128, F.tid); \
        if (dr_ == 0) pf_load<2, 16>(pvv, proj + r0_ * NPROJ + C_HI + h_ * HD, NPROJ, F.tid); } while (0)
    HO_ISSUE(0);
    f32x4 o[1][4];
    for (int u = 0; u < nunits; ++u) {
        const int item = first + (u >> 1) * stride, dir = u & 1;
        const int ch = item & 63, bh = item >> 6, b = bh >> 3, h = bh & 7; const size_t row0 = (size_t)b * SEQ + ch * 64;
        if (dir == 0) {
#pragma unroll
            for (int nt = 0; nt < 4; ++nt) o[0][nt] = (f32x4){0.f, 0.f, 0.f, 0.f};
        }
        const float lb = hgrn_lb(lblog, layer, dir, h * HD + d);
        float lf[16], kk[16], qv[16];
#pragma unroll
        for (int ii = 0; ii < 16; ++ii) { const float f = lb + (1.0f - lb) * fast_sigmoid(zr[ii]); lf[ii] = __logf(f); kk[ii] = 1.0f - f; qv[ii] = bf2f(qr[ii]) * 0.08838834764831845f; }
        if (dir == 0) {
#pragma unroll
            for (int ii = 1; ii < 16; ++ii) lf[ii] += lf[ii - 1];
        } else {
#pragma unroll
            for (int ii = 14; ii >= 0; --ii) lf[ii] += lf[ii + 1];
        }
        const float mytot = dir == 0 ? lf[15] : lf[0];
        __syncthreads();
        tot[sq * 128 + d] = mytot;
        if (dir == 0) pf_store<2, 16>(vt, 144, F.tid, pvv);
        pf_store<4, 16>(sT, 136, F.tid, pst);
        __syncthreads();
        if (u + 1 < nunits) HO_ISSUE(u + 1);
        const float t0 = tot[d], t1 = tot[128 + d], t2 = tot[256 + d], t3 = tot[384 + d];
        float other, R;
        if (dir == 0) { other = sq == 0 ? 0.f : (sq == 1 ? t0 : (sq == 2 ? t0 + t1 : t0 + t1 + t2)); R = t0 + t1; }
        else { other = sq == 3 ? 0.f : (sq == 2 ? t3 : (sq == 1 ? t3 + t2 : t3 + t2 + t1)); R = t3 + t2; }
#pragma unroll
        for (int ii = 0; ii < 16; ++ii) { const float cum = lf[ii] + other; const int t = 16 * sq + ii;
            const float ea = __expf(cum - R), eb = __expf(R - cum), ec = __expf(cum);
            qd[t * 136 + d] = (bf16)(cvt_pk_bf16(qv[ii] * ea, 0.f) & 0xffffu); kd[t * 136 + d] = (bf16)(cvt_pk_bf16(kk[ii] * eb, 0.f) & 0xffffu); qx[t * 136 + d] = (bf16)(cvt_pk_bf16(qv[ii] * ec, 0.f) & 0xffffu); }
        __syncthreads();
        { f32x4 s[1][2]; s[0][0] = (f32x4){0.f, 0.f, 0.f, 0.f}; s[0][1] = (f32x4){0.f, 0.f, 0.f, 0.f};
          wave_mma<1, 2, true>(s, qd + rg * 16 * 136, 136, kd + eh * 32 * 136, 136, 128, F.lane);
          const int t = 16 * rg + r;
#pragma unroll
          for (int nt = 0; nt < 2; ++nt) { float p[4];
#pragma unroll
              for (int j = 0; j < 4; ++j) { const int sk = 32 * eh + 16 * nt + 4 * q + j; const bool keep = dir == 0 ? (sk <= t) : (sk >= t); p[j] = keep ? s[0][nt][j] : 0.f; }
              u32x2 w; w.x = cvt_pk_bf16(p[0], p[1]); w.y = cvt_pk_bf16(p[2], p[3]);
              *(LAS u32x2*)(ps + t * 72 + 32 * eh + 16 * nt + 4 * q) = w; } }
        __syncthreads();
        wave_mma_g<1, 4, true, false, true>(o, ps + rg * 16 * 72, 72, vt + eh * 64, 144, 64, F.lane);
        wave_mma<1, 4, true>(o, qx + rg * 16 * 136, 136, sT + eh * 64 * 136, 136, 128, F.lane);
        if (dir == 1) {
            float ss = 0.f;
#pragma unroll
            for (int nt = 0; nt < 4; ++nt) ss += (o[0][nt][0] * o[0][nt][0] + o[0][nt][1] * o[0][nt][1]) + (o[0][nt][2] * o[0][nt][2] + o[0][nt][3] * o[0][nt][3]);
            ss += __shfl_xor(ss, 16); ss += __shfl_xor(ss, 32);
            const int t = 16 * rg + r;
            if (q == 0) rsq[t * 2 + eh] = ss;
            __syncthreads();
            const float rs = 1.0f / sqrtf((rsq[t * 2] + rsq[t * 2 + 1]) * (1.0f / HD) + RMS_EPS);
            const bf16* gp = proj + (row0 + t) * NPROJ + C_HG + h * HD + 64 * eh + 4 * q; bf16* op = mixin + (row0 + t) * D + RW + h * HD + 64 * eh + 4 * q; const float* gg = hng + h * HD + 64 * eh + 4 * q;
#pragma unroll
            for (int nt = 0; nt < 4; ++nt) { const u32x2 gt = *(const u32x2*)(gp + 16 * nt); const f32x4 g4 = *(const f32x4*)(gg + 16 * nt); const f32x4 v = o[0][nt] * rs * g4;
                u32x2 w; w.x = cvt_pk_bf16(v[0] * silu_f(bflo(gt.x)), v[1] * silu_f(bfhi(gt.x))); w.y = cvt_pk_bf16(v[2] * silu_f(bflo(gt.y)), v[3] * silu_f(bfhi(gt.y)));
                *(u32x2*)(op + 16 * nt) = w; }
        }
    }
#undef HO_ISSUE
    __syncthreads();
}

__device__ __forceinline__ void fourier_ut2(Frame& F, int bid, const bf16* proj, const bf16* fwt, bf16* ut2, float* nyq) {
    LAS bf16* zc = (LAS bf16*)F.lds;
    LAS bf16* zs = zc + 128 * 136;
    LAS bf16* ws = zs + 128 * 136;
    const int g = bid & 7, nb = (bid >> 3) & 15, b = bid >> 7;
    const bf16* zb = proj + (size_t)(b * SEQ) * NPROJ + C_FZ + g * FD;
    u32x4 ra[4], rb[4];
#pragma unroll
    for (int it = 0; it < 4; ++it) { const int i = F.tid + NWAVES * 64 * it, row = i >> 4, ch = i & 15, n = nb * 128 + row; const int mrow = (SEQ - n) & (SEQ - 1);
        ra[it] = *(const u32x4*)(zb + (size_t)n * NPROJ + ch * 8); rb[it] = *(const u32x4*)(zb + (size_t)mrow * NPROJ + ch * 8); }
    __syncthreads();
    stage_tile(ws, 136, fwt + (size_t)g * 256 * 128, 128, 256, 128, F.tid);
#pragma unroll
    for (int it = 0; it < 4; ++it) { const int i = F.tid + NWAVES * 64 * it, row = i >> 4, ch = i & 15, n = nb * 128 + row; const float k0 = n == 0 ? 0.f : 1.f;
        const u32x4 a = ra[it], m = rb[it]; u32x4 sc, sd;
        sc.x = cvt_pk_bf16(bflo(a.x) + k0 * bflo(m.x), bfhi(a.x) + k0 * bfhi(m.x)); sd.x = cvt_pk_bf16(k0 * (bflo(a.x) - bflo(m.x)), k0 * (bfhi(a.x) - bfhi(m.x)));
        sc.y = cvt_pk_bf16(bflo(a.y) + k0 * bflo(m.y), bfhi(a.y) + k0 * bfhi(m.y)); sd.y = cvt_pk_bf16(k0 * (bflo(a.y) - bflo(m.y)), k0 * (bfhi(a.y) - bfhi(m.y)));
        sc.z = cvt_pk_bf16(bflo(a.z) + k0 * bflo(m.z), bfhi(a.z) + k0 * bfhi(m.z)); sd.z = cvt_pk_bf16(k0 * (bflo(a.z) - bflo(m.z)), k0 * (bfhi(a.z) - bfhi(m.z)));
        sc.w = cvt_pk_bf16(bflo(a.w) + k0 * bflo(m.w), bfhi(a.w) + k0 * bfhi(m.w)); sd.w = cvt_pk_bf16(k0 * (bflo(a.w) - bflo(m.w)), k0 * (bfhi(a.w) - bfhi(m.w)));
        *(LAS u32x4*)(zc + row * 136 + ch * 8) = sc; *(LAS u32x4*)(zs + row * 136 + ch * 8) = sd; }
    __syncthreads();
    const int r = F.lane & 15, q = F.lane >> 4; const int n = nb * 128 + F.wave * 16 + 4 * q;
#pragma unroll
    for (int part = 0; part < 2; ++part) {
        f32x4 acc[1][8];
#pragma unroll
        for (int nt = 0; nt < 8; ++nt) acc[0][nt] = (f32x4){0.f, 0.f, 0.f, 0.f};
        wave_mma<1, 8, false>(acc, (part ? zs : zc) + F.wave * 16 * 136, 136, ws + part * 128 * 136, 136, 128, F.lane);
#pragma unroll
        for (int nt = 0; nt < 8; ++nt) { const int d = nt * 16 + r;
            u32x2 w; w.x = cvt_pk_bf16(acc[0][nt][0], acc[0][nt][1]); w.y = cvt_pk_bf16(acc[0][nt][2], acc[0][nt][3]);
            *(u32x2*)(ut2 + (size_t)(part * 2048 + b * FW + g * FD + d) * 2048 + n) = w; }
    }
    if (nb == 0 && F.tid < 128) {
        const int d = F.tid; const bf16* zr = zb + (size_t)2048 * NPROJ; float acc = 0.f;
        for (int c8 = 0; c8 < 16; ++c8) { const u32x4 zv = *(const u32x4*)(zr + c8 * 8); const u32x4 wv = *(const LAS u32x4*)(ws + d * 136 + c8 * 8);
            acc += bflo(zv.x) * bflo(wv.x) + bfhi(zv.x) * bfhi(wv.x) + bflo(zv.y) * bflo(wv.y) + bfhi(zv.y) * bfhi(wv.y) + bflo(zv.z) * bflo(wv.z) + bfhi(zv.z) * bfhi(wv.z) + bflo(zv.w) * bflo(wv.w) + bfhi(zv.w) * bfhi(wv.w); }
        nyq[b * FW + g * FD + d] = acc;
    }
    __syncthreads();
}
__device__ __forceinline__ void fourier_mid_row(Frame& F, int first_wave, int nwaves, const bf16* ut2, const float* nyq, const float* bias, bf16* mixin) {
    for (int c = first_wave; c < NB * FW; c += nwaves) {
        const u32x4* rowp = (const u32x4*)(ut2 + (size_t)c * 2048) + F.lane; float sacc = 0.f;
#pragma unroll
        for (int j = 0; j < 4; ++j) { const u32x4 v = rowp[64 * j]; sacc += (bflo(v.x) - bfhi(v.x)) + (bflo(v.y) - bfhi(v.y)) + (bflo(v.z) - bfhi(v.z)) + (bflo(v.w) - bfhi(v.w)); }
        sacc = wave_sum(sacc);
        if (F.lane == 0) { const int b = c >> 10, colm = c & 1023; const float y = sacc + nyq[c] + bias[colm];
            mixin[(size_t)(b * SEQ + 2048) * D + 3072 + colm] = (bf16)(cvt_pk_bf16(y, 0.f) & 0xffffu); }
    }
}

__device__ __forceinline__ void xattn_phase(Frame& F, const bf16* xq, const bf16* kvmem, bf16* xo) {
    LAS bf16* ra = (LAS bf16*)F.lds;
    LAS bf16* rb = ra + 128 * 264;
    for (int item = F.vcu; item < NB * XH * 32; item += F.G) {
        const int qb = item & 31, hd = (item >> 5) & 3, b = item >> 7;
        __syncthreads();
        stage_tile(ra, 264, xq + (size_t)(b * SEQ + qb * 128) * XW + hd * XD, XW, 128, 256, F.tid);
        f32x4 s[2][8];
#pragma unroll
        for (int hf = 0; hf < 2; ++hf) {
            if (hf) __syncthreads();
            stage_tile(rb, 264, kvmem + (size_t)(b * MEMT + hf * 128) * 2048 + hd * XD, 2048, 128, 256, F.tid);
            __syncthreads();
            f32x4 acc[1][8];
#pragma unroll
            for (int nt = 0; nt < 8; ++nt) acc[0][nt] = (f32x4){0.f, 0.f, 0.f, 0.f};
            wave_mma<1, 8, true>(acc, ra + F.wave * 16 * 264, 264, rb, 264, 256, F.lane);
#pragma unroll
            for (int nt = 0; nt < 8; ++nt) s[hf][nt] = acc[0][nt];
        }
        float mx = -1e30f;
#pragma unroll
        for (int hf = 0; hf < 2; ++hf)
#pragma unroll
            for (int nt = 0; nt < 8; ++nt)
#pragma unroll
                for (int j = 0; j < 4; ++j) mx = fmaxf(mx, s[hf][nt][j]);
        mx = fmaxf(mx, __shfl_xor(mx, 16)); mx = fmaxf(mx, __shfl_xor(mx, 32));
        float sum = 0.f;
#pragma unroll
        for (int hf = 0; hf < 2; ++hf)
#pragma unroll
            for (int nt = 0; nt < 8; ++nt)
#pragma unroll
                for (int j = 0; j < 4; ++j) { const float p = __expf(s[hf][nt][j] - mx); s[hf][nt][j] = p; sum += p; }
        sum += __shfl_xor(sum, 16); sum += __shfl_xor(sum, 32);
        const float inv = 1.0f / sum;
        __syncthreads();
        { const int r = F.lane & 15, q = F.lane >> 4; LAS bf16* prow = ra + (F.wave * 16 + r) * 264;
#pragma unroll
          for (int hf = 0; hf < 2; ++hf)
#pragma unroll
              for (int nt = 0; nt < 8; ++nt) { u32x2 w; w.x = cvt_pk_bf16(s[hf][nt][0], s[hf][nt][1]); w.y = cvt_pk_bf16(s[hf][nt][2], s[hf][nt][3]);
                  *(LAS u32x2*)(prow + hf * 128 + nt * 16 + 4 * q) = w; } }
        f32x4 o[1][16];
#pragma unroll
        for (int nt = 0; nt < 16; ++nt) o[0][nt] = (f32x4){0.f, 0.f, 0.f, 0.f};
#pragma unroll
        for (int hf = 0; hf < 2; ++hf) {
            if (hf) __syncthreads();
            stage_tile(rb, 272, kvmem + (size_t)(b * MEMT + hf * 128) * 2048 + 1024 + hd * XD, 2048, 128, 256, F.tid);
            __syncthreads();
            wave_mma_g<1, 16, true, false, true>(o, ra + F.wave * 16 * 264 + hf * 128, 264, rb, 272, 128, F.lane);
        }
        { const int r = F.lane & 15, q = F.lane >> 4; bf16* orow = xo + (size_t)(b * SEQ + qb * 128 + F.wave * 16 + r) * XW + hd * XD + 4 * q;
#pragma unroll
          for (int nt = 0; nt < 16; ++nt) { u32x2 w; w.x = cvt_pk_bf16(o[0][nt][0] * inv, o[0][nt][1] * inv); w.y = cvt_pk_bf16(o[0][nt][2] * inv, o[0][nt][3] * inv); *(u32x2*)(orow + nt * 16) = w; } }
    }
    __syncthreads();
}

#define AIN(k) ((const float*)(GAS const float*)args.in[k])
#define x_in (AIN(0))
#define mem (AIN(1))
#define mem_g (AIN(2))
#define W_in ((bf16*)(wsp + WS_WIN))
#define W_out ((bf16*)(wsp + WS_WOUT))
#define W_q ((bf16*)(wsp + WS_WQ))
#define W_kv ((bf16*)(wsp + WS_WKV))
#define W_o ((bf16*)(wsp + WS_WO))
#define W_gu ((bf16*)(wsp + WS_WGU))
#define W_dn ((bf16*)(wsp + WS_WDN))
#define anorm ((bf16*)(wsp + WS_ANORM))
#define proj ((bf16*)(wsp + WS_PROJ))
#define hid ((bf16*)(wsp + WS_PROJ))
#define gatez ((float*)(wsp + WS_GATEZ))
#define mixin ((bf16*)(wsp + WS_MIXIN))
#define tmpb ((bf16*)(wsp + WS_TMP))
#define rst ((bf16*)(wsp + WS_SCR))
#define hst ((bf16*)(wsp + WS_SCR + 128 * MiB))
#define dft ((bf16*)(wsp + WS_DFT))
#define ut ((bf16*)(wsp + WS_UT))
#define xq ((bf16*)(wsp + WS_XQ))
#define xo ((bf16*)(wsp + WS_XO))
#define kvmem ((bf16*)(wsp + WS_KVMEM))
#define memn ((bf16*)(wsp + WS_MEMN))
#define ropec ((float*)(wsp + WS_ROPE))
#define ropes ((float*)(wsp + WS_ROPE) + SEQ * 128)
#define fwt ((bf16*)(wsp + (layer == 0 ? WS_FWT : WS_FWT1)))
#define nyq ((float*)(wsp + WS_FWT + 640 * 1024))
#define rsv ((float*)(wsp + WS_FWT + 768 * 1024))
#define rqv ((float*)(wsp + WS_FWT + 832 * 1024))
#define hq ((signed char*)(wsp + WS_GATEZ))
#define cmaxf ((float*)(wsp + WS_CTL + 256 * 1024))
#define cminf ((float*)(wsp + WS_CTL + 448 * 1024))
#define hout ((float*)(GAS float*)args.out)
#define cq ((unsigned*)(wsp + WS_CTL) + CW_CONVQ)
#define cd (ConvDst{W_out, W_q, W_kv, W_o, W_gu, W_dn, W_in, cmaxf, cminf})
__global__ void __launch_bounds__(NWAVES * 64, 2) fwd_kernel(Args args) {
    extern __shared__ __attribute__((aligned(16))) unsigned char lds[];
    Frame F;
    F.lds = (LAS unsigned char*)lds;
    F.tid = threadIdx.x; F.lane = F.tid & 63; F.wave = __builtin_amdgcn_readfirstlane(F.tid >> 6);
    F.bid = blockIdx.x; F.G = gridDim.x; { const int bx = blockIdx.x; F.vcu = (F.G % 8 == 0) ? (bx % 8) * (F.G / 8) + bx / 8 : bx; }
    F.gw = F.vcu * NWAVES + F.wave; F.NGW = F.G * NWAVES;
    unsigned char* ws = (unsigned char*)(GAS unsigned char*)args.ws; F.ws = ws;
    volatile LAS unsigned* MISC = (volatile LAS unsigned*)(F.lds + MISC_OFF);
    for (int u = F.tid; u < (LDS_BYTES - LDSCTL_OFF) / 4; u += NWAVES * 64) ((LAS unsigned*)(F.lds + LDSCTL_OFF))[u] = 0u;
    __syncthreads();
    XcdBarrier bar; bar.bar = (unsigned*)(ws + WS_CTL) + CW_BAR; bar.x = 0; bar.st = nullptr;
    if (args.single) bar = xcd_barrier_post((unsigned*)(ws + WS_CTL) + CW_BAR, MISC + 8);
#define GRID_BAR() do { if (args.single) xcd_barrier(bar); } while (0)
#define RELAUNDER() do { { int b_ = blockIdx.x; asm volatile("" : "+s"(b_)); F.bid = b_; } wsp = (GAS unsigned char*)args.ws; asm volatile("" : "+s"(wsp)); int t_ = threadIdx.x; asm volatile("" : "+v"(t_)); F.tid = t_; F.lane = t_ & 63; F.wave = __builtin_amdgcn_readfirstlane(t_ >> 6); F.gw = F.vcu * NWAVES + F.wave; } while (0)

    GAS unsigned char* wsp = (GAS unsigned char*)args.ws;
    const int lo = args.ph_lo, hi = args.ph_hi;
#ifndef PHASE_MASK
#define PHASE_MASK 0xffffffffu
#endif
#define IN(k) (((PHASE_MASK >> (k)) & 1u) && lo <= (k) && (k) < hi)

    for (int layer = args.layer_lo; layer < args.layer_hi; ++layer) {
        const int cv_total = layer + 1 < NL ? CV_ITEMS_ALL : CV_ITEMS;
        if (IN(PH_PRE) && layer == 0) {
            RELAUNDER();
            const int gt = F.vcu * (NWAVES * 64) + F.tid, NT = F.G * NWAVES * 64;
            for (int i = gt; i < SEQ * 128; i += NT) { const int pos = i >> 7, j = i & 127;
                const float inv = exp2f(-(float)j * (13.287712379549449f / 128.0f)); const float ang = (float)pos * inv;
                const double rev = (double)ang * 0.15915494309189535; const float fr = (float)(rev - __builtin_rint(rev));
                ropec[i] = __builtin_amdgcn_cosf(fr); ropes[i] = __builtin_amdgcn_sinf(fr); }
            for (int i = gt; i < SEQ * 2048 / 8; i += NT) { const int k = i >> 8, c8 = (i & 255) * 8; const int sn = k >> 11, kk = k & 2047;
                float v[8];
#pragma unroll
                for (int j = 0; j < 8; ++j) { const int mm = (kk * (c8 + j)) & 4095; const float fr = (float)mm * (1.0f / 4096.0f); v[j] = sn ? __builtin_amdgcn_sinf(fr) : __builtin_amdgcn_cosf(fr); }
                u32x4 w; w.x = cvt_pk_bf16(v[0], v[1]); w.y = cvt_pk_bf16(v[2], v[3]); w.z = cvt_pk_bf16(v[4], v[5]); w.w = cvt_pk_bf16(v[6], v[7]);
                *(u32x4*)(dft + (size_t)k * 2048 + c8) = w; }
            for (int row = F.gw; row < NB * MEMT; row += F.NGW) rms_row_to_bf16(mem + (size_t)row * D, mem_g, memn + (size_t)row * D, F.lane);
            for (int l = 0; l < NL; ++l) { colmax_pass(F, AIN(19) + (size_t)l * D * FFH, D, FFH, AIN(18) + (size_t)l * D, cmaxf + (size_t)l * 2 * FFH);
                colmax_pass(F, AIN(20) + (size_t)l * D * FFH, D, FFH, AIN(18) + (size_t)l * D, cmaxf + (size_t)l * 2 * FFH + FFH);
                if (l >= 1) colmax_pass(F, AIN(4) + (size_t)l * D * NPROJ, D, NPROJ, AIN(3) + (size_t)l * D, cminf + (size_t)l * NPROJ); }
            { const int gt2 = F.vcu * (NWAVES * 64) + F.tid; if (gt2 < NPROJ) cminf[gt2] = 127.0f; }
        }
        if (IN(PH_CONV) && layer == 0) {
            RELAUNDER();
            LAS unsigned* scr = (LAS unsigned*)(F.lds + F.wave * 16384);
            convert_matrix(F, AIN(4), D, NPROJ, W_in, 0, 0, scr, AIN(3), nullptr);
            { const int gt = F.vcu * (NWAVES * 64) + F.tid, NT = F.G * NWAVES * 64;
              for (int i = gt; i < NL * FG * 32 * 128; i += NT) { const int c = i & 127, d4 = (i >> 7) & 31, g = (i >> 12) & (FG - 1), l = i >> 15;
                  const float* fw = AIN(8) + (size_t)l * FG * FD * FD + (size_t)g * FD * FD + 4 * d4;
                  f32x4 ac = (f32x4){0.f, 0.f, 0.f, 0.f}, as = ac;
#pragma unroll 16
                  for (int cp = 0; cp < 128; ++cp) { const float fr = (float)((c * cp) & 127) * (1.0f / 128.0f); const f32x4 w = *(const f32x4*)(fw + cp * FD); ac = ac + w * __builtin_amdgcn_cosf(fr); as = as - w * __builtin_amdgcn_sinf(fr); }
                  bf16* fo = (bf16*)(wsp + (l == 0 ? WS_FWT : WS_FWT1)) + ((size_t)g * 256 + 4 * d4) * 128 + c;
#pragma unroll
                  for (int jd = 0; jd < 4; ++jd) { fo[jd * 128] = (bf16)(cvt_pk_bf16(ac[jd] * 0.0013810679320049757f, 0.f) & 0xffff); fo[128 * 128 + jd * 128] = (bf16)(cvt_pk_bf16(as[jd] * 0.0013810679320049757f, 0.f) & 0xffff); } } }
            x_to_stream(F, x_in, anorm, rsv);
            __syncthreads();
            GRID_BAR();
        }
        if (IN(PH_INPROJ)) {
            RELAUNDER();
            if (layer == 0) { pg8::Gemm g{anorm, W_in, M, NPROJ, D}; pg8::StaticOrder S; S.init(M, NPROJ, F.G, F.bid);
              pg8::EpiInProj E{proj, ropec, ropes, rsv, cminf};
              pg8::gemm_phase<pg8::EpiInProj, pg8::StaticOrder, PG8_ALIGN, PG8_SP2, false>(F.lds, g, S, E); }
            else { pg8::Gemm g{(const bf16*)hq, W_in, M, NPROJ, D}; pg8::StaticOrder S; S.init(M, NPROJ, F.G, F.bid);
              pg8::EpiInProj E{proj, ropec, ropes, rqv, cminf + (size_t)layer * NPROJ};
              pg8::gemm_phase<pg8::EpiInProj, pg8::StaticOrder, PG8_ALIGN, PG8_SP2, true>(F.lds, g, S, E); }
            GRID_BAR();
        }
        if (IN(PH_MIXA)) {
            RELAUNDER();
            const int bid = F.bid;
            unsigned* donew = cq + 64 * (layer * 2 + 1);
            if (bid < 128) ret_state_pass(F, bid, 128, proj, rst);
            else hgrn_state_pass(F, bid - 128, 128, proj, gatez, AIN(6), layer, hst);
            RELAUNDER();
            fourier_ut2(F, bid, proj, fwt, ut, nyq);
            { VM_WAIT(); __syncthreads(); if (F.tid == 0) __hip_atomic_fetch_add(donew, 1u, __ATOMIC_RELAXED, __HIP_MEMORY_SCOPE_AGENT); }
            conv_pull(F, args.in, layer, cq + 64 * (layer * 2 + 0), cv_total, cv_total, cd, MISC + 16, donew, 256u);
            GRID_BAR();
        }
        if (IN(PH_MIXB)) {
            RELAUNDER();
            const int bid = F.bid; const float* hng = AIN(7) + (size_t)layer * HW; const float* fbias = AIN(9) + (size_t)layer * FW;
            if (bid < 64) {
                pg8::Gemm g{dft, ut, SEQ, SEQ, 2048};
                { pg8::OneUnit S{bid >> 3, bid & 7}; pg8::EpiF32 E{(float*)(ws + WS_TMP), 2048};
                  pg8::gemm_phase<pg8::EpiF32, pg8::OneUnit, PG8_ALIGN, PG8_SP2>(F.lds, g, S, E); }
                RELAUNDER();
                { pg8::OneUnit S{8 + (bid >> 3), 8 + (bid & 7)}; pg8::EpiFourier2 E{mixin, fbias, nyq, (const float*)(ws + WS_TMP)};
                  pg8::gemm_phase<pg8::EpiFourier2, pg8::OneUnit, PG8_ALIGN, PG8_SP2>(F.lds, g, S, E); }
                RELAUNDER();
                hgrn_output_pass(F, 832 + bid, 64, 1024, proj, gatez, AIN(6), layer, hst, hng, mixin);
            } else {
                const int idx = bid - 64;
                if (idx < 64) fourier_mid_row(F, idx * NWAVES + F.wave, 64 * NWAVES, ut, nyq, fbias, mixin);
                ret_output_pass(F, idx, 192, proj, rst, AIN(5) + (size_t)layer * RW, mixin);
                if (idx < 128) hgrn_output_pass(F, idx, 128, 384, proj, gatez, AIN(6), layer, hst, hng, mixin);
                else hgrn_output_pass(F, 384 + (idx - 128), 64, 832, proj, gatez, AIN(6), layer, hst, hng, mixin);
            }
            conv_pull(F, args.in, layer, cq + 64 * (layer * 2 + 0), CV_P_ITEMS, cv_total, cd, MISC + 16, nullptr, 0u);
            GRID_BAR();
        }
        if (IN(PH_WOUT)) {
            RELAUNDER();
            pg8::Gemm g{mixin, W_out, M, D, D}; pg8::StaticOrder S; S.init(M, D, F.G, F.bid);
            pg8::EpiBf16 E{tmpb, D, 1.0f, nullptr};
            pg8::gemm_phase<pg8::EpiBf16, pg8::StaticOrder, PG8_ALIGN, PG8_SP2>(F.lds, g, S, E);
            GRID_BAR();
        }
        if (IN(PH_NORM1)) {
            RELAUNDER();
            norm_phase(F, tmpb, layer == 0 ? x_in : nullptr, anorm, nullptr, AIN(11) + (size_t)layer * D, rsv);
            GRID_BAR();
        }
        if (IN(PH_XQ)) {
            RELAUNDER();
            { pg8::Gemm g{anorm, W_q, M, XW, D}; pg8::StaticOrder S; S.init(M, XW, F.G, F.bid);
              pg8::EpiBf16 E{xq, XW, 0.0625f, rsv};
              pg8::gemm_phase<pg8::EpiBf16, pg8::StaticOrder, PG8_ALIGN, PG8_SP2>(F.lds, g, S, E); }
            { pg8::Gemm g{memn, W_kv, NB * MEMT, 2 * XW, D}; pg8::StaticOrder S; S.init(NB * MEMT, 2 * XW, F.G, F.bid - 128);
              pg8::EpiBf16 E{kvmem, 2 * XW, 1.0f, nullptr};
              pg8::gemm_phase<pg8::EpiBf16, pg8::StaticOrder, PG8_ALIGN, PG8_SP2>(F.lds, g, S, E); }
            { unsigned* donex = cq + 64 * (4 + layer);
              if (F.bid < 144) { VM_WAIT(); __syncthreads(); if (F.tid == 0) __hip_atomic_fetch_add(donex, 1u, __ATOMIC_RELAXED, __HIP_MEMORY_SCOPE_AGENT); }
              conv_pull(F, args.in, layer, cq + 64 * (layer * 2 + 0), cv_total, cv_total, cd, MISC + 16, donex, 144u); }
            GRID_BAR();
        }
        if (IN(PH_XATT)) {
            RELAUNDER();
            xattn_phase(F, xq, kvmem, xo);
            GRID_BAR();
        }
        if (IN(PH_XWO)) {
            RELAUNDER();
            pg8::Gemm g{xo, W_o, M, D, XW}; pg8::StaticOrder S; S.init(M, D, F.G, F.bid);
            pg8::EpiBf16 E{tmpb, D, 1.0f, nullptr};
            pg8::gemm_phase<pg8::EpiBf16, pg8::StaticOrder, PG8_ALIGN, PG8_SP2>(F.lds, g, S, E);
            GRID_BAR();
        }
        if (IN(PH_NORM2)) {
            RELAUNDER();
            norm_phase_q(F, tmpb, anorm, AIN(17) + (size_t)layer * D, hq, rqv, nullptr);
            conv_pull(F, args.in, layer, cq + 64 * (layer * 2 + 0), CV_ITEMS, cv_total, cd, MISC + 16, nullptr, 0u);
            GRID_BAR();
        }
        if (IN(PH_FFN1)) {
            RELAUNDER();
            pg8::Gemm g{(const bf16*)hq, W_gu, M, 2 * FFH, D}; pg8::StaticOrder S; S.init(M, 2 * FFH, F.G, F.bid);
            pg8::EpiSwiGluQ E{hid, FFH, rqv, cmaxf + (size_t)layer * 2 * FFH, cmaxf + (size_t)layer * 2 * FFH + FFH};
            pg8::gemm_phase<pg8::EpiSwiGluQ, pg8::StaticOrder, PG8_ALIGN, PG8_SP2, true>(F.lds, g, S, E);
            if (layer + 1 < NL) {
                unsigned* donef = cq + 64 * (8 + layer);
                VM_WAIT(); __syncthreads(); if (F.tid == 0) __hip_atomic_fetch_add(donef, 1u, __ATOMIC_RELAXED, __HIP_MEMORY_SCOPE_AGENT);
                conv_pull(F, args.in, layer, cq + 64 * (layer * 2 + 0), cv_total, cv_total, cd, MISC + 16, donef, (unsigned)F.G);
            }
            GRID_BAR();
        }
        if (IN(PH_FFN2)) {
            RELAUNDER();
            pg8::Gemm g{hid, W_dn, M, D, FFH}; pg8::StaticOrder S; S.init(M, D, F.G, F.bid);
            pg8::EpiBf16 E{tmpb, D, 1.0f, nullptr};
            pg8::gemm_phase<pg8::EpiBf16, pg8::StaticOrder, PG8_ALIGN, PG8_SP2>(F.lds, g, S, E);
            GRID_BAR();
        }
        if (IN(PH_NORM3)) {
            RELAUNDER();
            const bool more = layer + 1 < NL;
            if (more) norm_phase_q(F, tmpb, anorm, AIN(22) + (size_t)layer * D, hq, rqv, rsv);
            else norm_phase(F, tmpb, nullptr, anorm, hout, AIN(22) + (size_t)layer * D, nullptr);
            if (more) conv_pull(F, args.in, layer, cq + 64 * (layer * 2 + 0), cv_total, cv_total, cd, MISC + 16, nullptr, 0u);
            if (more) GRID_BAR();
        }
    }
#undef IN
#undef GRID_BAR
}

#undef x_in
#undef mem
#undef mem_g
#undef W_in
#undef W_out
#undef W_q
#undef W_kv
#undef W_o
#undef W_gu
#undef W_dn
#undef anorm
#undef proj
#undef hid
#undef gatez
#undef mixin
#undef tmpb
#undef rst
#undef hst
#undef dft
#undef ut
#undef xq
#undef xo
#undef kvmem
#undef memn
#undef ropec
#undef ropes
#undef fwt
#undef nyq
#undef rsv
#undef rqv
#undef hq
#undef cmaxf
#undef cminf
#undef hout
#undef cq
#undef cd
extern "C" void kernel_launch(void* const* d_in, const int* in_sizes, int n_in, void* d_out, int out_size, void* d_ws, size_t ws_size, hipStream_t stream) {
    static int grid = 0;
    if (grid == 0) {
        if (n_in != 23 || out_size != M * D || ws_size < WS_END) { fprintf(stderr, "kernel_launch: unexpected shapes (n_in %d, out %d, ws %zu < %zu)\n", n_in, out_size, ws_size, (size_t)WS_END); grid = -1; return; }
        int dev = 0, cus = 0, per_cu = 0;
        if (hipGetDevice(&dev) != hipSuccess || hipDeviceGetAttribute(&cus, hipDeviceAttributeMultiprocessorCount, dev) != hipSuccess) { grid = -1; return; }
        if (hipFuncSetAttribute((const void*)fwd_kernel, hipFuncAttributeMaxDynamicSharedMemorySize, LDS_BYTES) != hipSuccess) { fprintf(stderr, "kernel_launch: hipFuncSetAttribute failed\n"); grid = -1; return; }
        if (hipOccupancyMaxActiveBlocksPerMultiprocessor(&per_cu, (const void*)fwd_kernel, NWAVES * 64, LDS_BYTES) != hipSuccess || per_cu < 1) fprintf(stderr, "kernel_launch: occupancy query reports %d\n", per_cu);
        (void)hipGetLastError();
        grid = cus;
    }
    if (grid < 0) return;
    (void)in_sizes;
    if (hipMemsetAsync((char*)d_ws + WS_CTL, 0, CTL_ZERO_BYTES, stream) != hipSuccess) return;
    Args a{};
    for (int i = 0; i < 23; ++i) a.in[i] = (const float*)d_in[i];
    a.out = (float*)d_out; a.ws = (unsigned char*)d_ws; a.pad = 0;
#if ONE_LAUNCH
    a.layer_lo = 0; a.layer_hi = NL; a.ph_lo = 0; a.ph_hi = PH_COUNT; a.single = 1;
    hipLaunchKernelGGL(fwd_kernel, dim3(grid), dim3(NWAVES * 64), LDS_BYTES, stream, a);
#else
    a.single = 0;
    for (int layer = 0; layer < NL; ++layer)
        for (int ph = (layer == 0 ? PH_PRE : PH_CONV); ph < PH_COUNT; ++ph) {
            a.layer_lo = layer; a.layer_hi = layer + 1; a.ph_lo = ph; a.ph_hi = ph + 1;
            hipLaunchKernelGGL(fwd_kernel, dim3(grid), dim3(NWAVES * 64), LDS_BYTES, stream, a);
        }
#endif
}
```

```cpp
#include <hip/hip_runtime.h>
#include <cstdio>
#include <cstdint>

#ifndef ONE_LAUNCH
#define ONE_LAUNCH 1
#endif

#define LAS __attribute__((address_space(3)))
#define GAS __attribute__((address_space(1)))
typedef unsigned short bf16;
typedef short bf16x8 __attribute__((ext_vector_type(8)));
typedef float f32x4 __attribute__((ext_vector_type(4)));
typedef float f32x2 __attribute__((ext_vector_type(2)));
typedef unsigned u32x4 __attribute__((ext_vector_type(4)));
typedef unsigned u32x2 __attribute__((ext_vector_type(2)));
typedef int i32x4 __attribute__((ext_vector_type(4)));

constexpr int D = 4096, NB = 2, SEQ = 4096, NL = 2, M = NB * SEQ;
constexpr int RW = 2048, RH = 8, RD = 256;
constexpr int HW = 1024, HH = 8, HD = 128;
constexpr int FW = 1024, FG = 8, FD = 128;
constexpr int NPROJ = 14336;
constexpr int XW = 1024, XH = 4, XD = 256, MEMT = 256;
constexpr int FFH = 11008;
constexpr int C_RQ = 0, C_RK = 2048, C_RV = 4096, C_RG = 6144, C_HQ = 8192, C_HFF = 9216, C_HFB = 10240, C_HI = 11264, C_HG = 12288, C_FZ = 13312;
constexpr float RMS_EPS = 1e-6f, GN_EPS = 1e-5f;

constexpr size_t MiB = 1u << 20;
constexpr size_t WS_CTL = 0, CTL_ZERO_BYTES = 1 * MiB;
constexpr size_t WS_WIN = 1 * MiB;
constexpr size_t WS_WOUT = 113 * MiB;
constexpr size_t WS_WQ = 145 * MiB;
constexpr size_t WS_WKV = 153 * MiB;
constexpr size_t WS_WO = 169 * MiB;
constexpr size_t WS_WGU = 177 * MiB;
constexpr size_t WS_WDN = 349 * MiB;
constexpr size_t WS_ANORM = 435 * MiB;
constexpr size_t WS_PROJ = 499 * MiB;
constexpr size_t WS_GATEZ = 723 * MiB;
constexpr size_t WS_MIXIN = 787 * MiB;
constexpr size_t WS_TMP = 851 * MiB;
constexpr size_t WS_SCR = 979 * MiB;
constexpr size_t WS_DFT = 1171 * MiB;
constexpr size_t WS_UT = 1235 * MiB;
constexpr size_t WS_XQ = 1267 * MiB;
constexpr size_t WS_XO = 1283 * MiB;
constexpr size_t WS_KVMEM = 1299 * MiB;
constexpr size_t WS_MEMN = 1301 * MiB;
constexpr size_t WS_ROPE = 1305 * MiB;
constexpr size_t WS_FWT = 1309 * MiB;
constexpr size_t WS_FWT1 = 1310 * MiB;
constexpr size_t WS_END = 1311 * MiB;
constexpr int CW_BAR = 4096, CW_CONVQ = 8192;

constexpr int LDS_BYTES = 147456;
constexpr int LDSCTL_OFF = LDS_BYTES - 512, MISC_OFF = LDSCTL_OFF + 320;
constexpr int NWAVES = 8;

typedef __bf16 bf16x2_t __attribute__((ext_vector_type(2)));
__device__ __forceinline__ unsigned cvt_pk_bf16(float lo, float hi) { const f32x2 v = {lo, hi}; return __builtin_bit_cast(unsigned, __builtin_convertvector(v, bf16x2_t)); }
__device__ __forceinline__ float bf2f(unsigned b) { return __uint_as_float(b << 16); }
__device__ __forceinline__ float bflo(unsigned w) { return __uint_as_float(w << 16); }
__device__ __forceinline__ float bfhi(unsigned w) { return __uint_as_float(w & 0xffff0000u); }
__device__ __forceinline__ float wave_sum(float v) {
#pragma unroll
    for (int o = 1; o < 64; o <<= 1) v += __shfl_xor(v, o);
    return v;
}
__device__ __forceinline__ float fast_sigmoid(float x) { return __builtin_amdgcn_rcpf(1.0f + __expf(-x)); }
__device__ __forceinline__ float silu_f(float x) { return x * fast_sigmoid(x); }
#define LDS_WAIT() asm volatile("s_waitcnt lgkmcnt(0)" ::: "memory")
#define VM_WAIT() asm volatile("s_waitcnt vmcnt(0)" ::: "memory")

namespace pg8 {
constexpr int BM = 256, BK = 64, HALF = 128, HTB = HALF * BK * 2, STAGE_BYTES = 8 * HTB, NXCD = 8, WGM = 8;
__host__ __device__ __forceinline__ int lds_byte(int r, int c) { const int st = (r >> 4) * 2 + (c >> 5), rr = r & 15, cc = c & 31, ob = rr * 64 + cc * 2; return st * 1024 + (ob ^ (((ob >> 9) & 1) << 5)); }
__host__ __device__ __forceinline__ void stage_rc(int b, int& R, int& C) { const int st = b / 1024, sb = b % 1024, swz = sb ^ (((sb >> 9) & 1) << 5); R = (st >> 1) * 16 + swz / 64; C = (st & 1) * 32 + (swz % 64) / 2; }
__host__ __device__ __forceinline__ int perm32(int rho) { const int n = rho >> 4, i = rho & 15; return 8 * (i >> 2) + 4 * n + (i & 3); }
struct Unit { int pm, pn; };
struct Gemm { const bf16* A; const bf16* Bt; int M, N, K; };
struct StaticOrder {
    int nM, nN, nwg, G, c;
    __host__ __device__ void init(int M_, int N_, int G_, int c_) { nM = M_ / BM; nN = N_ / BM; nwg = nM * nN; G = G_; c = c_; }
    __host__ __device__ bool next(int i, Unit& u) const {
        if (c < 0) return false;
        const long Lx = (long)i * G + c; if (Lx >= nwg) return false;
        int wgid = (int)Lx; { const int q = nwg / NXCD, r = nwg % NXCD, xcd = wgid % NXCD, off = wgid / NXCD; wgid = (xcd < r ? xcd * (q + 1) : r * (q + 1) + (xcd - r) * q) + off; }
        const int nig = WGM * nN, gid = wgid / nig, fm = gid * WGM, gsz = (nM - fm) < WGM ? (nM - fm) : WGM;
        u.pm = fm + ((wgid % nig) % gsz); u.pn = (wgid % nig) / gsz; return true;
    }
    __device__ __forceinline__ void a_ready(const Unit&) const {}
    __device__ __forceinline__ void done(const Unit&) const {}
};

struct EpiF32 {
    static constexpr bool PERM = false;
    static constexpr int NSCALE = 0; __device__ __forceinline__ const float* scale_ptr(const Unit&, int) const { return nullptr; }
    float* C; int ldc;
    __device__ __forceinline__ void operator()(const f32x4 (&acc)[2][2][4][2], const Unit& u, int wr, int wc, int fr, int fq, const LAS float* sl) const {
        const int row0 = u.pm * BM + wr * 64 + fr, col0 = u.pn * BM + wc * 32 + 4 * fq;
#pragma unroll
        for (int ai = 0; ai < 2; ++ai)
#pragma unroll
            for (int m = 0; m < 4; ++m) { float* rowp = C + (size_t)(row0 + ai * HALF + m * 16) * ldc + col0;
#pragma unroll
                for (int bj = 0; bj < 2; ++bj)
#pragma unroll
                    for (int n = 0; n < 2; ++n) *(f32x4*)(rowp + bj * HALF + n * 16) = acc[ai][bj][m][n]; }
    }
};
struct EpiBf16 {
    static constexpr bool PERM = true;
    static constexpr int NSCALE = 1;
    __device__ __forceinline__ const float* scale_ptr(const Unit& u, int) const { return rs ? rs + u.pm * BM : nullptr; }
    bf16* O; int ldc; float scale; const float* rs;
    __device__ __forceinline__ void operator()(const f32x4 (&acc)[2][2][4][2], const Unit& u, int wr, int wc, int fr, int fq, const LAS float* sl) const {
        const int row0 = u.pm * BM + wr * 64 + fr, col0 = u.pn * BM + wc * 32 + 8 * fq;
        float scv[2][4];
#pragma unroll
        for (int ai = 0; ai < 2; ++ai)
#pragma unroll
            for (int m = 0; m < 4; ++m) scv[ai][m] = rs ? scale * sl[wr * 64 + fr + ai * HALF + m * 16] : scale;
        asm volatile("" ::: "memory");
#pragma unroll
        for (int ai = 0; ai < 2; ++ai)
#pragma unroll
            for (int m = 0; m < 4; ++m) { bf16* rowp = O + (size_t)(row0 + ai * HALF + m * 16) * ldc + col0; const float sc = scv[ai][m];
#pragma unroll
                for (int bj = 0; bj < 2; ++bj) { const f32x4 v0 = acc[ai][bj][m][0] * sc, v1 = acc[ai][bj][m][1] * sc;
                    u32x4 w; w.x = cvt_pk_bf16(v0[0], v0[1]); w.y = cvt_pk_bf16(v0[2], v0[3]); w.z = cvt_pk_bf16(v1[0], v1[1]); w.w = cvt_pk_bf16(v1[2], v1[3]);
                    *(u32x4*)(rowp + bj * HALF) = w; } }
    }
};
struct EpiInProj {
    static constexpr bool PERM = true;
    static constexpr int NSCALE = 2;
    __device__ __forceinline__ const float* scale_ptr(const Unit& u, int k) const { return k == 0 ? rs + u.pm * BM : cm + u.pn * BM; }
    bf16* proj; const float* ropec; const float* ropes; const float* rs; const float* cm;
    __device__ __forceinline__ void operator()(const f32x4 (&acc)[2][2][4][2], const Unit& u, int wr, int wc, int fr, int fq, const LAS float* sl) const {
        const int row0 = u.pm * BM + wr * 64 + fr, colw = wc * 32 + 8 * fq;
        const LAS float* cp = sl + 256 + colw;
        const f32x4 ca0 = *(const LAS f32x4*)(cp) * (1.0f / 127.0f), ca1 = *(const LAS f32x4*)(cp + 4) * (1.0f / 127.0f), cb0 = *(const LAS f32x4*)(cp + HALF) * (1.0f / 127.0f), cb1 = *(const LAS f32x4*)(cp + HALF + 4) * (1.0f / 127.0f);
        float rsl[2][4];
#pragma unroll
        for (int ai = 0; ai < 2; ++ai)
#pragma unroll
            for (int m = 0; m < 4; ++m) rsl[ai][m] = sl[wr * 64 + fr + ai * HALF + m * 16];
        if (u.pn < 16) {
            const float sc0 = u.pn < 8 ? 0.0625f : 1.0f;
            const f32x4 C0 = *(const f32x4*)(ropec + 16 * 128 + colw), C1 = *(const f32x4*)(ropec + 16 * 128 + colw + 4), S0 = *(const f32x4*)(ropes + 16 * 128 + colw), S1 = *(const f32x4*)(ropes + 16 * 128 + colw + 4);
            f32x4 cc0[2], cc1[2], ss0[2], ss1[2];
#pragma unroll
            for (int ai = 0; ai < 2; ++ai) { const int pos0 = (row0 + ai * HALF) & (SEQ - 1);
                cc0[ai] = *(const f32x4*)(ropec + pos0 * 128 + colw); cc1[ai] = *(const f32x4*)(ropec + pos0 * 128 + colw + 4);
                ss0[ai] = *(const f32x4*)(ropes + pos0 * 128 + colw); ss1[ai] = *(const f32x4*)(ropes + pos0 * 128 + colw + 4); }
            asm volatile("" ::: "memory");
#pragma unroll
            for (int ai = 0; ai < 2; ++ai) {
                f32x4 c0 = cc0[ai], c1 = cc1[ai], s0 = ss0[ai], s1 = ss1[ai];
#pragma unroll
                for (int m = 0; m < 4; ++m) { const int r = row0 + ai * HALF + m * 16; const float sc = sc0 * rsl[ai][m];
                    if (m) { const f32x4 n0 = c0 * C0 - s0 * S0, n1 = c1 * C1 - s1 * S1; s0 = s0 * C0 + c0 * S0; s1 = s1 * C1 + c1 * S1; c0 = n0; c1 = n1; }
                    const f32x4 a0 = acc[ai][0][m][0] * ca0, a1 = acc[ai][0][m][1] * ca1, b0 = acc[ai][1][m][0] * cb0, b1 = acc[ai][1][m][1] * cb1;
                    const f32x4 o10 = (a0 * c0 - b0 * s0) * sc, o11 = (a1 * c1 - b1 * s1) * sc, o20 = (a0 * s0 + b0 * c0) * sc, o21 = (a1 * s1 + b1 * c1) * sc;
                    bf16* rowp = proj + (size_t)r * NPROJ + u.pn * BM + colw;
                    u32x4 w; w.x = cvt_pk_bf16(o10[0], o10[1]); w.y = cvt_pk_bf16(o10[2], o10[3]); w.z = cvt_pk_bf16(o11[0], o11[1]); w.w = cvt_pk_bf16(o11[2], o11[3]);
                    *(u32x4*)(rowp) = w;
                    w.x = cvt_pk_bf16(o20[0], o20[1]); w.y = cvt_pk_bf16(o20[2], o20[3]); w.z = cvt_pk_bf16(o21[0], o21[1]); w.w = cvt_pk_bf16(o21[2], o21[3]);
                    *(u32x4*)(rowp + HALF) = w; } }
        } else {
            asm volatile("" ::: "memory");
#pragma unroll
            for (int ai = 0; ai < 2; ++ai)
#pragma unroll
                for (int m = 0; m < 4; ++m) { bf16* rowp = proj + (size_t)(row0 + ai * HALF + m * 16) * NPROJ + u.pn * BM + colw; const float sc = rsl[ai][m];
                    { const f32x4 v0 = acc[ai][0][m][0] * ca0 * sc, v1 = acc[ai][0][m][1] * ca1 * sc;
                      u32x4 w; w.x = cvt_pk_bf16(v0[0], v0[1]); w.y = cvt_pk_bf16(v0[2], v0[3]); w.z = cvt_pk_bf16(v1[0], v1[1]); w.w = cvt_pk_bf16(v1[2], v1[3]); *(u32x4*)(rowp) = w; }
                    { const f32x4 v0 = acc[ai][1][m][0] * cb0 * sc, v1 = acc[ai][1][m][1] * cb1 * sc;
                      u32x4 w; w.x = cvt_pk_bf16(v0[0], v0[1]); w.y = cvt_pk_bf16(v0[2], v0[3]); w.z = cvt_pk_bf16(v1[0], v1[1]); w.w = cvt_pk_bf16(v1[2], v1[3]); *(u32x4*)(rowp + HALF) = w; } }
        }
    }
};
struct EpiSwiGlu {
    static constexpr bool PERM = true;
    static constexpr int NSCALE = 0; __device__ __forceinline__ const float* scale_ptr(const Unit&, int) const { return nullptr; }
    bf16* H; int ldc; const float* rs;
    __device__ __forceinline__ void operator()(const f32x4 (&acc)[2][2][4][2], const Unit& u, int wr, int wc, int fr, int fq, const LAS float* sl) const {
        const int row0 = u.pm * BM + wr * 64 + fr, col0 = u.pn * HALF + wc * 32 + 8 * fq;
#pragma unroll
        for (int ai = 0; ai < 2; ++ai)
#pragma unroll
            for (int m = 0; m < 4; ++m) { bf16* rowp = H + (size_t)(row0 + ai * HALF + m * 16) * ldc + col0; const float sc = rs[row0 + ai * HALF + m * 16];
                f32x4 v0, v1;
#pragma unroll
                for (int j = 0; j < 4; ++j) { v0[j] = silu_f(acc[ai][0][m][0][j] * sc) * (acc[ai][1][m][0][j] * sc); v1[j] = silu_f(acc[ai][0][m][1][j] * sc) * (acc[ai][1][m][1][j] * sc); }
                u32x4 w; w.x = cvt_pk_bf16(v0[0], v0[1]); w.y = cvt_pk_bf16(v0[2], v0[3]); w.z = cvt_pk_bf16(v1[0], v1[1]); w.w = cvt_pk_bf16(v1[2], v1[3]);
                *(u32x4*)(rowp) = w; }
    }
};
struct EpiSwiGluQ {
    static constexpr bool PERM = true;
    static constexpr int NSCALE = 3;
    __device__ __forceinline__ const float* scale_ptr(const Unit& u, int k) const { return k == 0 ? rq + u.pm * BM : (k == 1 ? cmg : cmu) + u.pn * HALF; }
    bf16* H; int ldc; const float* rq; const float* cmg; const float* cmu;
    __device__ __forceinline__ void operator()(const f32x4 (&acc)[2][2][4][2], const Unit& u, int wr, int wc, int fr, int fq, const LAS float* sl) const {
        const int row0 = u.pm * BM + wr * 64 + fr, col0 = u.pn * HALF + wc * 32 + 8 * fq;
        const int cl = wc * 32 + 8 * fq;
        const f32x4 sg0 = *(const LAS f32x4*)(sl + 256 + cl) * (1.0f / 127.0f), sg1 = *(const LAS f32x4*)(sl + 256 + cl + 4) * (1.0f / 127.0f);
        const f32x4 su0 = *(const LAS f32x4*)(sl + 512 + cl) * (1.0f / 127.0f), su1 = *(const LAS f32x4*)(sl + 512 + cl + 4) * (1.0f / 127.0f);
        float rql[2][4];
#pragma unroll
        for (int ai = 0; ai < 2; ++ai)
#pragma unroll
            for (int m = 0; m < 4; ++m) rql[ai][m] = sl[wr * 64 + fr + ai * HALF + m * 16];
        asm volatile("" ::: "memory");
#pragma unroll
        for (int ai = 0; ai < 2; ++ai)
#pragma unroll
            for (int m = 0; m < 4; ++m) { bf16* rowp = H + (size_t)(row0 + ai * HALF + m * 16) * ldc + col0; const float sc = rql[ai][m];
                f32x4 v0, v1;
#pragma unroll
                for (int j = 0; j < 4; ++j) { v0[j] = silu_f(acc[ai][0][m][0][j] * (sc * sg0[j])) * (acc[ai][1][m][0][j] * (sc * su0[j])); v1[j] = silu_f(acc[ai][0][m][1][j] * (sc * sg1[j])) * (acc[ai][1][m][1][j] * (sc * su1[j])); }
                u32x4 w; w.x = cvt_pk_bf16(v0[0], v0[1]); w.y = cvt_pk_bf16(v0[2], v0[3]); w.z = cvt_pk_bf16(v1[0], v1[1]); w.w = cvt_pk_bf16(v1[2], v1[3]);
                *(u32x4*)(rowp) = w; }
    }
};
struct SkipOrder : StaticOrder {
    int skip0, nskip;
    __device__ __forceinline__ bool next(int i, Unit& u) const { if (!StaticOrder::next(i, u)) return false; if (u.pn >= skip0) u.pn += nskip; return true; }
};
struct OneUnit {
    int pm, pn;
    __device__ __forceinline__ bool next(int i, Unit& u) const { if (pm < 0 || i > 0) return false; u.pm = pm; u.pn = pn; return true; }
    __device__ __forceinline__ void a_ready(const Unit&) const {}
    __device__ __forceinline__ void done(const Unit&) const {}
};
struct EpiFourier2 {
    static constexpr bool PERM = false;
    bf16* O; const float* bias; const float* nyq; const float* fa;
    static constexpr int NSCALE = 0; __device__ __forceinline__ const float* scale_ptr(const Unit&, int) const { return nullptr; }
    __device__ __forceinline__ void operator()(const f32x4 (&acc)[2][2][4][2], const Unit& u, int wr, int wc, int fr, int fq, const LAS float* sl) const {
        const int krow0 = (u.pm - 8) * BM + wr * 64 + fr, cbase = (u.pn - 8) * BM + wc * 32 + 4 * fq, b = cbase >> 10, colm0 = cbase & 1023;
#pragma unroll
        for (int ai = 0; ai < 2; ++ai)
#pragma unroll
            for (int m = 0; m < 4; ++m) { const int k = krow0 + ai * HALF + m * 16; const float sg = (k & 1) ? -1.0f : 1.0f;
                const float* ap = fa + (size_t)k * 2048 + cbase;
                bf16* row1 = O + (size_t)(b * SEQ + k) * D + 3072 + colm0; bf16* row2 = O + (size_t)(b * SEQ + ((SEQ - k) & (SEQ - 1))) * D + 3072 + colm0;
#pragma unroll
                for (int bj = 0; bj < 2; ++bj)
#pragma unroll
                    for (int n = 0; n < 2; ++n) { const int off = bj * HALF + n * 16;
                        const f32x4 av = *(const f32x4*)(ap + off); const f32x4 e = *(const f32x4*)(nyq + cbase + off) * sg + *(const f32x4*)(bias + colm0 + off); const f32x4 bv = acc[ai][bj][m][n];
                        const f32x4 p = av + bv + e, qv = av - bv + e;
                        u32x2 w; w.x = cvt_pk_bf16(p[0], p[1]); w.y = cvt_pk_bf16(p[2], p[3]); *(u32x2*)(row1 + off) = w;
                        if (k != 0) { w.x = cvt_pk_bf16(qv[0], qv[1]); w.y = cvt_pk_bf16(qv[2], qv[3]); *(u32x2*)(row2 + off) = w; } }
                asm volatile("" ::: "memory"); }
    }
};

template <class Epi, class Sched, bool ALIGN_EPI = false, bool SP2 = false, bool I8 = false>
__device__ __forceinline__ void gemm_phase(LAS unsigned char* lds, const Gemm g, const Sched& S, const Epi& E) {
    int tid_ = threadIdx.x; asm volatile("" : "+v"(tid_));
    const int tid = tid_, wid = __builtin_amdgcn_readfirstlane(tid >> 6), lane = tid & 63, wr = wid >> 2, wc = wid & 3, fr = lane & 15, fq = lane >> 4;
    const int KB = I8 ? g.K : 2 * g.K, nt = KB / (BK * 2);
    unsigned voffA[2], voffB[2];
#pragma unroll
    for (int i = 0; i < 2; ++i) { int R, C; stage_rc(tid * 16 + i * 8192, R, C); const int Rb = Epi::PERM ? ((R & ~31) + perm32(R & 31)) : R;
        voffA[i] = (unsigned)(R * KB + 2 * C); voffB[i] = (unsigned)(Rb * KB + 2 * C); }
    const size_t kstep = (size_t)(BK * 2);
    const size_t hstep = (size_t)HALF * KB;
    const size_t tstep = 2 * hstep;
    const unsigned ldsw = (unsigned)wid * 1024u;
    const int aoff = lds_byte(wr * 64 + fr, fq * 8), boff = lds_byte(wc * 32 + fr, fq * 8);
#define PG8_SA(b, h) (((b) * 2 + (h)) * HTB)
#define PG8_SB(b, h) ((4 + (b) * 2 + (h)) * HTB)
#define PG8_STAGE(bufoff, gbase, voff) do { _Pragma("unroll") for (int _i = 0; _i < 2; ++_i) \
        __builtin_amdgcn_global_load_lds((const unsigned*)((const char*)(gbase) + (voff)[_i]), (LAS unsigned*)(lds + (bufoff) + ldsw + _i * 8192), 16, 0, 0); } while (0)
#define PG8_LDA(dst, b, h) do { _Pragma("unroll") for (int m = 0; m < 4; ++m) _Pragma("unroll") for (int k = 0; k < 2; ++k) dst[m][k] = *(const LAS bf16x8*)(lds + PG8_SA(b, h) + aoff + m * 2048 + k * 1024); } while (0)
#define PG8_LDB(dst, b, h) do { _Pragma("unroll") for (int n = 0; n < 2; ++n) _Pragma("unroll") for (int k = 0; k < 2; ++k) dst[n][k] = *(const LAS bf16x8*)(lds + PG8_SB(b, h) + boff + n * 2048 + k * 1024); } while (0)
#define PG8_MMA(ai, bj, At, Bt) do { __builtin_amdgcn_s_setprio(1); _Pragma("unroll") for (int m = 0; m < 4; ++m) _Pragma("unroll") for (int n = 0; n < 2; ++n) _Pragma("unroll") for (int k = 0; k < 2; ++k) { \
        if constexpr (I8) acc[ai][bj][m][n] = __builtin_bit_cast(f32x4, __builtin_amdgcn_mfma_i32_16x16x64_i8(__builtin_bit_cast(i32x4, Bt[n][k]), __builtin_bit_cast(i32x4, At[m][k]), __builtin_bit_cast(i32x4, acc[ai][bj][m][n]), 0, 0, 0)); \
        else acc[ai][bj][m][n] = __builtin_amdgcn_mfma_f32_16x16x32_bf16(Bt[n][k], At[m][k], acc[ai][bj][m][n], 0, 0, 0); } __builtin_amdgcn_s_setprio(0); } while (0)
#define PG8_WAIT_V(n) asm volatile("s_waitcnt vmcnt(" #n ")" ::: "memory")
#define PG8_WAIT_L(n) asm volatile("s_waitcnt lgkmcnt(" #n ")" ::: "memory")
#define PG8_BAR __builtin_amdgcn_s_barrier()
#define PG8_SCHED __builtin_amdgcn_sched_barrier(0)
    Unit cur, nxt; int ui = 0;
    if (!S.next(0, cur)) return;
#define PG8_SCALES(unit, par) do { if constexpr (Epi::NSCALE > 0) { if (wid < Epi::NSCALE) { const float* gp_ = E.scale_ptr(unit, wid); \
        if (gp_) __builtin_amdgcn_global_load_lds((const unsigned*)(gp_ + 4 * lane), (LAS unsigned*)(lds + 8 * HTB + (par) * 3072 + wid * 1024), 16, 0, 0); } } } while (0)
    PG8_SCALES(cur, 0);
    f32x4 acc[2][2][4][2];
#pragma unroll
    for (int a = 0; a < 2; ++a)
#pragma unroll
        for (int b = 0; b < 2; ++b)
#pragma unroll
            for (int m = 0; m < 4; ++m)
#pragma unroll
                for (int n = 0; n < 2; ++n) acc[a][b][m][n] = (f32x4){0.f, 0.f, 0.f, 0.f};
    bf16x8 At[4][2], B0[2][2], B1[2][2];
    const char* cA = (const char*)g.A + (size_t)cur.pm * tstep; const char* cB = (const char*)g.Bt + (size_t)cur.pn * tstep;
    S.a_ready(cur);
    if constexpr (SP2) {
        PG8_STAGE(PG8_SB(0, 0), cB, voffB); PG8_STAGE(PG8_SB(0, 1), cB + hstep, voffB); PG8_STAGE(PG8_SA(0, 0), cA, voffA); PG8_STAGE(PG8_SA(0, 1), cA + hstep, voffA);
        if (wr == 1) PG8_BAR;
        PG8_WAIT_V(2); PG8_BAR;
        PG8_STAGE(PG8_SB(1, 0), cB + kstep, voffB); PG8_STAGE(PG8_SA(1, 0), cA + kstep, voffA); PG8_STAGE(PG8_SB(1, 1), cB + hstep + kstep, voffB);
        PG8_WAIT_V(6); PG8_BAR;
    } else {
        PG8_STAGE(PG8_SB(0, 0), cB, voffB); PG8_STAGE(PG8_SA(0, 0), cA, voffA); PG8_STAGE(PG8_SB(0, 1), cB + hstep, voffB); PG8_STAGE(PG8_SA(0, 1), cA + hstep, voffA);
        if (wr == 1) PG8_BAR;
        PG8_WAIT_V(4); PG8_BAR;
        PG8_STAGE(PG8_SB(1, 0), cB + kstep, voffB); PG8_STAGE(PG8_SA(1, 0), cA + kstep, voffA); PG8_STAGE(PG8_SB(1, 1), cB + hstep + kstep, voffB);
        PG8_WAIT_V(6); PG8_BAR;
    }
    for (;;) {
        const bool has_next = S.next(ui + 1, nxt);
        const char* nA = has_next ? (const char*)g.A + (size_t)nxt.pm * tstep : cA; const char* nB = has_next ? (const char*)g.Bt + (size_t)nxt.pn * tstep : cB;
        for (int t = 0; t < nt; t += 2) {
            const bool last = (t == nt - 2);
            const char* a1 = cA + (size_t)(t + 1) * kstep;
            const char* a2 = last ? nA : cA + (size_t)(t + 2) * kstep; const char* b2 = last ? nB : cB + (size_t)(t + 2) * kstep;
            const char* a3 = a2 + kstep; const char* b3 = b2 + kstep;
            if (last && has_next) { S.a_ready(nxt); PG8_SCALES(nxt, (ui + 1) & 1); }
            if constexpr (SP2) {
            PG8_LDB(B0, 0, 0); PG8_LDB(B1, 0, 1); PG8_SCHED; PG8_LDA(At, 0, 0); PG8_STAGE(PG8_SA(1, 1), a1 + hstep, voffA);
            PG8_WAIT_V(8); PG8_WAIT_L(0); PG8_BAR; PG8_MMA(0, 0, At, B0); PG8_MMA(0, 1, At, B1); PG8_BAR; PG8_SCHED;
            PG8_LDA(At, 0, 1); PG8_STAGE(PG8_SB(0, 0), b2, voffB); PG8_STAGE(PG8_SB(0, 1), b2 + hstep, voffB); PG8_STAGE(PG8_SA(0, 0), a2, voffA);
            PG8_WAIT_V(8); PG8_WAIT_L(0); PG8_BAR; PG8_MMA(1, 0, At, B0); PG8_MMA(1, 1, At, B1); PG8_BAR; PG8_SCHED;
            PG8_LDB(B0, 1, 0); PG8_LDB(B1, 1, 1); PG8_SCHED; PG8_LDA(At, 1, 0); PG8_STAGE(PG8_SA(0, 1), a2 + hstep, voffA);
            PG8_WAIT_V(8); PG8_WAIT_L(0); PG8_BAR; PG8_MMA(0, 0, At, B0); PG8_MMA(0, 1, At, B1); PG8_BAR; PG8_SCHED;
            PG8_LDA(At, 1, 1); PG8_STAGE(PG8_SB(1, 0), b3, voffB); PG8_STAGE(PG8_SB(1, 1), b3 + hstep, voffB); PG8_STAGE(PG8_SA(1, 0), a3, voffA);
            PG8_WAIT_V(8); PG8_WAIT_L(0); PG8_BAR; PG8_MMA(1, 0, At, B0); PG8_MMA(1, 1, At, B1); PG8_BAR; PG8_SCHED;
            } else {
            PG8_LDB(B0, 0, 0); PG8_SCHED; PG8_LDA(At, 0, 0); PG8_STAGE(PG8_SA(1, 1), a1 + hstep, voffA);
            PG8_WAIT_L(8); PG8_BAR; PG8_WAIT_L(0); PG8_MMA(0, 0, At, B0); PG8_BAR; PG8_SCHED;
            PG8_LDB(B1, 0, 1); PG8_STAGE(PG8_SB(0, 0), b2, voffB);
            PG8_BAR; PG8_WAIT_L(0); PG8_MMA(0, 1, At, B1); PG8_BAR;
            PG8_LDA(At, 0, 1); PG8_STAGE(PG8_SA(0, 0), a2, voffA);
            PG8_BAR; PG8_WAIT_L(0); PG8_MMA(1, 0, At, B0); PG8_BAR; PG8_SCHED;
            PG8_STAGE(PG8_SB(0, 1), b2 + hstep, voffB);
            PG8_WAIT_V(6); PG8_BAR; PG8_MMA(1, 1, At, B1); PG8_BAR;
            PG8_LDB(B0, 1, 0); PG8_SCHED; PG8_LDA(At, 1, 0); PG8_STAGE(PG8_SA(0, 1), a2 + hstep, voffA);
            PG8_WAIT_L(8); PG8_BAR; PG8_WAIT_L(0); PG8_MMA(0, 0, At, B0); PG8_BAR; PG8_SCHED;
            PG8_LDB(B1, 1, 1); PG8_STAGE(PG8_SB(1, 0), b3, voffB);
            PG8_BAR; PG8_WAIT_L(0); PG8_MMA(0, 1, At, B1); PG8_BAR;
            PG8_LDA(At, 1, 1); PG8_STAGE(PG8_SA(1, 0), a3, voffA);
            PG8_BAR; PG8_WAIT_L(0); PG8_MMA(1, 0, At, B0); PG8_BAR; PG8_SCHED;
            PG8_STAGE(PG8_SB(1, 1), b3 + hstep, voffB);
            PG8_WAIT_V(6); PG8_BAR; PG8_MMA(1, 1, At, B1); PG8_BAR;
            }
        }
        if constexpr (ALIGN_EPI) { if (wr == 0) PG8_BAR; }
        if constexpr (I8) {
#pragma unroll
            for (int a = 0; a < 2; ++a)
#pragma unroll
                for (int b = 0; b < 2; ++b)
#pragma unroll
                    for (int m = 0; m < 4; ++m)
#pragma unroll
                        for (int n = 0; n < 2; ++n) acc[a][b][m][n] = __builtin_convertvector(__builtin_bit_cast(i32x4, acc[a][b][m][n]), f32x4); }
        E(acc, cur, wr, wc, fr, fq, (const LAS float*)(lds + 8 * HTB + (ui & 1) * 3072)); S.done(cur);
        if (!has_next) break;
#pragma unroll
        for (int a = 0; a < 2; ++a)
#pragma unroll
            for (int b = 0; b < 2; ++b)
#pragma unroll
                for (int m = 0; m < 4; ++m)
#pragma unroll
                    for (int n = 0; n < 2; ++n) acc[a][b][m][n] = (f32x4){0.f, 0.f, 0.f, 0.f};
        cur = nxt; cA = nA; cB = nB; ++ui;
        if constexpr (ALIGN_EPI) { if (wr == 1) PG8_BAR; }
    }
    PG8_WAIT_V(0);
    if constexpr (!ALIGN_EPI) { if (wr == 0) PG8_BAR; }
    PG8_BAR;
#undef PG8_SCALES
#undef PG8_SA
#undef PG8_SB
#undef PG8_STAGE
#undef PG8_LDA
#undef PG8_LDB
#undef PG8_MMA
#undef PG8_WAIT_V
#undef PG8_WAIT_L
#undef PG8_BAR
#undef PG8_SCHED
}
}
#define PG8_SP2 true
#define PG8_ALIGN true

#define XB_TMO      128
#define XB_XCNT(j)  (256  + 64 * (j))
#define XB_XSUB(j)  (1280 + 64 * (j))
#define XB_XGEN(j)  (2304 + 64 * (j))
#define XB_TOP      3328
#define XB_TOPGEN   3392
#define XCD_BAR_WORDS 3456
#define XB_SPIN_CAP (1u << 18)
__device__ __forceinline__ unsigned xb_ld(unsigned* p)              { return __hip_atomic_load(p, __ATOMIC_RELAXED, __HIP_MEMORY_SCOPE_AGENT); }
__device__ __forceinline__ unsigned xb_add(unsigned* p, unsigned v) { return __hip_atomic_fetch_add(p, v, __ATOMIC_RELAXED, __HIP_MEMORY_SCOPE_AGENT); }
__device__ __forceinline__ unsigned xb_xcc_id() { return (unsigned)__builtin_amdgcn_s_getreg((3 << 11) | 20) & 0xFu; }
#define XB_SPIN(cond, bar) do { unsigned _sp = 0; while (cond) { __builtin_amdgcn_s_sleep(1); \
    if ((++_sp & 255u) == 0u) { if (xb_ld(&(bar)[XB_TMO])) break; if (_sp > XB_SPIN_CAP) { atomicAdd(&(bar)[XB_TMO], 1u); break; } } } } while (0)
struct XcdBarrier { unsigned* bar; unsigned x; volatile LAS unsigned* st; };
__device__ __forceinline__ XcdBarrier xcd_barrier_post(unsigned* bar, volatile LAS unsigned* st) {
    XcdBarrier b; b.bar = bar; b.x = xb_xcc_id(); b.st = st;
    if (threadIdx.x == 0) (void)xb_add(&bar[XB_XCNT(b.x)], 1u);
    return b;
}
__device__ __forceinline__ void xcd_barrier_complete(unsigned* bar, unsigned x, unsigned& nloc, unsigned& nx) {
    const unsigned G = gridDim.x * gridDim.y * gridDim.z;
    unsigned sum, cnt, mine, sp = 0u;
    for (;;) {
        sum = 0u; cnt = 0u; mine = 0u;
#pragma unroll
        for (unsigned j = 0; j < 16; ++j) { const unsigned c = xb_ld(&bar[XB_XCNT(j)]); sum += c; cnt += (c > 0u) ? 1u : 0u; mine = (j == x) ? c : mine; }
        if (sum == G) break;
        __builtin_amdgcn_s_sleep(1);
        if ((++sp & 255u) == 0u) { if (xb_ld(&bar[XB_TMO])) break; if (sp > XB_SPIN_CAP) { atomicAdd(&bar[XB_TMO], 1u); break; } }
    }
    nloc = mine > 0u ? mine : 1u; nx = cnt > 0u ? cnt : 1u;
}
__device__ __forceinline__ void xcd_barrier(const XcdBarrier& b) {
    asm volatile("s_waitcnt vmcnt(0)" ::: "memory");
    __syncthreads();
    if (threadIdx.x == 0) {
        unsigned* bar = b.bar;
        __builtin_amdgcn_s_waitcnt(0);
        unsigned nloc = b.st[0], nx = b.st[1];
        if (nloc == 0u) { xcd_barrier_complete(bar, b.x, nloc, nx); b.st[0] = nloc; b.st[1] = nx; }
        const unsigned old = xb_add(&bar[XB_XSUB(b.x)], 1u);
        const unsigned gen = old / nloc;
        if (old + 1u == (gen + 1u) * nloc) {
            __builtin_amdgcn_fence(__ATOMIC_RELEASE, "agent");
            asm volatile("s_waitcnt vmcnt(0)" ::: "memory");
            const unsigned og = xb_add(&bar[XB_TOP], 1u);
            const unsigned tg = og / nx;
            if (og + 1u == (tg + 1u) * nx) xb_add(&bar[XB_TOPGEN], 1u);
            else XB_SPIN(xb_ld(&bar[XB_TOPGEN]) == tg, bar);
            __builtin_amdgcn_fence(__ATOMIC_ACQUIRE, "agent");
            xb_add(&bar[XB_XGEN(b.x)], 1u);
            asm volatile("s_waitcnt vmcnt(0)" ::: "memory");
        } else {
            XB_SPIN(xb_ld(&bar[XB_XGEN(b.x)]) == gen, bar);
            __builtin_amdgcn_fence(__ATOMIC_ACQUIRE, "agent");
            asm volatile("s_waitcnt vmcnt(0)" ::: "memory");
        }
    }
    __syncthreads();
}

struct Args { const float* in[23]; float* out; unsigned char* ws; int layer_lo, layer_hi, ph_lo, ph_hi, single, pad; };
struct Frame {
    LAS unsigned char* lds;
    int tid, lane, wave, vcu, G, gw, NGW, bid;
    unsigned char* ws;
};
enum { PH_PRE = 0, PH_CONV, PH_INPROJ, PH_MIXA, PH_MIXB, PH_WOUT, PH_NORM1, PH_XQ, PH_XATT, PH_XWO, PH_NORM2, PH_FFN1, PH_FFN2, PH_NORM3, PH_COUNT };

__device__ __forceinline__ void transpose_item64(const float* W, int K, int N, bf16* WT, int drow0, int k0, int n0, LAS unsigned* scr, int lane, const float* gk) {
    const int m = lane & 15, kp = lane >> 4;
    f32x4 va[8], vb[8];
#pragma unroll
    for (int i = 0; i < 8; ++i) { const float* p = W + (size_t)(k0 + 8 * i + 2 * kp) * N + n0 + 4 * m; va[i] = __builtin_nontemporal_load((const f32x4*)p); vb[i] = __builtin_nontemporal_load((const f32x4*)(p + N)); }
    if (gk) {
#pragma unroll
        for (int i = 0; i < 8; ++i) { const f32x2 g2 = *(const f32x2*)(gk + k0 + 8 * i + 2 * kp); va[i] = va[i] * g2.x; vb[i] = vb[i] * g2.y; } }
#pragma unroll
    for (int i = 0; i < 8; ++i)
#pragma unroll
        for (int j = 0; j < 4; ++j) scr[(4 * m + j) * 33 + 4 * i + kp] = cvt_pk_bf16(va[i][j], vb[i][j]);
    LDS_WAIT(); asm volatile("" ::: "memory");
    const int c = lane & 7;
#pragma unroll
    for (int jj = 0; jj < 8; ++jj) { const int n = (lane >> 3) + 8 * jj; const LAS unsigned* sp = scr + n * 33 + 4 * c;
        u32x4 o; o.x = sp[0]; o.y = sp[1]; o.z = sp[2]; o.w = sp[3];
        __builtin_nontemporal_store(o, (u32x4*)(WT + (size_t)(drow0 + n) * K + k0 + 8 * c)); }
    LDS_WAIT(); asm volatile("" ::: "memory");
}
__device__ __forceinline__ void colmax_pass(Frame& F, const float* W, int K, int N, const float* gk, float* cmax) {
    const int nblk = N / 256, items = (K / 128) * nblk;
    for (int it = F.gw; it < items; it += F.NGW) { const int kb = it / nblk, nb = it - kb * nblk; const float* p = W + (size_t)(kb * 128) * N + nb * 256 + 4 * F.lane;
        f32x4 mx = (f32x4){0.f, 0.f, 0.f, 0.f};
#pragma unroll 8
        for (int kk = 0; kk < 128; ++kk) { const f32x4 w = __builtin_nontemporal_load((const f32x4*)(p + (size_t)kk * N)); const float g = gk[kb * 128 + kk];
            mx.x = fmaxf(mx.x, fabsf(w.x * g)); mx.y = fmaxf(mx.y, fabsf(w.y * g)); mx.z = fmaxf(mx.z, fabsf(w.z * g)); mx.w = fmaxf(mx.w, fabsf(w.w * g)); }
        unsigned* cm = (unsigned*)(cmax + nb * 256 + 4 * F.lane);
        atomicMax(cm + 0, __float_as_uint(mx.x)); atomicMax(cm + 1, __float_as_uint(mx.y)); atomicMax(cm + 2, __float_as_uint(mx.z)); atomicMax(cm + 3, __float_as_uint(mx.w)); }
}
__device__ __forceinline__ unsigned q8(float x) { int v = (int)__builtin_rintf(x); v = v < -127 ? -127 : (v > 127 ? 127 : v); return (unsigned)v & 0xffu; }
__device__ __forceinline__ void transpose_item64_q(const float* W, int K, int N, signed char* WT, int drow0, int k0, int n0, LAS unsigned* scr, int lane, const float* gk, const float* cmax) {
    const int m = lane & 15, kp = lane >> 4;
    f32x4 va[4][4];
#pragma unroll
    for (int i = 0; i < 4; ++i)
#pragma unroll
        for (int kk = 0; kk < 4; ++kk) va[i][kk] = __builtin_nontemporal_load((const f32x4*)(W + (size_t)(k0 + 16 * i + 4 * kp + kk) * N + n0 + 4 * m));
    const f32x4 cm = *(const f32x4*)(cmax + n0 + 4 * m);
    f32x4 inv; inv.x = cm.x > 0.f ? 127.0f / cm.x : 0.f; inv.y = cm.y > 0.f ? 127.0f / cm.y : 0.f; inv.z = cm.z > 0.f ? 127.0f / cm.z : 0.f; inv.w = cm.w > 0.f ? 127.0f / cm.w : 0.f;
#pragma unroll
    for (int i = 0; i < 4; ++i) { const f32x4 g4 = *(const f32x4*)(gk + k0 + 16 * i + 4 * kp);
#pragma unroll
        for (int j = 0; j < 4; ++j) { const float sj = inv[j];
            scr[(4 * m + j) * 17 + 4 * i + kp] = q8(va[i][0][j] * g4.x * sj) | (q8(va[i][1][j] * g4.y * sj) << 8) | (q8(va[i][2][j] * g4.z * sj) << 16) | (q8(va[i][3][j] * g4.w * sj) << 24); } }
    LDS_WAIT(); asm volatile("" ::: "memory");
    const int c = lane & 3;
#pragma unroll
    for (int jj = 0; jj < 4; ++jj) { const int n = (lane >> 2) + 16 * jj; const LAS unsigned* sp = scr + n * 17 + 4 * c;
        u32x4 o; o.x = sp[0]; o.y = sp[1]; o.z = sp[2]; o.w = sp[3];
        __builtin_nontemporal_store(o, (u32x4*)(WT + (size_t)(drow0 + n) * K + k0 + 16 * c)); }
    LDS_WAIT(); asm volatile("" ::: "memory");
}
__device__ __forceinline__ void convert_matrix(Frame& F, const float* W, int K, int N, bf16* WT, int row_off, int mode, LAS unsigned* scr, const float* gk, const float* cmq) {
    const int nblk = N / 64, items = (K / 64) * nblk;
    for (int it = F.gw; it < items; it += F.NGW) {
        const int kb = it / nblk, nb = it % nblk, n0 = 64 * nb;
        const int drow0 = mode == 0 ? row_off + n0 : ((n0 >> 7) * 256 + (mode == 2 ? 128 : 0) + (n0 & 127));
        if (cmq) transpose_item64_q(W, K, N, (signed char*)WT, drow0, 64 * kb, n0, scr, F.lane, gk, cmq);
        else transpose_item64(W, K, N, WT, drow0, 64 * kb, n0, scr, F.lane, gk);
    }
}

constexpr int CV1 = 64 * 64, CV2 = CV1 + 64 * 16, CV3 = CV2 + 64 * 16, CV4 = CV3 + 64 * 16, CV5 = CV4 + 16 * 64, CV6 = CV5 + 64 * 172, CV7 = CV6 + 64 * 172, CV8 = CV7 + 172 * 64;
constexpr int CV9 = CV8 + 64 * 224;
constexpr int CV_PER_ITEM = 32, CV_ITEMS = CV8 / CV_PER_ITEM, CV_ITEMS_ALL = CV9 / CV_PER_ITEM, CV_P_ITEMS = CV5 / CV_PER_ITEM;
static_assert(CV8 % CV_PER_ITEM == 0 && CV5 % CV_PER_ITEM == 0 && CV9 % CV_PER_ITEM == 0, "conversion tiles per item");
struct ConvDst { bf16 *W_out, *W_q, *W_kv, *W_o, *W_gu, *W_dn, *W_in; const float* cmax; const float* cmin; };
__device__ __forceinline__ void convert_tile(const float* const* in_, int layer, int tt, const ConvDst& cd, LAS unsigned* scr, int lane) {
    struct { const float* const* p; __device__ __forceinline__ const float* operator[](int k) const { return (const float*)(GAS const float*)p[k]; } } in{in_};
    const float* W; const float* gk = nullptr; int K, N, row_off = 0, mode = 0, loc; bf16* WT;
    if (tt < CV1)      { W = in[10] + (size_t)layer * D * D;    K = D;   N = D;   WT = cd.W_out; loc = tt; }
    else if (tt < CV2) { W = in[13] + (size_t)layer * D * XW;   K = D;   N = XW;  WT = cd.W_q;  loc = tt - CV1; gk = in[12] + (size_t)layer * D; }
    else if (tt < CV3) { W = in[14] + (size_t)layer * D * XW;   K = D;   N = XW;  WT = cd.W_kv; loc = tt - CV2; }
    else if (tt < CV4) { W = in[15] + (size_t)layer * D * XW;   K = D;   N = XW;  WT = cd.W_kv; loc = tt - CV3; row_off = XW; }
    else if (tt < CV5) { W = in[16] + (size_t)layer * XW * D;   K = XW;  N = D;   WT = cd.W_o;  loc = tt - CV4; }
    else if (tt < CV6) { W = in[19] + (size_t)layer * D * FFH;  K = D;   N = FFH; WT = cd.W_gu; loc = tt - CV5; mode = 1; gk = in[18] + (size_t)layer * D; }
    else if (tt < CV7) { W = in[20] + (size_t)layer * D * FFH;  K = D;   N = FFH; WT = cd.W_gu; loc = tt - CV6; mode = 2; gk = in[18] + (size_t)layer * D; }
    else if (tt < CV8) { W = in[21] + (size_t)layer * FFH * D;  K = FFH; N = D;   WT = cd.W_dn; loc = tt - CV7; }
    else               { W = in[4] + (size_t)(layer + 1) * D * NPROJ; K = D; N = NPROJ; WT = cd.W_in; loc = tt - CV8; gk = in[3] + (size_t)(layer + 1) * D; }
    const int nblk = N / 64, kb = loc / nblk, nb = loc - kb * nblk, n0 = 64 * nb;
    const int drow0 = mode == 0 ? row_off + n0 : ((n0 >> 7) * 256 + (mode == 2 ? 128 : 0) + (n0 & 127));
    if (tt >= CV8) transpose_item64_q(W, K, N, (signed char*)WT, drow0, 64 * kb, n0, scr, lane, gk, cd.cmin + (size_t)(layer + 1) * NPROJ);
    else if (mode != 0) transpose_item64_q(W, K, N, (signed char*)WT, drow0, 64 * kb, n0, scr, lane, gk, cd.cmax + (size_t)layer * 2 * FFH + (mode == 2 ? FFH : 0));
    else transpose_item64(W, K, N, WT, drow0, 64 * kb, n0, scr, lane, gk);
}
__device__ __forceinline__ unsigned conv_next(unsigned* q, unsigned limit, unsigned* stopw, unsigned stopv) {
    if (stopw && __hip_atomic_load(stopw, __ATOMIC_RELAXED, __HIP_MEMORY_SCOPE_AGENT) >= stopv) return 0xffffffffu;
    if (__hip_atomic_load(q, __ATOMIC_RELAXED, __HIP_MEMORY_SCOPE_AGENT) >= limit) return 0xffffffffu;
    return __hip_atomic_fetch_add(q, 1u, __ATOMIC_RELAXED, __HIP_MEMORY_SCOPE_AGENT);
}
__device__ __forceinline__ void conv_pull(Frame& F, const float* const* in, int layer, unsigned* q, int limit, int count, const ConvDst& cd, volatile LAS unsigned* slot, unsigned* stopw, unsigned stopv) {
    LAS unsigned* scr = (LAS unsigned*)(F.lds + F.wave * 16384);
    __syncthreads();
    unsigned nxt = 0xffffffffu;
    if (F.tid == 0) nxt = conv_next(q, (unsigned)limit, stopw, stopv);
    int par = 0;
    for (;;) {
        if (F.tid == 0) slot[par] = nxt;
        __syncthreads();
        const unsigned cur = slot[par]; par ^= 1;
        if (cur >= (unsigned)count) break;
        if (F.tid == 0) {
            if (limit < count) nxt = conv_next(q, (unsigned)limit, stopw, stopv);
            else if (stopw && __hip_atomic_load(stopw, __ATOMIC_RELAXED, __HIP_MEMORY_SCOPE_AGENT) >= stopv) nxt = 0xffffffffu;
            else nxt = __hip_atomic_fetch_add(q, 1u, __ATOMIC_RELAXED, __HIP_MEMORY_SCOPE_AGENT);
        }
        const int t0 = (int)cur * CV_PER_ITEM + F.wave * (CV_PER_ITEM / NWAVES);
#pragma unroll 1
        for (int e = 0; e < CV_PER_ITEM / NWAVES; ++e) convert_tile(in, layer, t0 + e, cd, scr, F.lane);
    }
}

__device__ __forceinline__ void rms_row_to_bf16(const float* xrow, const float* g, bf16* orow, int lane) {
    const f32x4* xr = (const f32x4*)xrow + lane; const f32x4* gr = (const f32x4*)g + lane;
    f32x4 v[16]; float s = 0.f;
#pragma unroll
    for (int j = 0; j < 16; ++j) { v[j] = xr[64 * j]; s += (v[j].x * v[j].x + v[j].y * v[j].y) + (v[j].z * v[j].z + v[j].w * v[j].w); }
    const float r = 1.0f / sqrtf(wave_sum(s) * (1.0f / D) + RMS_EPS);
    u32x2* o8 = (u32x2*)orow + lane;
#pragma unroll
    for (int j = 0; j < 16; ++j) { const f32x4 gg = gr[64 * j]; u32x2 w; w.x = cvt_pk_bf16(v[j].x * r * gg.x, v[j].y * r * gg.y); w.y = cvt_pk_bf16(v[j].z * r * gg.z, v[j].w * r * gg.w); o8[64 * j] = w; }
}
__device__ __forceinline__ void norm_phase(Frame& F, const bf16* tmp, const float* hin32, bf16* hb, float* out32, const float* gpost, float* rs_out) {
    LAS float* gl = (LAS float*)F.lds;
    __syncthreads();
    for (int i = F.tid; i < D / 4; i += NWAVES * 64) ((LAS f32x4*)gl)[i] = ((const f32x4*)gpost)[i];
    __syncthreads();
    for (int row0 = F.gw; row0 < M; row0 += 2 * F.NGW) {
        f32x4 v[2][16]; float s[2] = {0.f, 0.f};
#pragma unroll
        for (int rr = 0; rr < 2; ++rr) { const int row = row0 + rr * F.NGW; const u32x4* tr = (const u32x4*)(tmp + (size_t)row * D) + F.lane;
#pragma unroll
            for (int j = 0; j < 8; ++j) { const u32x4 w = __builtin_nontemporal_load(tr + 64 * j);
                v[rr][2 * j] = (f32x4){bflo(w.x), bfhi(w.x), bflo(w.y), bfhi(w.y)}; v[rr][2 * j + 1] = (f32x4){bflo(w.z), bfhi(w.z), bflo(w.w), bfhi(w.w)}; }
        }
#pragma unroll
        for (int rr = 0; rr < 2; ++rr)
#pragma unroll
            for (int j = 0; j < 16; ++j) s[rr] += (v[rr][j].x * v[rr][j].x + v[rr][j].y * v[rr][j].y) + (v[rr][j].z * v[rr][j].z + v[rr][j].w * v[rr][j].w);
#pragma unroll
        for (int o = 1; o < 64; o <<= 1) { s[0] += __shfl_xor(s[0], o); s[1] += __shfl_xor(s[1], o); }
        float s2[2] = {0.f, 0.f};
#pragma unroll
        for (int rr = 0; rr < 2; ++rr) { const int row = row0 + rr * F.NGW; const float r = 1.0f / sqrtf(s[rr] * (1.0f / D) + RMS_EPS);
            u32x4* hbr = (u32x4*)(hb + (size_t)row * D) + F.lane;
            u32x4 hw[8];
            if (!hin32) {
#pragma unroll
                for (int j = 0; j < 8; ++j) hw[j] = __builtin_nontemporal_load(hbr + 64 * j); }
            asm volatile("" ::: "memory");
#pragma unroll
            for (int j = 0; j < 8; ++j) { const int off = 8 * F.lane + 512 * j;
                f32x4 h0, h1;
                if (hin32) { h0 = *(const f32x4*)(hin32 + (size_t)row * D + off); h1 = *(const f32x4*)(hin32 + (size_t)row * D + off + 4); }
                else { const u32x4 w = hw[j]; h0 = (f32x4){bflo(w.x), bfhi(w.x), bflo(w.y), bfhi(w.y)}; h1 = (f32x4){bflo(w.z), bfhi(w.z), bflo(w.w), bfhi(w.w)}; }
                const f32x4 g0 = *(const LAS f32x4*)(gl + off), g1 = *(const LAS f32x4*)(gl + off + 4);
                h0 = h0 + v[rr][2 * j] * r * g0; h1 = h1 + v[rr][2 * j + 1] * r * g1;
                s2[rr] += (h0.x * h0.x + h0.y * h0.y) + (h0.z * h0.z + h0.w * h0.w) + (h1.x * h1.x + h1.y * h1.y) + (h1.z * h1.z + h1.w * h1.w);
                if (out32) { *(f32x4*)(out32 + (size_t)row * D + off) = h0; *(f32x4*)(out32 + (size_t)row * D + off + 4) = h1; }
                else { u32x4 w; w.x = cvt_pk_bf16(h0.x, h0.y); w.y = cvt_pk_bf16(h0.z, h0.w); w.z = cvt_pk_bf16(h1.x, h1.y); w.w = cvt_pk_bf16(h1.z, h1.w); hbr[64 * j] = w; } } }
        if (rs_out) {
#pragma unroll
            for (int o = 1; o < 64; o <<= 1) { s2[0] += __shfl_xor(s2[0], o); s2[1] += __shfl_xor(s2[1], o); }
            if (F.lane == 0) { rs_out[row0] = 1.0f / sqrtf(s2[0] * (1.0f / D) + RMS_EPS); rs_out[row0 + F.NGW] = 1.0f / sqrtf(s2[1] * (1.0f / D) + RMS_EPS); }
        }
    }
}
__device__ __forceinline__ void norm_phase_q(Frame& F, const bf16* tmp, bf16* hb, const float* gpost, signed char* hq, float* rq, float* rs_out) {
    LAS float* gl = (LAS float*)F.lds;
    __syncthreads();
    for (int i = F.tid; i < D / 4; i += NWAVES * 64) ((LAS f32x4*)gl)[i] = ((const f32x4*)gpost)[i];
    __syncthreads();
    for (int row0 = F.gw; row0 < M; row0 += 2 * F.NGW) {
        f32x4 v[2][16]; float s[2] = {0.f, 0.f};
#pragma unroll
        for (int rr = 0; rr < 2; ++rr) { const int row = row0 + rr * F.NGW; const u32x4* tr = (const u32x4*)(tmp + (size_t)row * D) + F.lane;
#pragma unroll
            for (int j = 0; j < 8; ++j) { const u32x4 w = __builtin_nontemporal_load(tr + 64 * j);
                v[rr][2 * j] = (f32x4){bflo(w.x), bfhi(w.x), bflo(w.y), bfhi(w.y)}; v[rr][2 * j + 1] = (f32x4){bflo(w.z), bfhi(w.z), bflo(w.w), bfhi(w.w)}; }
        }
#pragma unroll
        for (int rr = 0; rr < 2; ++rr)
#pragma unroll
            for (int j = 0; j < 16; ++j) s[rr] += (v[rr][j].x * v[rr][j].x + v[rr][j].y * v[rr][j].y) + (v[rr][j].z * v[rr][j].z + v[rr][j].w * v[rr][j].w);
#pragma unroll
        for (int o = 1; o < 64; o <<= 1) { s[0] += __shfl_xor(s[0], o); s[1] += __shfl_xor(s[1], o); }
        float s2[2] = {0.f, 0.f}, am[2] = {0.f, 0.f};
#pragma unroll
        for (int rr = 0; rr < 2; ++rr) { const int row = row0 + rr * F.NGW; const float r = 1.0f / sqrtf(s[rr] * (1.0f / D) + RMS_EPS);
            u32x4* hbr = (u32x4*)(hb + (size_t)row * D) + F.lane;
            u32x4 hw[8];
#pragma unroll
            for (int j = 0; j < 8; ++j) hw[j] = __builtin_nontemporal_load(hbr + 64 * j);
            asm volatile("" ::: "memory");
#pragma unroll
            for (int j = 0; j < 8; ++j) { const int off = 8 * F.lane + 512 * j;
                const u32x4 w = hw[j]; f32x4 h0 = (f32x4){bflo(w.x), bfhi(w.x), bflo(w.y), bfhi(w.y)}, h1 = (f32x4){bflo(w.z), bfhi(w.z), bflo(w.w), bfhi(w.w)};
                const f32x4 g0 = *(const LAS f32x4*)(gl + off), g1 = *(const LAS f32x4*)(gl + off + 4);
                h0 = h0 + v[rr][2 * j] * r * g0; h1 = h1 + v[rr][2 * j + 1] * r * g1;
                s2[rr] += (h0.x * h0.x + h0.y * h0.y) + (h0.z * h0.z + h0.w * h0.w) + (h1.x * h1.x + h1.y * h1.y) + (h1.z * h1.z + h1.w * h1.w);
                am[rr] = fmaxf(am[rr], fmaxf(fmaxf(fmaxf(fabsf(h0.x), fabsf(h0.y)), fmaxf(fabsf(h0.z), fabsf(h0.w))), fmaxf(fmaxf(fabsf(h1.x), fabsf(h1.y)), fmaxf(fabsf(h1.z), fabsf(h1.w)))));
                v[rr][2 * j] = h0; v[rr][2 * j + 1] = h1;
                u32x4 wo; wo.x = cvt_pk_bf16(h0.x, h0.y); wo.y = cvt_pk_bf16(h0.z, h0.w); wo.z = cvt_pk_bf16(h1.x, h1.y); wo.w = cvt_pk_bf16(h1.z, h1.w); hbr[64 * j] = wo; } }
#pragma unroll
        for (int o = 1; o < 64; o <<= 1) { s2[0] += __shfl_xor(s2[0], o); s2[1] += __shfl_xor(s2[1], o); am[0] = fmaxf(am[0], __shfl_xor(am[0], o)); am[1] = fmaxf(am[1], __shfl_xor(am[1], o)); }
#pragma unroll
        for (int rr = 0; rr < 2; ++rr) { const int row = row0 + rr * F.NGW; const float inv = am[rr] > 0.f ? 127.0f / am[rr] : 0.f;
            u32x2* qo = (u32x2*)(hq + (size_t)row * D) + F.lane;
#pragma unroll
            for (int j = 0; j < 8; ++j) { const f32x4 a = v[rr][2 * j] * inv, bq = v[rr][2 * j + 1] * inv;
                u32x2 w; w.x = q8(a.x) | (q8(a.y) << 8) | (q8(a.z) << 16) | (q8(a.w) << 24); w.y = q8(bq.x) | (q8(bq.y) << 8) | (q8(bq.z) << 16) | (q8(bq.w) << 24); qo[64 * j] = w; }
            if (F.lane == 0) { const float rsn = 1.0f / sqrtf(s2[rr] * (1.0f / D) + RMS_EPS); rq[row] = rsn * am[rr] * (1.0f / 127.0f); if (rs_out) rs_out[row] = rsn; } }
    }
}
__device__ __forceinline__ void x_to_stream(Frame& F, const float* x, bf16* hb, float* rs_out) {
    for (int row = F.gw; row < M; row += F.NGW) {
        float s2 = 0.f;
#pragma unroll
        for (int j = 0; j < 8; ++j) { const int off = 8 * F.lane + 512 * j; const f32x4 h0 = *(const f32x4*)(x + (size_t)row * D + off), h1 = *(const f32x4*)(x + (size_t)row * D + off + 4);
            s2 += (h0.x * h0.x + h0.y * h0.y) + (h0.z * h0.z + h0.w * h0.w) + (h1.x * h1.x + h1.y * h1.y) + (h1.z * h1.z + h1.w * h1.w);
            u32x4 w; w.x = cvt_pk_bf16(h0.x, h0.y); w.y = cvt_pk_bf16(h0.z, h0.w); w.z = cvt_pk_bf16(h1.x, h1.y); w.w = cvt_pk_bf16(h1.z, h1.w); *((u32x4*)(hb + (size_t)row * D + off)) = w; }
        s2 = wave_sum(s2);
        if (F.lane == 0) rs_out[row] = 1.0f / sqrtf(s2 * (1.0f / D) + RMS_EPS);
    }
}

template <int MT, int NT, bool TR>
__device__ __forceinline__ void wave_mma(f32x4 (&acc)[MT][NT], const LAS bf16* A, int lda, const LAS bf16* Bm, int ldb, int K, int lane) {
    const int r = lane & 15, q = lane >> 4;
    for (int k0 = 0; k0 < K; k0 += 32) {
        bf16x8 a[MT], b[NT];
#pragma unroll
        for (int mt = 0; mt < MT; ++mt) a[mt] = *(const LAS bf16x8*)(A + (mt * 16 + r) * lda + k0 + 8 * q);
#pragma unroll
        for (int nt = 0; nt < NT; ++nt) b[nt] = *(const LAS bf16x8*)(Bm + (nt * 16 + r) * ldb + k0 + 8 * q);
#pragma unroll
        for (int mt = 0; mt < MT; ++mt)
#pragma unroll
            for (int nt = 0; nt < NT; ++nt)
                acc[mt][nt] = TR ? __builtin_amdgcn_mfma_f32_16x16x32_bf16(b[nt], a[mt], acc[mt][nt], 0, 0, 0) : __builtin_amdgcn_mfma_f32_16x16x32_bf16(a[mt], b[nt], acc[mt][nt], 0, 0, 0);
    }
}
__device__ __forceinline__ void stage_tile(LAS bf16* dst, int lld, const bf16* src, size_t gld, int rows, int cols, int tid) {
    const int cpr = cols >> 3, total = rows * cpr;
    for (int i = tid; i < total; i += NWAVES * 64) { const int r = i / cpr, c = i - r * cpr; *(LAS u32x4*)(dst + r * lld + c * 8) = *(const u32x4*)(src + (size_t)r * gld + c * 8); }
}
__device__ __forceinline__ void stage_tile_tr(LAS bf16* dst, int lld, const bf16* src, size_t gld, int rows, int cols, int tid) {
    const int cpr = cols >> 3, total = rows * cpr;
    for (int i = tid; i < total; i += NWAVES * 64) { const int c = i / rows, r = i - c * rows; const u32x4 v = *(const u32x4*)(src + (size_t)r * gld + c * 8);
        LAS bf16* d = dst + (c * 8) * lld + r;
        d[0] = (bf16)(v.x & 0xffff); d[lld] = (bf16)(v.x >> 16); d[2 * lld] = (bf16)(v.y & 0xffff); d[3 * lld] = (bf16)(v.y >> 16);
        d[4 * lld] = (bf16)(v.z & 0xffff); d[5 * lld] = (bf16)(v.z >> 16); d[6 * lld] = (bf16)(v.w & 0xffff); d[7 * lld] = (bf16)(v.w >> 16); }
}

struct NoScale { __device__ __forceinline__ float operator()(int) const { return 1.0f; } static constexpr bool ON = false; };
struct Exp2Scale { float a, b; static constexpr bool ON = true; __device__ __forceinline__ float operator()(int r) const { return exp2f(a + b * (float)r); } };
template <class RS>
__device__ __forceinline__ void stage_tile_tr2(LAS bf16* dst, int lld, const bf16* src, size_t gld, int rows, int cols, int tid, const RS& sc) {
    const int hp = rows >> 1, total = hp * (cols >> 3), ls = lld >> 1;
    for (int i = tid; i < total; i += NWAVES * 64) { const int rp = i % hp, c8 = i / hp;
        const u32x4 a = *(const u32x4*)(src + (size_t)(2 * rp) * gld + c8 * 8), b = *(const u32x4*)(src + (size_t)(2 * rp + 1) * gld + c8 * 8);
        LAS unsigned* d = (LAS unsigned*)(dst + (c8 * 8) * lld + 2 * rp);
        if (RS::ON) { const float s0 = sc(2 * rp), s1 = sc(2 * rp + 1);
            d[0 * ls] = cvt_pk_bf16(bflo(a.x) * s0, bflo(b.x) * s1); d[1 * ls] = cvt_pk_bf16(bfhi(a.x) * s0, bfhi(b.x) * s1);
            d[2 * ls] = cvt_pk_bf16(bflo(a.y) * s0, bflo(b.y) * s1); d[3 * ls] = cvt_pk_bf16(bfhi(a.y) * s0, bfhi(b.y) * s1);
            d[4 * ls] = cvt_pk_bf16(bflo(a.z) * s0, bflo(b.z) * s1); d[5 * ls] = cvt_pk_bf16(bfhi(a.z) * s0, bfhi(b.z) * s1);
            d[6 * ls] = cvt_pk_bf16(bflo(a.w) * s0, bflo(b.w) * s1); d[7 * ls] = cvt_pk_bf16(bfhi(a.w) * s0, bfhi(b.w) * s1);
        } else {
            d[0 * ls] = (a.x & 0xffffu) | (b.x << 16); d[1 * ls] = (a.x >> 16) | (b.x & 0xffff0000u);
            d[2 * ls] = (a.y & 0xffffu) | (b.y << 16); d[3 * ls] = (a.y >> 16) | (b.y & 0xffff0000u);
            d[4 * ls] = (a.z & 0xffffu) | (b.z << 16); d[5 * ls] = (a.z >> 16) | (b.z & 0xffff0000u);
            d[6 * ls] = (a.w & 0xffffu) | (b.w << 16); d[7 * ls] = (a.w >> 16) | (b.w & 0xffff0000u);
        } }
}

typedef short s16x4 __attribute__((ext_vector_type(4)));
__device__ __forceinline__ bf16x8 tr_frag(const LAS bf16* base, int pitch, int lane) {
    const int g = lane >> 4, q = (lane >> 2) & 3, p = lane & 3;
    const LAS bf16* a = base + (8 * g + q) * pitch + 4 * p;
    const s16x4 lo = __builtin_amdgcn_ds_read_tr16_b64_v4i16((LAS s16x4*)a);
    const s16x4 hi = __builtin_amdgcn_ds_read_tr16_b64_v4i16((LAS s16x4*)(a + 4 * pitch));
    return __builtin_shufflevector(lo, hi, 0, 1, 2, 3, 4, 5, 6, 7);
}
template <int MT, int NT, bool TR, bool AT, bool BT>
__device__ __forceinline__ void wave_mma_g(f32x4 (&acc)[MT][NT], const LAS bf16* A, int lda, const LAS bf16* Bm, int ldb, int K, int lane) {
    const int r = lane & 15, q = lane >> 4;
    for (int k0 = 0; k0 < K; k0 += 32) {
        bf16x8 a[MT], b[NT];
#pragma unroll
        for (int mt = 0; mt < MT; ++mt) { if (AT) a[mt] = tr_frag(A + k0 * lda + 16 * mt, lda, lane); else a[mt] = *(const LAS bf16x8*)(A + (mt * 16 + r) * lda + k0 + 8 * q); }
#pragma unroll
        for (int nt = 0; nt < NT; ++nt) { if (BT) b[nt] = tr_frag(Bm + k0 * ldb + 16 * nt, ldb, lane); else b[nt] = *(const LAS bf16x8*)(Bm + (nt * 16 + r) * ldb + k0 + 8 * q); }
#pragma unroll
        for (int mt = 0; mt < MT; ++mt)
#pragma unroll
            for (int nt = 0; nt < NT; ++nt)
                acc[mt][nt] = TR ? __builtin_amdgcn_mfma_f32_16x16x32_bf16(b[nt], a[mt], acc[mt][nt], 0, 0, 0) : __builtin_amdgcn_mfma_f32_16x16x32_bf16(a[mt], b[nt], acc[mt][nt], 0, 0, 0);
    }
}
template <int N> struct Pf { u32x4 r[N]; };
template <int N, int CPR> __device__ __forceinline__ void pf_load(Pf<N>& p, const bf16* src, size_t gld, int tid) {
#pragma unroll
    for (int it = 0; it < N; ++it) { const int i = tid + NWAVES * 64 * it; p.r[it] = *(const u32x4*)(src + (size_t)(i / CPR) * gld + (i % CPR) * 8); }
}
template <int N, int CPR> __device__ __forceinline__ void pf_store(LAS bf16* dst, int lld, int tid, const Pf<N>& p) {
#pragma unroll
    for (int it = 0; it < N; ++it) { const int i = tid + NWAVES * 64 * it; *(LAS u32x4*)(dst + (i / CPR) * lld + (i % CPR) * 8) = p.r[it]; }
}
__device__ __forceinline__ u32x4 scale_bf16x8(u32x4 v, float s) {
    u32x4 o; o.x = cvt_pk_bf16(bflo(v.x) * s, bfhi(v.x) * s); o.y = cvt_pk_bf16(bflo(v.y) * s, bfhi(v.y) * s); o.z = cvt_pk_bf16(bflo(v.z) * s, bfhi(v.z) * s); o.w = cvt_pk_bf16(bflo(v.w) * s, bfhi(v.w) * s); return o;
}

struct RsCtx { const bf16* proj; bf16* st; LAS bf16* kt; LAS bf16* vt; int b, h, bh, dir, e0; float l2g, gC; };
__device__ __forceinline__ void rs_load(Pf<8>& pk, Pf<2>& pv, const RsCtx& c, int ci, int tid) {
    const int ch = c.dir ? 31 - ci : ci; const bf16* rowp = c.proj + (size_t)(c.b * SEQ + ch * 128) * NPROJ;
    pf_load<8, 32>(pk, rowp + C_RK + c.h * RD, NPROJ, tid); pf_load<2, 8>(pv, rowp + C_RV + c.h * RD + c.e0, NPROJ, tid);
}
__device__ __forceinline__ void rs_step(Frame& F, f32x4 (&acc)[4][2], Pf<8>& pk, Pf<2>& pv, const RsCtx& c, int ci) {
    const int r = F.lane & 15, q = F.lane >> 4;
    const int ch = c.dir ? 31 - ci : ci;
    bf16* sp = c.st + ((((size_t)(c.bh * 2 + c.dir) * 32 + ch) * 256 + c.e0) * 256) + 32 * F.wave + 4 * q;
#pragma unroll
    for (int mt = 0; mt < 4; ++mt)
#pragma unroll
        for (int nt = 0; nt < 2; ++nt) { u32x2 w; w.x = cvt_pk_bf16(acc[mt][nt][0], acc[mt][nt][1]); w.y = cvt_pk_bf16(acc[mt][nt][2], acc[mt][nt][3]);
            *(u32x2*)(sp + (size_t)(16 * mt + r) * 256 + 16 * nt) = w; }
    __syncthreads();
    pf_store<8, 32>(c.kt, 272, F.tid, pk);
#pragma unroll
    for (int it = 0; it < 2; ++it) { const int i = F.tid + NWAVES * 64 * it, row = i >> 3;
        const float sc = exp2f(c.l2g * (float)(c.dir ? row : 127 - row)); *(LAS u32x4*)(c.vt + row * 80 + (i & 7) * 8) = scale_bf16x8(pv.r[it], sc); }
    __syncthreads();
    if (ci + 2 < 32) rs_load(pk, pv, c, ci + 2, F.tid);
#pragma unroll
    for (int mt = 0; mt < 4; ++mt)
#pragma unroll
        for (int nt = 0; nt < 2; ++nt) acc[mt][nt] = acc[mt][nt] * c.gC;
    wave_mma_g<4, 2, true, true, true>(acc, c.vt, 80, c.kt + 32 * F.wave, 272, 128, F.lane);
}
__device__ __forceinline__ void ret_state_pass(Frame& F, int first, int stride, const bf16* proj, bf16* st) {
    for (int item = first; item < 128; item += stride) {
        RsCtx c; c.proj = proj; c.st = st; c.kt = (LAS bf16*)F.lds; c.vt = c.kt + 128 * 272;
        const int es = item & 3; c.dir = (item >> 2) & 1; c.bh = item >> 3; c.b = c.bh >> 3; c.h = c.bh & 7; c.e0 = es * 64;
        const int hg = c.dir ? (7 - c.h) : c.h; const float gam = 1.0f - exp2f(-5.0f - (float)hg); c.l2g = log2f(gam); c.gC = exp2f(128.0f * c.l2g);
        f32x4 acc[4][2];
#pragma unroll
        for (int mt = 0; mt < 4; ++mt)
#pragma unroll
            for (int nt = 0; nt < 2; ++nt) acc[mt][nt] = (f32x4){0.f, 0.f, 0.f, 0.f};
        Pf<8> pkA, pkB; Pf<2> pvA, pvB;
        rs_load(pkA, pvA, c, 0, F.tid); rs_load(pkB, pvB, c, 1, F.tid);
        for (int ci = 0; ci < 32; ci += 2) { rs_step(F, acc, pkA, pvA, c, ci); rs_step(F, acc, pkB, pvB, c, ci + 1); }
    }
    __syncthreads();
}
struct RoCtx { const bf16* kbase; const bf16* vbase; const bf16* stf; const bf16* stb; };
template <int S> __device__ __forceinline__ void ro_issue(Pf<4>& pa, Pf<2>& pv, const RoCtx& c, int tid) {
    if constexpr (S < 2) pf_load<4, 32>(pa, c.kbase + (size_t)(64 * S) * NPROJ, NPROJ, tid);
    else if constexpr (S < 14) { constexpr int es = (S - 2) / 3, kind = (S - 2) % 3;
        if constexpr (kind == 0) pf_load<4, 32>(pa, c.stf + (size_t)(64 * es) * 256, 256, tid);
        else if constexpr (kind == 1) pf_load<4, 32>(pa, c.stb + (size_t)(64 * es) * 256, 256, tid);
        else pf_load<2, 8>(pv, c.vbase + 64 * es, NPROJ, tid); }
}
template <int S> __device__ __forceinline__ void ro_round(Frame& F, Pf<4>& pa, Pf<2>& pv, const RoCtx& c, LAS bf16* qs, LAS bf16* ps, LAS bf16* bs, f32x4 (&o)[4][1][4], int n, float l2f, float l2b, float qdf, float qdb) {
    const int q = F.lane >> 4;
    __syncthreads();
    if constexpr (S < 2 || (S - 2) % 3 != 2) pf_store<4, 32>(bs, 264, F.tid, pa); else pf_store<2, 8>(bs, 80, F.tid, pv);
    __syncthreads();
    ro_issue<S + 1>(pa, pv, c, F.tid);
    if constexpr (S < 2) {
        f32x4 s[1][4];
#pragma unroll
        for (int nt = 0; nt < 4; ++nt) s[0][nt] = (f32x4){0.f, 0.f, 0.f, 0.f};
        wave_mma<1, 4, true>(s, qs + F.wave * 16 * 264, 264, bs, 264, 256, F.lane);
#pragma unroll
        for (int nt = 0; nt < 4; ++nt) { float p[4];
#pragma unroll
            for (int j = 0; j < 4; ++j) { const int mkey = 64 * S + 16 * nt + 4 * q + j; const int dist = n - mkey;
                const float w = dist >= 0 ? exp2f((float)dist * l2f) : exp2f((float)(-dist) * l2b); p[j] = s[0][nt][j] * w; }
            u32x2 w2; w2.x = cvt_pk_bf16(p[0], p[1]); w2.y = cvt_pk_bf16(p[2], p[3]);
            *(LAS u32x2*)(ps + n * 136 + 64 * S + 16 * nt + 4 * q) = w2; }
    } else { constexpr int es = (S - 2) / 3, kind = (S - 2) % 3;
        if constexpr (kind < 2) {
            f32x4 t[1][4];
#pragma unroll
            for (int nt = 0; nt < 4; ++nt) t[0][nt] = (f32x4){0.f, 0.f, 0.f, 0.f};
            wave_mma<1, 4, true>(t, qs + F.wave * 16 * 264, 264, bs, 264, 256, F.lane);
#pragma unroll
            for (int nt = 0; nt < 4; ++nt) { if constexpr (kind == 0) o[es][0][nt] = t[0][nt] * qdf; else o[es][0][nt] = o[es][0][nt] + t[0][nt] * qdb; }
        } else {
            wave_mma_g<1, 4, true, false, true>(o[es], ps + F.wave * 16 * 136, 136, bs, 80, 128, F.lane);
        }
    }
}
__device__ __forceinline__ void ret_output_pass(Frame& F, int first, int stride, const bf16* proj, const bf16* st, const float* rng, bf16* mixin) {
    LAS bf16* qs = (LAS bf16*)F.lds;
    LAS bf16* ps = qs + 128 * 264;
    LAS bf16* bs = ps + 128 * 136;
    const int r = F.lane & 15, q = F.lane >> 4;
    for (int item = first; item < 512; item += stride) {
        const int ch = item & 31, bh = item >> 5, b = bh >> 3, h = bh & 7;
        const float l2f = log2f(1.0f - exp2f(-5.0f - (float)h)), l2b = log2f(1.0f - exp2f(-5.0f - (float)(7 - h)));
        const size_t row0 = (size_t)b * SEQ + ch * 128;
        const int n = 16 * F.wave + r;
        RoCtx c; c.kbase = proj + row0 * NPROJ + C_RK + h * RD; c.vbase = proj + row0 * NPROJ + C_RV + h * RD;
        c.stf = st + (((size_t)(bh * 2 + 0) * 32 + ch) * 256) * 256; c.stb = st + (((size_t)(bh * 2 + 1) * 32 + ch) * 256) * 256;
        Pf<4> pa; Pf<2> pv;
        ro_issue<0>(pa, pv, c, F.tid);
        __syncthreads();
        stage_tile(qs, 264, proj + row0 * NPROJ + C_RQ + h * RD, NPROJ, 128, 256, F.tid);
        const float qdf = exp2f((float)(n + 1) * l2f), qdb = exp2f((float)(128 - n) * l2b);
        f32x4 o[4][1][4];
        ro_round<0>(F, pa, pv, c, qs, ps, bs, o, n, l2f, l2b, qdf, qdb); ro_round<1>(F, pa, pv, c, qs, ps, bs, o, n, l2f, l2b, qdf, qdb);
        ro_round<2>(F, pa, pv, c, qs, ps, bs, o, n, l2f, l2b, qdf, qdb); ro_round<3>(F, pa, pv, c, qs, ps, bs, o, n, l2f, l2b, qdf, qdb); ro_round<4>(F, pa, pv, c, qs, ps, bs, o, n, l2f, l2b, qdf, qdb);
        ro_round<5>(F, pa, pv, c, qs, ps, bs, o, n, l2f, l2b, qdf, qdb); ro_round<6>(F, pa, pv, c, qs, ps, bs, o, n, l2f, l2b, qdf, qdb); ro_round<7>(F, pa, pv, c, qs, ps, bs, o, n, l2f, l2b, qdf, qdb);
        ro_round<8>(F, pa, pv, c, qs, ps, bs, o, n, l2f, l2b, qdf, qdb); ro_round<9>(F, pa, pv, c, qs, ps, bs, o, n, l2f, l2b, qdf, qdb); ro_round<10>(F, pa, pv, c, qs, ps, bs, o, n, l2f, l2b, qdf, qdb);
        ro_round<11>(F, pa, pv, c, qs, ps, bs, o, n, l2f, l2b, qdf, qdb); ro_round<12>(F, pa, pv, c, qs, ps, bs, o, n, l2f, l2b, qdf, qdb); ro_round<13>(F, pa, pv, c, qs, ps, bs, o, n, l2f, l2b, qdf, qdb);
        float sm = 0.f;
#pragma unroll
        for (int es = 0; es < 4; ++es)
#pragma unroll
            for (int nt = 0; nt < 4; ++nt) sm += (o[es][0][nt][0] + o[es][0][nt][1]) + (o[es][0][nt][2] + o[es][0][nt][3]);
        sm += __shfl_xor(sm, 16); sm += __shfl_xor(sm, 32);
        const float mu = sm * (1.0f / RD); float sv = 0.f;
#pragma unroll
        for (int es = 0; es < 4; ++es)
#pragma unroll
            for (int nt = 0; nt < 4; ++nt) { const f32x4 dvv = o[es][0][nt] - mu; o[es][0][nt] = dvv; sv += (dvv[0] * dvv[0] + dvv[1] * dvv[1]) + (dvv[2] * dvv[2] + dvv[3] * dvv[3]); }
        sv += __shfl_xor(sv, 16); sv += __shfl_xor(sv, 32);
        const float rs = 1.0f / sqrtf(sv * (1.0f / RD) + GN_EPS);
        const bf16* gp = proj + (row0 + n) * NPROJ + C_RG + h * RD + 4 * q; bf16* op = mixin + (row0 + n) * D + h * RD + 4 * q; const float* gg = rng + h * RD + 4 * q;
#pragma unroll
        for (int es = 0; es < 4; ++es)
#pragma unroll
            for (int nt = 0; nt < 4; ++nt) { const int e = 64 * es + 16 * nt; const u32x2 gt = *(const u32x2*)(gp + e); const f32x4 g4 = *(const f32x4*)(gg + e);
                const f32x4 v = o[es][0][nt] * rs * g4;
                u32x2 w; w.x = cvt_pk_bf16(v[0] * silu_f(bflo(gt.x)), v[1] * silu_f(bfhi(gt.x))); w.y = cvt_pk_bf16(v[2] * silu_f(bflo(gt.y)), v[3] * silu_f(bfhi(gt.y)));
                *(u32x2*)(op + e) = w; }
    }
    __syncthreads();
}

__device__ __forceinline__ float hgrn_lb(const float* lblog, int layer, int dir, int col) {
    if (layer == 0) return 0.f;
    float mx = -1e30f;
    for (int l = 0; l < NL; ++l) mx = fmaxf(mx, lblog[(l * 2 + dir) * HW + col]);
    float den = 0.f, num = 0.f;
    for (int l = 0; l < NL; ++l) { const float ev = __expf(lblog[(l * 2 + dir) * HW + col] - mx); den += ev; if (l >= 1 && l <= layer) num += ev; }
    return num / den;
}
constexpr int HSB = 4;
struct HsCtx { const bf16* proj; const float* gatez; bf16* hst; LAS bf16* kpt; LAS bf16* vt; LAS float* tot; LAS float* adec; int b, h, bh, dir, d0, d, sg; float lb; };
__device__ __forceinline__ void hs_load(float (&zr)[HSB][4], Pf<2> (&pv)[HSB], const HsCtx& c, int cg, int tid) {
#pragma unroll
    for (int cb = 0; cb < HSB; ++cb) { const int ci = cg * HSB + cb, ch = c.dir ? 63 - ci : ci; const size_t row0 = (size_t)c.b * SEQ + ch * 64;
        const bf16* zp = c.proj + (row0 + 4 * c.sg) * NPROJ + C_HFF + c.dir * HW + c.h * HD + c.d0 + c.d;
#pragma unroll
        for (int ii = 0; ii < 4; ++ii) zr[cb][ii] = bf2f(zp[(size_t)ii * NPROJ]);
        pf_load<2, 16>(pv[cb], c.proj + row0 * NPROJ + C_HI + c.h * HD, NPROJ, tid); }
}
__device__ __forceinline__ void hs_step(Frame& F, f32x4 (&acc)[1][2], float (&zr)[HSB][4], Pf<2> (&pv)[HSB], const HsCtx& c, int cg) {
    const int r = F.lane & 15, q = F.lane >> 4, d = c.d, sg = c.sg, dir = c.dir;
    float lf[HSB][4], kk[HSB][4], mytot[HSB];
#pragma unroll
    for (int cb = 0; cb < HSB; ++cb) {
#pragma unroll
        for (int ii = 0; ii < 4; ++ii) { const float f = c.lb + (1.0f - c.lb) * fast_sigmoid(zr[cb][ii]); lf[cb][ii] = __logf(f); kk[cb][ii] = 1.0f - f; }
        if (dir == 0) { lf[cb][1] += lf[cb][0]; lf[cb][2] += lf[cb][1]; lf[cb][3] += lf[cb][2]; } else { lf[cb][2] += lf[cb][3]; lf[cb][1] += lf[cb][2]; lf[cb][0] += lf[cb][1]; }
        mytot[cb] = dir == 0 ? lf[cb][3] : lf[cb][0]; }
    __syncthreads();
#pragma unroll
    for (int cb = 0; cb < HSB; ++cb) { c.tot[cb * 512 + sg * 32 + d] = mytot[cb]; pf_store<2, 16>(c.vt + cb * 64 * 144, 144, F.tid, pv[cb]); }
    __syncthreads();
    if (cg + 2 < 64 / HSB) hs_load(zr, pv, c, cg + 2, F.tid);
#pragma unroll
    for (int cb = 0; cb < HSB; ++cb) {
        float other = 0.f, all = 0.f;
#pragma unroll
        for (int g = 0; g < 16; ++g) { const float tv = c.tot[cb * 512 + g * 32 + d]; all += tv; if (dir == 0 ? (g < sg) : (g > sg)) other += tv; }
        float kv[4];
#pragma unroll
        for (int ii = 0; ii < 4; ++ii) kv[ii] = kk[cb][ii] * __expf(all - (lf[cb][ii] + other));
        { u32x2 w; w.x = cvt_pk_bf16(kv[0], kv[1]); w.y = cvt_pk_bf16(kv[2], kv[3]); *(LAS u32x2*)(c.kpt + cb * 32 * 72 + d * 72 + 4 * sg) = w; }
        if (sg == 0) c.adec[cb * 32 + d] = __expf(all); }
    __syncthreads();
#pragma unroll
    for (int cb = 0; cb < HSB; ++cb) { const int ci = cg * HSB + cb, ch = dir ? 63 - ci : ci;
#pragma unroll
        for (int nt = 0; nt < 2; ++nt) { u32x2 w; w.x = cvt_pk_bf16(acc[0][nt][0], acc[0][nt][1]); w.y = cvt_pk_bf16(acc[0][nt][2], acc[0][nt][3]);
            *(u32x2*)(c.hst + ((((size_t)(c.bh * 2 + dir) * 64 + ch) * 128 + 16 * F.wave + r) * 128) + c.d0 + 16 * nt + 4 * q) = w; }
#pragma unroll
        for (int nt = 0; nt < 2; ++nt) { const f32x4 a4 = *(const LAS f32x4*)(c.adec + cb * 32 + 16 * nt + 4 * q); acc[0][nt] = acc[0][nt] * a4; }
        wave_mma_g<1, 2, true, true, false>(acc, c.vt + cb * 64 * 144 + 16 * F.wave, 144, c.kpt + cb * 32 * 72, 72, 64, F.lane); }
}
__device__ __forceinline__ void hgrn_state_pass(Frame& F, int first, int stride, const bf16* proj, const float* gatez, const float* lblog, int layer, bf16* hst) {
    for (int item = first; item < 128; item += stride) {
        HsCtx c; c.proj = proj; c.gatez = gatez; c.hst = hst;
        c.kpt = (LAS bf16*)F.lds; c.vt = c.kpt + HSB * 32 * 72; c.tot = (LAS float*)(c.vt + HSB * 64 * 144); c.adec = c.tot + HSB * 512;
        const int ds = item & 3; c.dir = (item >> 2) & 1; c.bh = item >> 3; c.b = c.bh >> 3; c.h = c.bh & 7; c.d0 = ds * 32; c.d = F.tid & 31; c.sg = F.tid >> 5;
        c.lb = hgrn_lb(lblog, layer, c.dir, c.h * HD + c.d0 + c.d);
        f32x4 acc[1][2]; acc[0][0] = (f32x4){0.f, 0.f, 0.f, 0.f}; acc[0][1] = (f32x4){0.f, 0.f, 0.f, 0.f};
        float zA[HSB][4], zB[HSB][4]; Pf<2> pvA[HSB], pvB[HSB];
        hs_load(zA, pvA, c, 0, F.tid); hs_load(zB, pvB, c, 1, F.tid);
        for (int cg = 0; cg < 64 / HSB; cg += 2) { hs_step(F, acc, zA, pvA, c, cg); hs_step(F, acc, zB, pvB, c, cg + 1); }
    }
    __syncthreads();
}
__device__ __forceinline__ void hgrn_output_pass(Frame& F, int first, int stride, int last, const bf16* proj, const float* gatez, const float* lblog, int layer, const bf16* hst, const float* hng, bf16* mixin) {
    LAS bf16* qd = (LAS bf16*)F.lds;
    LAS bf16* kd = qd + 64 * 136;
    LAS bf16* qx = kd + 64 * 136;
    LAS bf16* ps = qx + 64 * 136;
    LAS bf16* vt = ps + 64 * 72;
    LAS bf16* sT = vt + 64 * 144;
    LAS float* tot = (LAS float*)(sT + 128 * 136);
    LAS float* rsq = tot + 512;
    const int r = F.lane & 15, q = F.lane >> 4, rg = F.wave & 3, eh = F.wave >> 2;
    const int d = F.tid & 127, sq = F.tid >> 7;
    const int nitems = first < last ? (last - first + stride - 1) / stride : 0, nunits = 2 * nitems;
    if (nunits == 0) return;
    float zr[16]; unsigned short qr[16]; Pf<4> pst; Pf<2> pvv;
#define HO_ISSUE(u_) do { const int it_ = first + ((u_) >> 1) * stride, dr_ = (u_) & 1; const int ch_ = it_ & 63, bh_ = it_ >> 6, b_ = bh_ >> 3, h_ = bh_ & 7; const size_t r0_ = (size_t)b_ * SEQ + ch_ * 64; \
        const bf16* zp_ = proj + (r0_ + 16 * sq) * NPROJ + C_HFF + dr_ * HW + h_ * HD + d; const bf16* qp_ = proj + (r0_ + 16 * sq) * NPROJ + C_HQ + h_ * HD + d; \
        _Pragma("unroll") for (int ii = 0; ii < 16; ++ii) { zr[ii] = bf2f(zp_[(size_t)ii * NPROJ]); qr[ii] = qp_[(size_t)ii * NPROJ]; } \
        pf_load<4, 16>(pst, hst + (((size_t)(bh_ * 2 + dr_) * 64 + ch_) * 128) * 128, 128, F.tid); \
        if (dr_ == 0) pf_load<2, 16>(pvv, proj + r0_ * NPROJ + C_HI + h_ * HD, NPROJ, F.tid); } while (0)
    HO_ISSUE(0);
    f32x4 o[1][4];
    for (int u = 0; u < nunits; ++u) {
        const int item = first + (u >> 1) * stride, dir = u & 1;
        const int ch = item & 63, bh = item >> 6, b = bh >> 3, h = bh & 7; const size_t row0 = (size_t)b * SEQ + ch * 64;
        if (dir == 0) {
#pragma unroll
            for (int nt = 0; nt < 4; ++nt) o[0][nt] = (f32x4){0.f, 0.f, 0.f, 0.f};
        }
        const float lb = hgrn_lb(lblog, layer, dir, h * HD + d);
        float lf[16], kk[16], qv[16];
#pragma unroll
        for (int ii = 0; ii < 16; ++ii) { const float f = lb + (1.0f - lb) * fast_sigmoid(zr[ii]); lf[ii] = __logf(f); kk[ii] = 1.0f - f; qv[ii] = bf2f(qr[ii]) * 0.08838834764831845f; }
        if (dir == 0) {
#pragma unroll
            for (int ii = 1; ii < 16; ++ii) lf[ii] += lf[ii - 1];
        } else {
#pragma unroll
            for (int ii = 14; ii >= 0; --ii) lf[ii] += lf[ii + 1];
        }
        const float mytot = dir == 0 ? lf[15] : lf[0];
        __syncthreads();
        tot[sq * 128 + d] = mytot;
        if (dir == 0) pf_store<2, 16>(vt, 144, F.tid, pvv);
        pf_store<4, 16>(sT, 136, F.tid, pst);
        __syncthreads();
        if (u + 1 < nunits) HO_ISSUE(u + 1);
        const float t0 = tot[d], t1 = tot[128 + d], t2 = tot[256 + d], t3 = tot[384 + d];
        float other, R;
        if (dir == 0) { other = sq == 0 ? 0.f : (sq == 1 ? t0 : (sq == 2 ? t0 + t1 : t0 + t1 + t2)); R = t0 + t1; }
        else { other = sq == 3 ? 0.f : (sq == 2 ? t3 : (sq == 1 ? t3 + t2 : t3 + t2 + t1)); R = t3 + t2; }
#pragma unroll
        for (int ii = 0; ii < 16; ++ii) { const float cum = lf[ii] + other; const int t = 16 * sq + ii;
            const float ea = __expf(cum - R), eb = __expf(R - cum), ec = __expf(cum);
            qd[t * 136 + d] = (bf16)(cvt_pk_bf16(qv[ii] * ea, 0.f) & 0xffffu); kd[t * 136 + d] = (bf16)(cvt_pk_bf16(kk[ii] * eb, 0.f) & 0xffffu); qx[t * 136 + d] = (bf16)(cvt_pk_bf16(qv[ii] * ec, 0.f) & 0xffffu); }
        __syncthreads();
        { f32x4 s[1][2]; s[0][0] = (f32x4){0.f, 0.f, 0.f, 0.f}; s[0][1] = (f32x4){0.f, 0.f, 0.f, 0.f};
          wave_mma<1, 2, true>(s, qd + rg * 16 * 136, 136, kd + eh * 32 * 136, 136, 128, F.lane);
          const int t = 16 * rg + r;
#pragma unroll
          for (int nt = 0; nt < 2; ++nt) { float p[4];
#pragma unroll
              for (int j = 0; j < 4; ++j) { const int sk = 32 * eh + 16 * nt + 4 * q + j; const bool keep = dir == 0 ? (sk <= t) : (sk >= t); p[j] = keep ? s[0][nt][j] : 0.f; }
              u32x2 w; w.x = cvt_pk_bf16(p[0], p[1]); w.y = cvt_pk_bf16(p[2], p[3]);
              *(LAS u32x2*)(ps + t * 72 + 32 * eh + 16 * nt + 4 * q) = w; } }
        __syncthreads();
        wave_mma_g<1, 4, true, false, true>(o, ps + rg * 16 * 72, 72, vt + eh * 64, 144, 64, F.lane);
        wave_mma<1, 4, true>(o, qx + rg * 16 * 136, 136, sT + eh * 64 * 136, 136, 128, F.lane);
        if (dir == 1) {
            float ss = 0.f;
#pragma unroll
            for (int nt = 0; nt < 4; ++nt) ss += (o[0][nt][0] * o[0][nt][0] + o[0][nt][1] * o[0][nt][1]) + (o[0][nt][2] * o[0][nt][2] + o[0][nt][3] * o[0][nt][3]);
            ss += __shfl_xor(ss, 16); ss += __shfl_xor(ss, 32);
            const int t = 16 * rg + r;
            if (q == 0) rsq[t * 2 + eh] = ss;
            __syncthreads();
            const float rs = 1.0f / sqrtf((rsq[t * 2] + rsq[t * 2 + 1]) * (1.0f / HD) + RMS_EPS);
            const bf16* gp = proj + (row0 + t) * NPROJ + C_HG + h * HD + 64 * eh + 4 * q; bf16* op = mixin + (row0 + t) * D + RW + h * HD + 64 * eh + 4 * q; const float* gg = hng + h * HD + 64 * eh + 4 * q;
#pragma unroll
            for (int nt = 0; nt < 4; ++nt) { const u32x2 gt = *(const u32x2*)(gp + 16 * nt); const f32x4 g4 = *(const f32x4*)(gg + 16 * nt); const f32x4 v = o[0][nt] * rs * g4;
                u32x2 w; w.x = cvt_pk_bf16(v[0] * silu_f(bflo(gt.x)), v[1] * silu_f(bfhi(gt.x))); w.y = cvt_pk_bf16(v[2] * silu_f(bflo(gt.y)), v[3] * silu_f(bfhi(gt.y)));
                *(u32x2*)(op + 16 * nt) = w; }
        }
    }
#undef HO_ISSUE
    __syncthreads();
}

__device__ __forceinline__ void fourier_ut2(Frame& F, int bid, const bf16* proj, const bf16* fwt, bf16* ut2, float* nyq) {
    LAS bf16* zc = (LAS bf16*)F.lds;
    LAS bf16* zs = zc + 128 * 136;
    LAS bf16* ws = zs + 128 * 136;
    const int g = bid & 7, nb = (bid >> 3) & 15, b = bid >> 7;
    const bf16* zb = proj + (size_t)(b * SEQ) * NPROJ + C_FZ + g * FD;
    u32x4 ra[4], rb[4];
#pragma unroll
    for (int it = 0; it < 4; ++it) { const int i = F.tid + NWAVES * 64 * it, row = i >> 4, ch = i & 15, n = nb * 128 + row; const int mrow = (SEQ - n) & (SEQ - 1);
        ra[it] = *(const u32x4*)(zb + (size_t)n * NPROJ + ch * 8); rb[it] = *(const u32x4*)(zb + (size_t)mrow * NPROJ + ch * 8); }
    __syncthreads();
    stage_tile(ws, 136, fwt + (size_t)g * 256 * 128, 128, 256, 128, F.tid);
#pragma unroll
    for (int it = 0; it < 4; ++it) { const int i = F.tid + NWAVES * 64 * it, row = i >> 4, ch = i & 15, n = nb * 128 + row; const float k0 = n == 0 ? 0.f : 1.f;
        const u32x4 a = ra[it], m = rb[it]; u32x4 sc, sd;
        sc.x = cvt_pk_bf16(bflo(a.x) + k0 * bflo(m.x), bfhi(a.x) + k0 * bfhi(m.x)); sd.x = cvt_pk_bf16(k0 * (bflo(a.x) - bflo(m.x)), k0 * (bfhi(a.x) - bfhi(m.x)));
        sc.y = cvt_pk_bf16(bflo(a.y) + k0 * bflo(m.y), bfhi(a.y) + k0 * bfhi(m.y)); sd.y = cvt_pk_bf16(k0 * (bflo(a.y) - bflo(m.y)), k0 * (bfhi(a.y) - bfhi(m.y)));
        sc.z = cvt_pk_bf16(bflo(a.z) + k0 * bflo(m.z), bfhi(a.z) + k0 * bfhi(m.z)); sd.z = cvt_pk_bf16(k0 * (bflo(a.z) - bflo(m.z)), k0 * (bfhi(a.z) - bfhi(m.z)));
        sc.w = cvt_pk_bf16(bflo(a.w) + k0 * bflo(m.w), bfhi(a.w) + k0 * bfhi(m.w)); sd.w = cvt_pk_bf16(k0 * (bflo(a.w) - bflo(m.w)), k0 * (bfhi(a.w) - bfhi(m.w)));
        *(LAS u32x4*)(zc + row * 136 + ch * 8) = sc; *(LAS u32x4*)(zs + row * 136 + ch * 8) = sd; }
    __syncthreads();
    const int r = F.lane & 15, q = F.lane >> 4; const int n = nb * 128 + F.wave * 16 + 4 * q;
#pragma unroll
    for (int part = 0; part < 2; ++part) {
        f32x4 acc[1][8];
#pragma unroll
        for (int nt = 0; nt < 8; ++nt) acc[0][nt] = (f32x4){0.f, 0.f, 0.f, 0.f};
        wave_mma<1, 8, false>(acc, (part ? zs : zc) + F.wave * 16 * 136, 136, ws + part * 128 * 136, 136, 128, F.lane);
#pragma unroll
        for (int nt = 0; nt < 8; ++nt) { const int d = nt * 16 + r;
            u32x2 w; w.x = cvt_pk_bf16(acc[0][nt][0], acc[0][nt][1]); w.y = cvt_pk_bf16(acc[0][nt][2], acc[0][nt][3]);
            *(u32x2*)(ut2 + (size_t)(part * 2048 + b * FW + g * FD + d) * 2048 + n) = w; }
    }
    if (nb == 0 && F.tid < 128) {
        const int d = F.tid; const bf16* zr = zb + (size_t)2048 * NPROJ; float acc = 0.f;
        for (int c8 = 0; c8 < 16; ++c8) { const u32x4 zv = *(const u32x4*)(zr + c8 * 8); const u32x4 wv = *(const LAS u32x4*)(ws + d * 136 + c8 * 8);
            acc += bflo(zv.x) * bflo(wv.x) + bfhi(zv.x) * bfhi(wv.x) + bflo(zv.y) * bflo(wv.y) + bfhi(zv.y) * bfhi(wv.y) + bflo(zv.z) * bflo(wv.z) + bfhi(zv.z) * bfhi(wv.z) + bflo(zv.w) * bflo(wv.w) + bfhi(zv.w) * bfhi(wv.w); }
        nyq[b * FW + g * FD + d] = acc;
    }
    __syncthreads();
}
__device__ __forceinline__ void fourier_mid_row(Frame& F, int first_wave, int nwaves, const bf16* ut2, const float* nyq, const float* bias, bf16* mixin) {
    for (int c = first_wave; c < NB * FW; c += nwaves) {
        const u32x4* rowp = (const u32x4*)(ut2 + (size_t)c * 2048) + F.lane; float sacc = 0.f;
#pragma unroll
        for (int j = 0; j < 4; ++j) { const u32x4 v = rowp[64 * j]; sacc += (bflo(v.x) - bfhi(v.x)) + (bflo(v.y) - bfhi(v.y)) + (bflo(v.z) - bfhi(v.z)) + (bflo(v.w) - bfhi(v.w)); }
        sacc = wave_sum(sacc);
        if (F.lane == 0) { const int b = c >> 10, colm = c & 1023; const float y = sacc + nyq[c] + bias[colm];
            mixin[(size_t)(b * SEQ + 2048) * D + 3072 + colm] = (bf16)(cvt_pk_bf16(y, 0.f) & 0xffffu); }
    }
}

__device__ __forceinline__ void xattn_phase(Frame& F, const bf16* xq, const bf16* kvmem, bf16* xo) {
    LAS bf16* ra = (LAS bf16*)F.lds;
    LAS bf16* rb = ra + 128 * 264;
    for (int item = F.vcu; item < NB * XH * 32; item += F.G) {
        const int qb = item & 31, hd = (item >> 5) & 3, b = item >> 7;
        __syncthreads();
        stage_tile(ra, 264, xq + (size_t)(b * SEQ + qb * 128) * XW + hd * XD, XW, 128, 256, F.tid);
        f32x4 s[2][8];
#pragma unroll
        for (int hf = 0; hf < 2; ++hf) {
            if (hf) __syncthreads();
            stage_tile(rb, 264, kvmem + (size_t)(b * MEMT + hf * 128) * 2048 + hd * XD, 2048, 128, 256, F.tid);
            __syncthreads();
            f32x4 acc[1][8];
#pragma unroll
            for (int nt = 0; nt < 8; ++nt) acc[0][nt] = (f32x4){0.f, 0.f, 0.f, 0.f};
            wave_mma<1, 8, true>(acc, ra + F.wave * 16 * 264, 264, rb, 264, 256, F.lane);
#pragma unroll
            for (int nt = 0; nt < 8; ++nt) s[hf][nt] = acc[0][nt];
        }
        float mx = -1e30f;
#pragma unroll
        for (int hf = 0; hf < 2; ++hf)
#pragma unroll
            for (int nt = 0; nt < 8; ++nt)
#pragma unroll
                for (int j = 0; j < 4; ++j) mx = fmaxf(mx, s[hf][nt][j]);
        mx = fmaxf(mx, __shfl_xor(mx, 16)); mx = fmaxf(mx, __shfl_xor(mx, 32));
        float sum = 0.f;
#pragma unroll
        for (int hf = 0; hf < 2; ++hf)
#pragma unroll
            for (int nt = 0; nt < 8; ++nt)
#pragma unroll
                for (int j = 0; j < 4; ++j) { const float p = __expf(s[hf][nt][j] - mx); s[hf][nt][j] = p; sum += p; }
        sum += __shfl_xor(sum, 16); sum += __shfl_xor(sum, 32);
        const float inv = 1.0f / sum;
        __syncthreads();
        { const int r = F.lane & 15, q = F.lane >> 4; LAS bf16* prow = ra + (F.wave * 16 + r) * 264;
#pragma unroll
          for (int hf = 0; hf < 2; ++hf)
#pragma unroll
              for (int nt = 0; nt < 8; ++nt) { u32x2 w; w.x = cvt_pk_bf16(s[hf][nt][0], s[hf][nt][1]); w.y = cvt_pk_bf16(s[hf][nt][2], s[hf][nt][3]);
                  *(LAS u32x2*)(prow + hf * 128 + nt * 16 + 4 * q) = w; } }
        f32x4 o[1][16];
#pragma unroll
        for (int nt = 0; nt < 16; ++nt) o[0][nt] = (f32x4){0.f, 0.f, 0.f, 0.f};
#pragma unroll
        for (int hf = 0; hf < 2; ++hf) {
            if (hf) __syncthreads();
            stage_tile(rb, 272, kvmem + (size_t)(b * MEMT + hf * 128) * 2048 + 1024 + hd * XD, 2048, 128, 256, F.tid);
            __syncthreads();
            wave_mma_g<1, 16, true, false, true>(o, ra + F.wave * 16 * 264 + hf * 128, 264, rb, 272, 128, F.lane);
        }
        { const int r = F.lane & 15, q = F.lane >> 4; bf16* orow = xo + (size_t)(b * SEQ + qb * 128 + F.wave * 16 + r) * XW + hd * XD + 4 * q;
#pragma unroll
          for (int nt = 0; nt < 16; ++nt) { u32x2 w; w.x = cvt_pk_bf16(o[0][nt][0] * inv, o[0][nt][1] * inv); w.y = cvt_pk_bf16(o[0][nt][2] * inv, o[0][nt][3] * inv); *(u32x2*)(orow + nt * 16) = w; } }
    }
    __syncthreads();
}

#define AIN(k) ((const float*)(GAS const float*)args.in[k])
#define x_in (AIN(0))
#define mem (AIN(1))
#define mem_g (AIN(2))
#define W_in ((bf16*)(wsp + WS_WIN))
#define W_out ((bf16*)(wsp + WS_WOUT))
#define W_q ((bf16*)(wsp + WS_WQ))
#define W_kv ((bf16*)(wsp + WS_WKV))
#define W_o ((bf16*)(wsp + WS_WO))
#define W_gu ((bf16*)(wsp + WS_WGU))
#define W_dn ((bf16*)(wsp + WS_WDN))
#define anorm ((bf16*)(wsp + WS_ANORM))
#define proj ((bf16*)(wsp + WS_PROJ))
#define hid ((bf16*)(wsp + WS_PROJ))
#define gatez ((float*)(wsp + WS_GATEZ))
#define mixin ((bf16*)(wsp + WS_MIXIN))
#define tmpb ((bf16*)(wsp + WS_TMP))
#define rst ((bf16*)(wsp + WS_SCR))
#define hst ((bf16*)(wsp + WS_SCR + 128 * MiB))
#define dft ((bf16*)(wsp + WS_DFT))
#define ut ((bf16*)(wsp + WS_UT))
#define xq ((bf16*)(wsp + WS_XQ))
#define xo ((bf16*)(wsp + WS_XO))
#define kvmem ((bf16*)(wsp + WS_KVMEM))
#define memn ((bf16*)(wsp + WS_MEMN))
#define ropec ((float*)(wsp + WS_ROPE))
#define ropes ((float*)(wsp + WS_ROPE) + SEQ * 128)
#define fwt ((bf16*)(wsp + (layer == 0 ? WS_FWT : WS_FWT1)))
#define nyq ((float*)(wsp + WS_FWT + 640 * 1024))
#define rsv ((float*)(wsp + WS_FWT + 768 * 1024))
#define rqv ((float*)(wsp + WS_FWT + 832 * 1024))
#define hq ((signed char*)(wsp + WS_GATEZ))
#define cmaxf ((float*)(wsp + WS_CTL + 256 * 1024))
#define cminf ((float*)(wsp + WS_CTL + 448 * 1024))
#define hout ((float*)(GAS float*)args.out)
#define cq ((unsigned*)(wsp + WS_CTL) + CW_CONVQ)
#define cd (ConvDst{W_out, W_q, W_kv, W_o, W_gu, W_dn, W_in, cmaxf, cminf})
__global__ void __launch_bounds__(NWAVES * 64, 2) fwd_kernel(Args args) {
    extern __shared__ __attribute__((aligned(16))) unsigned char lds[];
    Frame F;
    F.lds = (LAS unsigned char*)lds;
    F.tid = threadIdx.x; F.lane = F.tid & 63; F.wave = __builtin_amdgcn_readfirstlane(F.tid >> 6);
    F.bid = blockIdx.x; F.G = gridDim.x; { const int bx = blockIdx.x; F.vcu = (F.G % 8 == 0) ? (bx % 8) * (F.G / 8) + bx / 8 : bx; }
    F.gw = F.vcu * NWAVES + F.wave; F.NGW = F.G * NWAVES;
    unsigned char* ws = (unsigned char*)(GAS unsigned char*)args.ws; F.ws = ws;
    volatile LAS unsigned* MISC = (volatile LAS unsigned*)(F.lds + MISC_OFF);
    for (int u = F.tid; u < (LDS_BYTES - LDSCTL_OFF) / 4; u += NWAVES * 64) ((LAS unsigned*)(F.lds + LDSCTL_OFF))[u] = 0u;
    __syncthreads();
    XcdBarrier bar; bar.bar = (unsigned*)(ws + WS_CTL) + CW_BAR; bar.x = 0; bar.st = nullptr;
    if (args.single) bar = xcd_barrier_post((unsigned*)(ws + WS_CTL) + CW_BAR, MISC + 8);
#define GRID_BAR() do { if (args.single) xcd_barrier(bar); } while (0)
#define RELAUNDER() do { { int b_ = blockIdx.x; asm volatile("" : "+s"(b_)); F.bid = b_; } wsp = (GAS unsigned char*)args.ws; asm volatile("" : "+s"(wsp)); int t_ = threadIdx.x; asm volatile("" : "+v"(t_)); F.tid = t_; F.lane = t_ & 63; F.wave = __builtin_amdgcn_readfirstlane(t_ >> 6); F.gw = F.vcu * NWAVES + F.wave; } while (0)

    GAS unsigned char* wsp = (GAS unsigned char*)args.ws;
    const int lo = args.ph_lo, hi = args.ph_hi;
#ifndef PHASE_MASK
#define PHASE_MASK 0xffffffffu
#endif
#define IN(k) (((PHASE_MASK >> (k)) & 1u) && lo <= (k) && (k) < hi)

    for (int layer = args.layer_lo; layer < args.layer_hi; ++layer) {
        const int cv_total = layer + 1 < NL ? CV_ITEMS_ALL : CV_ITEMS;
        if (IN(PH_PRE) && layer == 0) {
            RELAUNDER();
            const int gt = F.vcu * (NWAVES * 64) + F.tid, NT = F.G * NWAVES * 64;
            for (int i = gt; i < SEQ * 128; i += NT) { const int pos = i >> 7, j = i & 127;
                const float inv = exp2f(-(float)j * (13.287712379549449f / 128.0f)); const float ang = (float)pos * inv;
                const double rev = (double)ang * 0.15915494309189535; const float fr = (float)(rev - __builtin_rint(rev));
                ropec[i] = __builtin_amdgcn_cosf(fr); ropes[i] = __builtin_amdgcn_sinf(fr); }
            for (int i = gt; i < SEQ * 2048 / 8; i += NT) { const int k = i >> 8, c8 = (i & 255) * 8; const int sn = k >> 11, kk = k & 2047;
                float v[8];
#pragma unroll
                for (int j = 0; j < 8; ++j) { const int mm = (kk * (c8 + j)) & 4095; const float fr = (float)mm * (1.0f / 4096.0f); v[j] = sn ? __builtin_amdgcn_sinf(fr) : __builtin_amdgcn_cosf(fr); }
                u32x4 w; w.x = cvt_pk_bf16(v[0], v[1]); w.y = cvt_pk_bf16(v[2], v[3]); w.z = cvt_pk_bf16(v[4], v[5]); w.w = cvt_pk_bf16(v[6], v[7]);
                *(u32x4*)(dft + (size_t)k * 2048 + c8) = w; }
            for (int row = F.gw; row < NB * MEMT; row += F.NGW) rms_row_to_bf16(mem + (size_t)row * D, mem_g, memn + (size_t)row * D, F.lane);
            for (int l = 0; l < NL; ++l) { colmax_pass(F, AIN(19) + (size_t)l * D * FFH, D, FFH, AIN(18) + (size_t)l * D, cmaxf + (size_t)l * 2 * FFH);
                colmax_pass(F, AIN(20) + (size_t)l * D * FFH, D, FFH, AIN(18) + (size_t)l * D, cmaxf + (size_t)l * 2 * FFH + FFH);
                if (l >= 1) colmax_pass(F, AIN(4) + (size_t)l * D * NPROJ, D, NPROJ, AIN(3) + (size_t)l * D, cminf + (size_t)l * NPROJ); }
            { const int gt2 = F.vcu * (NWAVES * 64) + F.tid; if (gt2 < NPROJ) cminf[gt2] = 127.0f; }
        }
        if (IN(PH_CONV) && layer == 0) {
            RELAUNDER();
            LAS unsigned* scr = (LAS unsigned*)(F.lds + F.wave * 16384);
            convert_matrix(F, AIN(4), D, NPROJ, W_in, 0, 0, scr, AIN(3), nullptr);
            { const int gt = F.vcu * (NWAVES * 64) + F.tid, NT = F.G * NWAVES * 64;
              for (int i = gt; i < NL * FG * 32 * 128; i += NT) { const int c = i & 127, d4 = (i >> 7) & 31, g = (i >> 12) & (FG - 1), l = i >> 15;
                  const float* fw = AIN(8) + (size_t)l * FG * FD * FD + (size_t)g * FD * FD + 4 * d4;
                  f32x4 ac = (f32x4){0.f, 0.f, 0.f, 0.f}, as = ac;
#pragma unroll 16
                  for (int cp = 0; cp < 128; ++cp) { const float fr = (float)((c * cp) & 127) * (1.0f / 128.0f); const f32x4 w = *(const f32x4*)(fw + cp * FD); ac = ac + w * __builtin_amdgcn_cosf(fr); as = as - w * __builtin_amdgcn_sinf(fr); }
                  bf16* fo = (bf16*)(wsp + (l == 0 ? WS_FWT : WS_FWT1)) + ((size_t)g * 256 + 4 * d4) * 128 + c;
#pragma unroll
                  for (int jd = 0; jd < 4; ++jd) { fo[jd * 128] = (bf16)(cvt_pk_bf16(ac[jd] * 0.0013810679320049757f, 0.f) & 0xffff); fo[128 * 128 + jd * 128] = (bf16)(cvt_pk_bf16(as[jd] * 0.0013810679320049757f, 0.f) & 0xffff); } } }
            x_to_stream(F, x_in, anorm, rsv);
            __syncthreads();
            GRID_BAR();
        }
        if (IN(PH_INPROJ)) {
            RELAUNDER();
            if (layer == 0) { pg8::Gemm g{anorm, W_in, M, NPROJ, D}; pg8::StaticOrder S; S.init(M, NPROJ, F.G, F.bid);
              pg8::EpiInProj E{proj, ropec, ropes, rsv, cminf};
              pg8::gemm_phase<pg8::EpiInProj, pg8::StaticOrder, PG8_ALIGN, PG8_SP2, false>(F.lds, g, S, E); }
            else { pg8::Gemm g{(const bf16*)hq, W_in, M, NPROJ, D}; pg8::StaticOrder S; S.init(M, NPROJ, F.G, F.bid);
              pg8::EpiInProj E{proj, ropec, ropes, rqv, cminf + (size_t)layer * NPROJ};
              pg8::gemm_phase<pg8::EpiInProj, pg8::StaticOrder, PG8_ALIGN, PG8_SP2, true>(F.lds, g, S, E); }
            GRID_BAR();
        }
        if (IN(PH_MIXA)) {
            RELAUNDER();
            const int bid = F.bid;
            unsigned* donew = cq + 64 * (layer * 2 + 1);
            if (bid < 128) ret_state_pass(F, bid, 128, proj, rst);
            else hgrn_state_pass(F, bid - 128, 128, proj, gatez, AIN(6), layer, hst);
            RELAUNDER();
            fourier_ut2(F, bid, proj, fwt, ut, nyq);
            { VM_WAIT(); __syncthreads(); if (F.tid == 0) __hip_atomic_fetch_add(donew, 1u, __ATOMIC_RELAXED, __HIP_MEMORY_SCOPE_AGENT); }
            conv_pull(F, args.in, layer, cq + 64 * (layer * 2 + 0), cv_total, cv_total, cd, MISC + 16, donew, 256u);
            GRID_BAR();
        }
        if (IN(PH_MIXB)) {
            RELAUNDER();
            const int bid = F.bid; const float* hng = AIN(7) + (size_t)layer * HW; const float* fbias = AIN(9) + (size_t)layer * FW;
            if (bid < 64) {
                pg8::Gemm g{dft, ut, SEQ, SEQ, 2048};
                { pg8::OneUnit S{bid >> 3, bid & 7}; pg8::EpiF32 E{(float*)(ws + WS_TMP), 2048};
                  pg8::gemm_phase<pg8::EpiF32, pg8::OneUnit, PG8_ALIGN, PG8_SP2>(F.lds, g, S, E); }
                RELAUNDER();
                { pg8::OneUnit S{8 + (bid >> 3), 8 + (bid & 7)}; pg8::EpiFourier2 E{mixin, fbias, nyq, (const float*)(ws + WS_TMP)};
                  pg8::gemm_phase<pg8::EpiFourier2, pg8::OneUnit, PG8_ALIGN, PG8_SP2>(F.lds, g, S, E); }
                RELAUNDER();
                hgrn_output_pass(F, 832 + bid, 64, 1024, proj, gatez, AIN(6), layer, hst, hng, mixin);
            } else {
                const int idx = bid - 64;
                if (idx < 64) fourier_mid_row(F, idx * NWAVES + F.wave, 64 * NWAVES, ut, nyq, fbias, mixin);
                ret_output_pass(F, idx, 192, proj, rst, AIN(5) + (size_t)layer * RW, mixin);
                if (idx < 128) hgrn_output_pass(F, idx, 128, 384, proj, gatez, AIN(6), layer, hst, hng, mixin);
                else hgrn_output_pass(F, 384 + (idx - 128), 64, 832, proj, gatez, AIN(6), layer, hst, hng, mixin);
            }
            conv_pull(F, args.in, layer, cq + 64 * (layer * 2 + 0), CV_P_ITEMS, cv_total, cd, MISC + 16, nullptr, 0u);
            GRID_BAR();
        }
        if (IN(PH_WOUT)) {
            RELAUNDER();
            pg8::Gemm g{mixin, W_out, M, D, D}; pg8::StaticOrder S; S.init(M, D, F.G, F.bid);
            pg8::EpiBf16 E{tmpb, D, 1.0f, nullptr};
            pg8::gemm_phase<pg8::EpiBf16, pg8::StaticOrder, PG8_ALIGN, PG8_SP2>(F.lds, g, S, E);
            GRID_BAR();
        }
        if (IN(PH_NORM1)) {
            RELAUNDER();
            norm_phase(F, tmpb, layer == 0 ? x_in : nullptr, anorm, nullptr, AIN(11) + (size_t)layer * D, rsv);
            GRID_BAR();
        }
        if (IN(PH_XQ)) {
            RELAUNDER();
            { pg8::Gemm g{anorm, W_q, M, XW, D}; pg8::StaticOrder S; S.init(M, XW, F.G, F.bid);
              pg8::EpiBf16 E{xq, XW, 0.0625f, rsv};
              pg8::gemm_phase<pg8::EpiBf16, pg8::StaticOrder, PG8_ALIGN, PG8_SP2>(F.lds, g, S, E); }
            { pg8::Gemm g{memn, W_kv, NB * MEMT, 2 * XW, D}; pg8::StaticOrder S; S.init(NB * MEMT, 2 * XW, F.G, F.bid - 128);
              pg8::EpiBf16 E{kvmem, 2 * XW, 1.0f, nullptr};
              pg8::gemm_phase<pg8::EpiBf16, pg8::StaticOrder, PG8_ALIGN, PG8_SP2>(F.lds, g, S, E); }
            { unsigned* donex = cq + 64 * (4 + layer);
              if (F.bid < 144) { VM_WAIT(); __syncthreads(); if (F.tid == 0) __hip_atomic_fetch_add(donex, 1u, __ATOMIC_RELAXED, __HIP_MEMORY_SCOPE_AGENT); }
              conv_pull(F, args.in, layer, cq + 64 * (layer * 2 + 0), cv_total, cv_total, cd, MISC + 16, donex, 144u); }
            GRID_BAR();
        }
        if (IN(PH_XATT)) {
            RELAUNDER();
            xattn_phase(F, xq, kvmem, xo);
            GRID_BAR();
        }
        if (IN(PH_XWO)) {
            RELAUNDER();
            pg8::Gemm g{xo, W_o, M, D, XW}; pg8::StaticOrder S; S.init(M, D, F.G, F.bid);
            pg8::EpiBf16 E{tmpb, D, 1.0f, nullptr};
            pg8::gemm_phase<pg8::EpiBf16, pg8::StaticOrder, PG8_ALIGN, PG8_SP2>(F.lds, g, S, E);
            GRID_BAR();
        }
        if (IN(PH_NORM2)) {
            RELAUNDER();
            norm_phase_q(F, tmpb, anorm, AIN(17) + (size_t)layer * D, hq, rqv, nullptr);
            conv_pull(F, args.in, layer, cq + 64 * (layer * 2 + 0), CV_ITEMS, cv_total, cd, MISC + 16, nullptr, 0u);
            GRID_BAR();
        }
        if (IN(PH_FFN1)) {
            RELAUNDER();
            pg8::Gemm g{(const bf16*)hq, W_gu, M, 2 * FFH, D}; pg8::StaticOrder S; S.init(M, 2 * FFH, F.G, F.bid);
            pg8::EpiSwiGluQ E{hid, FFH, rqv, cmaxf + (size_t)layer * 2 * FFH, cmaxf + (size_t)layer * 2 * FFH + FFH};
            pg8::gemm_phase<pg8::EpiSwiGluQ, pg8::StaticOrder, PG8_ALIGN, PG8_SP2, true>(F.lds, g, S, E);
            if (layer + 1 < NL) {
                unsigned* donef = cq + 64 * (8 + layer);
                VM_WAIT(); __syncthreads(); if (F.tid == 0) __hip_atomic_fetch_add(donef, 1u, __ATOMIC_RELAXED, __HIP_MEMORY_SCOPE_AGENT);
                conv_pull(F, args.in, layer, cq + 64 * (layer * 2 + 0), cv_total, cv_total, cd, MISC + 16, donef, (unsigned)F.G);
            }
            GRID_BAR();
        }
        if (IN(PH_FFN2)) {
            RELAUNDER();
            pg8::Gemm g{hid, W_dn, M, D, FFH}; pg8::StaticOrder S; S.init(M, D, F.G, F.bid);
            pg8::EpiBf16 E{tmpb, D, 1.0f, nullptr};
            pg8::gemm_phase<pg8::EpiBf16, pg8::StaticOrder, PG8_ALIGN, PG8_SP2>(F.lds, g, S, E);
            GRID_BAR();
        }
        if (IN(PH_NORM3)) {
            RELAUNDER();
            const bool more = layer + 1 < NL;
            if (more) norm_phase_q(F, tmpb, anorm, AIN(22) + (size_t)layer * D, hq, rqv, rsv);
            else norm_phase(F, tmpb, nullptr, anorm, hout, AIN(22) + (size_t)layer * D, nullptr);
            if (more) conv_pull(F, args.in, layer, cq + 64 * (layer * 2 + 0), cv_total, cv_total, cd, MISC + 16, nullptr, 0u);
            if (more) GRID_BAR();
        }
    }
#undef IN
#undef GRID_BAR
}

#undef x_in
#undef mem
#undef mem_g
#undef W_in
#undef W_out
#undef W_q
#undef W_kv
#undef W_o
#undef W_gu
#undef W_dn
#undef anorm
#undef proj
#undef hid
#undef gatez
#undef mixin
#undef tmpb
#undef rst
#undef hst
#undef dft
#undef ut
#undef xq
#undef xo
#undef kvmem
#undef memn
#undef ropec
#undef ropes
#undef fwt
#undef nyq
#undef rsv
#undef rqv
#undef hq
#undef cmaxf
#undef cminf
#undef hout
#undef cq
#undef cd
extern "C" void kernel_launch(void* const* d_in, const int* in_sizes, int n_in, void* d_out, int out_size, void* d_ws, size_t ws_size, hipStream_t stream) {
    static int grid = 0;
    if (grid == 0) {
        if (n_in != 23 || out_size != M * D || ws_size < WS_END) { fprintf(stderr, "kernel_launch: unexpected shapes (n_in %d, out %d, ws %zu < %zu)\n", n_in, out_size, ws_size, (size_t)WS_END); grid = -1; return; }
        int dev = 0, cus = 0, per_cu = 0;
        if (hipGetDevice(&dev) != hipSuccess || hipDeviceGetAttribute(&cus, hipDeviceAttributeMultiprocessorCount, dev) != hipSuccess) { grid = -1; return; }
        if (hipFuncSetAttribute((const void*)fwd_kernel, hipFuncAttributeMaxDynamicSharedMemorySize, LDS_BYTES) != hipSuccess) { fprintf(stderr, "kernel_launch: hipFuncSetAttribute failed\n"); grid = -1; return; }
        if (hipOccupancyMaxActiveBlocksPerMultiprocessor(&per_cu, (const void*)fwd_kernel, NWAVES * 64, LDS_BYTES) != hipSuccess || per_cu < 1) fprintf(stderr, "kernel_launch: occupancy query reports %d\n", per_cu);
        (void)hipGetLastError();
        grid = cus;
    }
    if (grid < 0) return;
    (void)in_sizes;
    if (hipMemsetAsync((char*)d_ws + WS_CTL, 0, CTL_ZERO_BYTES, stream) != hipSuccess) return;
    Args a{};
    for (int i = 0; i < 23; ++i) a.in[i] = (const float*)d_in[i];
    a.out = (float*)d_out; a.ws = (unsigned char*)d_ws; a.pad = 0;
#if ONE_LAUNCH
    a.layer_lo = 0; a.layer_hi = NL; a.ph_lo = 0; a.ph_hi = PH_COUNT; a.single = 1;
    hipLaunchKernelGGL(fwd_kernel, dim3(grid), dim3(NWAVES * 64), LDS_BYTES, stream, a);
#else
    a.single = 0;
    for (int layer = 0; layer < NL; ++layer)
        for (int ph = (layer == 0 ? PH_PRE : PH_CONV); ph < PH_COUNT; ++ph) {
            a.layer_lo = layer; a.layer_hi = layer + 1; a.ph_lo = ph; a.ph_hi = ph + 1;
            hipLaunchKernelGGL(fwd_kernel, dim3(grid), dim3(NWAVES * 64), LDS_BYTES, stream, a);
        }
#endif
}
```

```cpp
#include <hip/hip_runtime.h>
#include <cstdio>
#include <cstdint>

#ifndef ONE_LAUNCH
#define ONE_LAUNCH 1
#endif

#define LAS __attribute__((address_space(3)))
#define GAS __attribute__((address_space(1)))
typedef unsigned short bf16;
typedef short bf16x8 __attribute__((ext_vector_type(8)));
typedef float f32x4 __attribute__((ext_vector_type(4)));
typedef float f32x2 __attribute__((ext_vector_type(2)));
typedef unsigned u32x4 __attribute__((ext_vector_type(4)));
typedef unsigned u32x2 __attribute__((ext_vector_type(2)));
typedef int i32x4 __attribute__((ext_vector_type(4)));

constexpr int D = 4096, NB = 2, SEQ = 4096, NL = 2, M = NB * SEQ;
constexpr int RW = 2048, RH = 8, RD = 256;
constexpr int HW = 1024, HH = 8, HD = 128;
constexpr int FW = 1024, FG = 8, FD = 128;
constexpr int NPROJ = 14336;
constexpr int XW = 1024, XH = 4, XD = 256, MEMT = 256;
constexpr int FFH = 11008;
constexpr int C_RQ = 0, C_RK = 2048, C_RV = 4096, C_RG = 6144, C_HQ = 8192, C_HFF = 9216, C_HFB = 10240, C_HI = 11264, C_HG = 12288, C_FZ = 13312;
constexpr float RMS_EPS = 1e-6f, GN_EPS = 1e-5f;

constexpr size_t MiB = 1u << 20;
constexpr size_t WS_CTL = 0, CTL_ZERO_BYTES = 1 * MiB;
constexpr size_t WS_WIN = 1 * MiB;
constexpr size_t WS_WOUT = 113 * MiB;
constexpr size_t WS_WQ = 145 * MiB;
constexpr size_t WS_WKV = 153 * MiB;
constexpr size_t WS_WO = 169 * MiB;
constexpr size_t WS_WGU = 177 * MiB;
constexpr size_t WS_WDN = 349 * MiB;
constexpr size_t WS_ANORM = 435 * MiB;
constexpr size_t WS_PROJ = 499 * MiB;
constexpr size_t WS_GATEZ = 723 * MiB;
constexpr size_t WS_MIXIN = 787 * MiB;
constexpr size_t WS_TMP = 851 * MiB;
constexpr size_t WS_SCR = 979 * MiB;
constexpr size_t WS_DFT = 1171 * MiB;
constexpr size_t WS_UT = 1235 * MiB;
constexpr size_t WS_XQ = 1267 * MiB;
constexpr size_t WS_XO = 1283 * MiB;
constexpr size_t WS_KVMEM = 1299 * MiB;
constexpr size_t WS_MEMN = 1301 * MiB;
constexpr size_t WS_ROPE = 1305 * MiB;
constexpr size_t WS_FWT = 1309 * MiB;
constexpr size_t WS_FWT1 = 1310 * MiB;
constexpr size_t WS_END = 1311 * MiB;
constexpr int CW_BAR = 4096, CW_CONVQ = 8192;

constexpr int LDS_BYTES = 147456;
constexpr int LDSCTL_OFF = LDS_BYTES - 512, MISC_OFF = LDSCTL_OFF + 320;
constexpr int NWAVES = 8;

typedef __bf16 bf16x2_t __attribute__((ext_vector_type(2)));
__device__ __forceinline__ unsigned cvt_pk_bf16(float lo, float hi) { const f32x2 v = {lo, hi}; return __builtin_bit_cast(unsigned, __builtin_convertvector(v, bf16x2_t)); }
__device__ __forceinline__ float bf2f(unsigned b) { return __uint_as_float(b << 16); }
__device__ __forceinline__ float bflo(unsigned w) { return __uint_as_float(w << 16); }
__device__ __forceinline__ float bfhi(unsigned w) { return __uint_as_float(w & 0xffff0000u); }
__device__ __forceinline__ float wave_sum(float v) {
#pragma unroll
    for (int o = 1; o < 64; o <<= 1) v += __shfl_xor(v, o);
    return v;
}
__device__ __forceinline__ float fast_sigmoid(float x) { return __builtin_amdgcn_rcpf(1.0f + __expf(-x)); }
__device__ __forceinline__ float silu_f(float x) { return x * fast_sigmoid(x); }
#define LDS_WAIT() asm volatile("s_waitcnt lgkmcnt(0)" ::: "memory")
#define VM_WAIT() asm volatile("s_waitcnt vmcnt(0)" ::: "memory")

namespace pg8 {
constexpr int BM = 256, BK = 64, HALF = 128, HTB = HALF * BK * 2, STAGE_BYTES = 8 * HTB, NXCD = 8, WGM = 8;
__host__ __device__ __forceinline__ int lds_byte(int r, int c) { const int st = (r >> 4) * 2 + (c >> 5), rr = r & 15, cc = c & 31, ob = rr * 64 + cc * 2; return st * 1024 + (ob ^ (((ob >> 9) & 1) << 5)); }
__host__ __device__ __forceinline__ void stage_rc(int b, int& R, int& C) { const int st = b / 1024, sb = b % 1024, swz = sb ^ (((sb >> 9) & 1) << 5); R = (st >> 1) * 16 + swz / 64; C = (st & 1) * 32 + (swz % 64) / 2; }
__host__ __device__ __forceinline__ int perm32(int rho) { const int n = rho >> 4, i = rho & 15; return 8 * (i >> 2) + 4 * n + (i & 3); }
struct Unit { int pm, pn; };
struct Gemm { const bf16* A; const bf16* Bt; int M, N, K; };
struct StaticOrder {
    int nM, nN, nwg, G, c;
    __host__ __device__ void init(int M_, int N_, int G_, int c_) { nM = M_ / BM; nN = N_ / BM; nwg = nM * nN; G = G_; c = c_; }
    __host__ __device__ bool next(int i, Unit& u) const {
        if (c < 0) return false;
        const long Lx = (long)i * G + c; if (Lx >= nwg) return false;
        int wgid = (int)Lx; { const int q = nwg / NXCD, r = nwg % NXCD, xcd = wgid % NXCD, off = wgid / NXCD; wgid = (xcd < r ? xcd * (q + 1) : r * (q + 1) + (xcd - r) * q) + off; }
        const int nig = WGM * nN, gid = wgid / nig, fm = gid * WGM, gsz = (nM - fm) < WGM ? (nM - fm) : WGM;
        u.pm = fm + ((wgid % nig) % gsz); u.pn = (wgid % nig) / gsz; return true;
    }
    __device__ __forceinline__ void a_ready(const Unit&) const {}
    __device__ __forceinline__ void done(const Unit&) const {}
};

struct EpiF32 {
    static constexpr bool PERM = false;
    static constexpr int NSCALE = 0; __device__ __forceinline__ const float* scale_ptr(const Unit&, int) const { return nullptr; }
    float* C; int ldc;
    __device__ __forceinline__ void operator()(const f32x4 (&acc)[2][2][4][2], const Unit& u, int wr, int wc, int fr, int fq, const LAS float* sl) const {
        const int row0 = u.pm * BM + wr * 64 + fr, col0 = u.pn * BM + wc * 32 + 4 * fq;
#pragma unroll
        for (int ai = 0; ai < 2; ++ai)
#pragma unroll
            for (int m = 0; m < 4; ++m) { float* rowp = C + (size_t)(row0 + ai * HALF + m * 16) * ldc + col0;
#pragma unroll
                for (int bj = 0; bj < 2; ++bj)
#pragma unroll
                    for (int n = 0; n < 2; ++n) *(f32x4*)(rowp + bj * HALF + n * 16) = acc[ai][bj][m][n]; }
    }
};
struct EpiBf16 {
    static constexpr bool PERM = true;
    static constexpr int NSCALE = 1;
    __device__ __forceinline__ const float* scale_ptr(const Unit& u, int) const { return rs ? rs + u.pm * BM : nullptr; }
    bf16* O; int ldc; float scale; const float* rs;
    __device__ __forceinline__ void operator()(const f32x4 (&acc)[2][2][4][2], const Unit& u, int wr, int wc, int fr, int fq, const LAS float* sl) const {
        const int row0 = u.pm * BM + wr * 64 + fr, col0 = u.pn * BM + wc * 32 + 8 * fq;
        float scv[2][4];
#pragma unroll
        for (int ai = 0; ai < 2; ++ai)
#pragma unroll
            for (int m = 0; m < 4; ++m) scv[ai][m] = rs ? scale * sl[wr * 64 + fr + ai * HALF + m * 16] : scale;
        asm volatile("" ::: "memory");
#pragma unroll
        for (int ai = 0; ai < 2; ++ai)
#pragma unroll
            for (int m = 0; m < 4; ++m) { bf16* rowp = O + (size_t)(row0 + ai * HALF + m * 16) * ldc + col0; const float sc = scv[ai][m];
#pragma unroll
                for (int bj = 0; bj < 2; ++bj) { const f32x4 v0 = acc[ai][bj][m][0] * sc, v1 = acc[ai][bj][m][1] * sc;
                    u32x4 w; w.x = cvt_pk_bf16(v0[0], v0[1]); w.y = cvt_pk_bf16(v0[2], v0[3]); w.z = cvt_pk_bf16(v1[0], v1[1]); w.w = cvt_pk_bf16(v1[2], v1[3]);
                    *(u32x4*)(rowp + bj * HALF) = w; } }
    }
};
struct EpiInProj {
    static constexpr bool PERM = true;
    static constexpr int NSCALE = 2;
    __device__ __forceinline__ const float* scale_ptr(const Unit& u, int k) const { return k == 0 ? rs + u.pm * BM : cm + u.pn * BM; }
    bf16* proj; const float* ropec; const float* ropes; const float* rs; const float* cm;
    __device__ __forceinline__ void operator()(const f32x4 (&acc)[2][2][4][2], const Unit& u, int wr, int wc, int fr, int fq, const LAS float* sl) const {
        const int row0 = u.pm * BM + wr * 64 + fr, colw = wc * 32 + 8 * fq;
        const LAS float* cp = sl + 256 + colw;
        const f32x4 ca0 = *(const LAS f32x4*)(cp) * (1.0f / 127.0f), ca1 = *(const LAS f32x4*)(cp + 4) * (1.0f / 127.0f), cb0 = *(const LAS f32x4*)(cp + HALF) * (1.0f / 127.0f), cb1 = *(const LAS f32x4*)(cp + HALF + 4) * (1.0f / 127.0f);
        float rsl[2][4];
#pragma unroll
        for (int ai = 0; ai < 2; ++ai)
#pragma unroll
            for (int m = 0; m < 4; ++m) rsl[ai][m] = sl[wr * 64 + fr + ai * HALF + m * 16];
        if (u.pn < 16) {
            const float sc0 = u.pn < 8 ? 0.0625f : 1.0f;
            const f32x4 C0 = *(const f32x4*)(ropec + 16 * 128 + colw), C1 = *(const f32x4*)(ropec + 16 * 128 + colw + 4), S0 = *(const f32x4*)(ropes + 16 * 128 + colw), S1 = *(const f32x4*)(ropes + 16 * 128 + colw + 4);
            f32x4 cc0[2], cc1[2], ss0[2], ss1[2];
#pragma unroll
            for (int ai = 0; ai < 2; ++ai) { const int pos0 = (row0 + ai * HALF) & (SEQ - 1);
                cc0[ai] = *(const f32x4*)(ropec + pos0 * 128 + colw); cc1[ai] = *(const f32x4*)(ropec + pos0 * 128 + colw + 4);
                ss0[ai] = *(const f32x4*)(ropes + pos0 * 128 + colw); ss1[ai] = *(const f32x4*)(ropes + pos0 * 128 + colw + 4); }
            asm volatile("" ::: "memory");
#pragma unroll
            for (int ai = 0; ai < 2; ++ai) {
                f32x4 c0 = cc0[ai], c1 = cc1[ai], s0 = ss0[ai], s1 = ss1[ai];
#pragma unroll
                for (int m = 0; m < 4; ++m) { const int r = row0 + ai * HALF + m * 16; const float sc = sc0 * rsl[ai][m];
                    if (m) { const f32x4 n0 = c0 * C0 - s0 * S0, n1 = c1 * C1 - s1 * S1; s0 = s0 * C0 + c0 * S0; s1 = s1 * C1 + c1 * S1; c0 = n0; c1 = n1; }
                    const f32x4 a0 = acc[ai][0][m][0] * ca0, a1 = acc[ai][0][m][1] * ca1, b0 = acc[ai][1][m][0] * cb0, b1 = acc[ai][1][m][1] * cb1;
                    const f32x4 o10 = (a0 * c0 - b0 * s0) * sc, o11 = (a1 * c1 - b1 * s1) * sc, o20 = (a0 * s0 + b0 * c0) * sc, o21 = (a1 * s1 + b1 * c1) * sc;
                    bf16* rowp = proj + (size_t)r * NPROJ + u.pn * BM + colw;
                    u32x4 w; w.x = cvt_pk_bf16(o10[0], o10[1]); w.y = cvt_pk_bf16(o10[2], o10[3]); w.z = cvt_pk_bf16(o11[0], o11[1]); w.w = cvt_pk_bf16(o11[2], o11[3]);
                    *(u32x4*)(rowp) = w;
                    w.x = cvt_pk_bf16(o20[0], o20[1]); w.y = cvt_pk_bf16(o20[2], o20[3]); w.z = cvt_pk_bf16(o21[0], o21[1]); w.w = cvt_pk_bf16(o21[2], o21[3]);
                    *(u32x4*)(rowp + HALF) = w; } }
        } else {
            asm volatile("" ::: "memory");
#pragma unroll
            for (int ai = 0; ai < 2; ++ai)
#pragma unroll
                for (int m = 0; m < 4; ++m) { bf16* rowp = proj + (size_t)(row0 + ai * HALF + m * 16) * NPROJ + u.pn * BM + colw; const float sc = rsl[ai][m];
                    { const f32x4 v0 = acc[ai][0][m][0] * ca0 * sc, v1 = acc[ai][0][m][1] * ca1 * sc;
                      u32x4 w; w.x = cvt_pk_bf16(v0[0], v0[1]); w.y = cvt_pk_bf16(v0[2], v0[3]); w.z = cvt_pk_bf16(v1[0], v1[1]); w.w = cvt_pk_bf16(v1[2], v1[3]); *(u32x4*)(rowp) = w; }
                    { const f32x4 v0 = acc[ai][1][m][0] * cb0 * sc, v1 = acc[ai][1][m][1] * cb1 * sc;
                      u32x4 w; w.x = cvt_pk_bf16(v0[0], v0[1]); w.y = cvt_pk_bf16(v0[2], v0[3]); w.z = cvt_pk_bf16(v1[0], v1[1]); w.w = cvt_pk_bf16(v1[2], v1[3]); *(u32x4*)(rowp + HALF) = w; } }
        }
    }
};
struct EpiSwiGlu {
    static constexpr bool PERM = true;
    static constexpr int NSCALE = 0; __device__ __forceinline__ const float* scale_ptr(const Unit&, int) const { return nullptr; }
    bf16* H; int ldc; const float* rs;
    __device__ __forceinline__ void operator()(const f32x4 (&acc)[2][2][4][2], const Unit& u, int wr, int wc, int fr, int fq, const LAS float* sl) const {
        const int row0 = u.pm * BM + wr * 64 + fr, col0 = u.pn * HALF + wc * 32 + 8 * fq;
#pragma unroll
        for (int ai = 0; ai < 2; ++ai)
#pragma unroll
            for (int m = 0; m < 4; ++m) { bf16* rowp = H + (size_t)(row0 + ai * HALF + m * 16) * ldc + col0; const float sc = rs[row0 + ai * HALF + m * 16];
                f32x4 v0, v1;
#pragma unroll
                for (int j = 0; j < 4; ++j) { v0[j] = silu_f(acc[ai][0][m][0][j] * sc) * (acc[ai][1][m][0][j] * sc); v1[j] = silu_f(acc[ai][0][m][1][j] * sc) * (acc[ai][1][m][1][j] * sc); }
                u32x4 w; w.x = cvt_pk_bf16(v0[0], v0[1]); w.y = cvt_pk_bf16(v0[2], v0[3]); w.z = cvt_pk_bf16(v1[0], v1[1]); w.w = cvt_pk_bf16(v1[2], v1[3]);
                *(u32x4*)(rowp) = w; }
    }
};
struct EpiSwiGluQ {
    static constexpr bool PERM = true;
    static constexpr int NSCALE = 3;
    __device__ __forceinline__ const float* scale_ptr(const Unit& u, int k) const { return k == 0 ? rq + u.pm * BM : (k == 1 ? cmg : cmu) + u.pn * HALF; }
    bf16* H; int ldc; const float* rq; const float* cmg; const float* cmu;
    __device__ __forceinline__ void operator()(const f32x4 (&acc)[2][2][4][2], const Unit& u, int wr, int wc, int fr, int fq, const LAS float* sl) const {
        const int row0 = u.pm * BM + wr * 64 + fr, col0 = u.pn * HALF + wc * 32 + 8 * fq;
        const int cl = wc * 32 + 8 * fq;
        const f32x4 sg0 = *(const LAS f32x4*)(sl + 256 + cl) * (1.0f / 127.0f), sg1 = *(const LAS f32x4*)(sl + 256 + cl + 4) * (1.0f / 127.0f);
        const f32x4 su0 = *(const LAS f32x4*)(sl + 512 + cl) * (1.0f / 127.0f), su1 = *(const LAS f32x4*)(sl + 512 + cl + 4) * (1.0f / 127.0f);
        float rql[2][4];
#pragma unroll
        for (int ai = 0; ai < 2; ++ai)
#pragma unroll
            for (int m = 0; m < 4; ++m) rql[ai][m] = sl[wr * 64 + fr + ai * HALF + m * 16];
        asm volatile("" ::: "memory");
#pragma unroll
        for (int ai = 0; ai < 2; ++ai)
#pragma unroll
            for (int m = 0; m < 4; ++m) { bf16* rowp = H + (size_t)(row0 + ai * HALF + m * 16) * ldc + col0; const float sc = rql[ai][m];
                f32x4 v0, v1;
#pragma unroll
                for (int j = 0; j < 4; ++j) { v0[j] = silu_f(acc[ai][0][m][0][j] * (sc * sg0[j])) * (acc[ai][1][m][0][j] * (sc * su0[j])); v1[j] = silu_f(acc[ai][0][m][1][j] * (sc * sg1[j])) * (acc[ai][1][m][1][j] * (sc * su1[j])); }
                u32x4 w; w.x = cvt_pk_bf16(v0[0], v0[1]); w.y = cvt_pk_bf16(v0[2], v0[3]); w.z = cvt_pk_bf16(v1[0], v1[1]); w.w = cvt_pk_bf16(v1[2], v1[3]);
                *(u32x4*)(rowp) = w; }
    }
};
struct SkipOrder : StaticOrder {
    int skip0, nskip;
    __device__ __forceinline__ bool next(int i, Unit& u) const { if (!StaticOrder::next(i, u)) return false; if (u.pn >= skip0) u.pn += nskip; return true; }
};
struct OneUnit {
    int pm, pn;
    __device__ __forceinline__ bool next(int i, Unit& u) const { if (pm < 0 || i > 0) return false; u.pm = pm; u.pn = pn; return true; }
    __device__ __forceinline__ void a_ready(const Unit&) const {}
    __device__ __forceinline__ void done(const Unit&) const {}
};
struct EpiFourier2 {
    static constexpr bool PERM = false;
    bf16* O; const float* bias; const float* nyq; const float* fa;
    static constexpr int NSCALE = 0; __device__ __forceinline__ const float* scale_ptr(const Unit&, int) const { return nullptr; }
    __device__ __forceinline__ void operator()(const f32x4 (&acc)[2][2][4][2], const Unit& u, int wr, int wc, int fr, int fq, const LAS float* sl) const {
        const int krow0 = (u.pm - 8) * BM + wr * 64 + fr, cbase = (u.pn - 8) * BM + wc * 32 + 4 * fq, b = cbase >> 10, colm0 = cbase & 1023;
#pragma unroll
        for (int ai = 0; ai < 2; ++ai)
#pragma unroll
            for (int m = 0; m < 4; ++m) { const int k = krow0 + ai * HALF + m * 16; const float sg = (k & 1) ? -1.0f : 1.0f;
                const float* ap = fa + (size_t)k * 2048 + cbase;
                bf16* row1 = O + (size_t)(b * SEQ + k) * D + 3072 + colm0; bf16* row2 = O + (size_t)(b * SEQ + ((SEQ - k) & (SEQ - 1))) * D + 3072 + colm0;
#pragma unroll
                for (int bj = 0; bj < 2; ++bj)
#pragma unroll
                    for (int n = 0; n < 2; ++n) { const int off = bj * HALF + n * 16;
                        const f32x4 av = *(const f32x4*)(ap + off); const f32x4 e = *(const f32x4*)(nyq + cbase + off) * sg + *(const f32x4*)(bias + colm0 + off); const f32x4 bv = acc[ai][bj][m][n];
                        const f32x4 p = av + bv + e, qv = av - bv + e;
                        u32x2 w; w.x = cvt_pk_bf16(p[0], p[1]); w.y = cvt_pk_bf16(p[2], p[3]); *(u32x2*)(row1 + off) = w;
                        if (k != 0) { w.x = cvt_pk_bf16(qv[0], qv[1]); w.y = cvt_pk_bf16(qv[2], qv[3]); *(u32x2*)(row2 + off) = w; } }
                asm volatile("" ::: "memory"); }
    }
};

template <class Epi, class Sched, bool ALIGN_EPI = false, bool SP2 = false, bool I8 = false>
__device__ __forceinline__ void gemm_phase(LAS unsigned char* lds, const Gemm g, const Sched& S, const Epi& E) {
    int tid_ = threadIdx.x; asm volatile("" : "+v"(tid_));
    const int tid = tid_, wid = __builtin_amdgcn_readfirstlane(tid >> 6), lane = tid & 63, wr = wid >> 2, wc = wid & 3, fr = lane & 15, fq = lane >> 4;
    const int KB = I8 ? g.K : 2 * g.K, nt = KB / (BK * 2);
    unsigned voffA[2], voffB[2];
#pragma unroll
    for (int i = 0; i < 2; ++i) { int R, C; stage_rc(tid * 16 + i * 8192, R, C); const int Rb = Epi::PERM ? ((R & ~31) + perm32(R & 31)) : R;
        voffA[i] = (unsigned)(R * KB + 2 * C); voffB[i] = (unsigned)(Rb * KB + 2 * C); }
    const size_t kstep = (size_t)(BK * 2);
    const size_t hstep = (size_t)HALF * KB;
    const size_t tstep = 2 * hstep;
    const unsigned ldsw = (unsigned)wid * 1024u;
    const int aoff = lds_byte(wr * 64 + fr, fq * 8), boff = lds_byte(wc * 32 + fr, fq * 8);
#define PG8_SA(b, h) (((b) * 2 + (h)) * HTB)
#define PG8_SB(b, h) ((4 + (b) * 2 + (h)) * HTB)
#define PG8_STAGE(bufoff, gbase, voff) do { _Pragma("unroll") for (int _i = 0; _i < 2; ++_i) \
        __builtin_amdgcn_global_load_lds((const unsigned*)((const char*)(gbase) + (voff)[_i]), (LAS unsigned*)(lds + (bufoff) + ldsw + _i * 8192), 16, 0, 0); } while (0)
#define PG8_LDA(dst, b, h) do { _Pragma("unroll") for (int m = 0; m < 4; ++m) _Pragma("unroll") for (int k = 0; k < 2; ++k) dst[m][k] = *(const LAS bf16x8*)(lds + PG8_SA(b, h) + aoff + m * 2048 + k * 1024); } while (0)
#define PG8_LDB(dst, b, h) do { _Pragma("unroll") for (int n = 0; n < 2; ++n) _Pragma("unroll") for (int k = 0; k < 2; ++k) dst[n][k] = *(const LAS bf16x8*)(lds + PG8_SB(b, h) + boff + n * 2048 + k * 1024); } while (0)
#define PG8_MMA(ai, bj, At, Bt) do { __builtin_amdgcn_s_setprio(1); _Pragma("unroll") for (int m = 0; m < 4; ++m) _Pragma("unroll") for (int n = 0; n < 2; ++n) _Pragma("unroll") for (int k = 0; k < 2; ++k) { \
        if constexpr (I8) acc[ai][bj][m][n] = __builtin_bit_cast(f32x4, __builtin_amdgcn_mfma_i32_16x16x64_i8(__builtin_bit_cast(i32x4, Bt[n][k]), __builtin_bit_cast(i32x4, At[m][k]), __builtin_bit_cast(i32x4, acc[ai][bj][m][n]), 0, 0, 0)); \
        else acc[ai][bj][m][n] = __builtin_amdgcn_mfma_f32_16x16x32_bf16(Bt[n][k], At[m][k], acc[ai][bj][m][n], 0, 0, 0); } __builtin_amdgcn_s_setprio(0); } while (0)
#define PG8_WAIT_V(n) asm volatile("s_waitcnt vmcnt(" #n ")" ::: "memory")
#define PG8_WAIT_L(n) asm volatile("s_waitcnt lgkmcnt(" #n ")" ::: "memory")
#define PG8_BAR __builtin_amdgcn_s_barrier()
#define PG8_SCHED __builtin_amdgcn_sched_barrier(0)
    Unit cur, nxt; int ui = 0;
    if (!S.next(0, cur)) return;
#define PG8_SCALES(unit, par) do { if constexpr (Epi::NSCALE > 0) { if (wid < Epi::NSCALE) { const float* gp_ = E.scale_ptr(unit, wid); \
        if (gp_) __builtin_amdgcn_global_load_lds((const unsigned*)(gp_ + 4 * lane), (LAS unsigned*)(lds + 8 * HTB + (par) * 3072 + wid * 1024), 16, 0, 0); } } } while (0)
    PG8_SCALES(cur, 0);
    f32x4 acc[2][2][4][2];
#pragma unroll
    for (int a = 0; a < 2; ++a)
#pragma unroll
        for (int b = 0; b < 2; ++b)
#pragma unroll
            for (int m = 0; m < 4; ++m)
#pragma unroll
                for (int n = 0; n < 2; ++n) acc[a][b][m][n] = (f32x4){0.f, 0.f, 0.f, 0.f};
    bf16x8 At[4][2], B0[2][2], B1[2][2];
    const char* cA = (const char*)g.A + (size_t)cur.pm * tstep; const char* cB = (const char*)g.Bt + (size_t)cur.pn * tstep;
    S.a_ready(cur);
    if constexpr (SP2) {
        PG8_STAGE(PG8_SB(0, 0), cB, voffB); PG8_STAGE(PG8_SB(0, 1), cB + hstep, voffB); PG8_STAGE(PG8_SA(0, 0), cA, voffA); PG8_STAGE(PG8_SA(0, 1), cA + hstep, voffA);
        if (wr == 1) PG8_BAR;
        PG8_WAIT_V(2); PG8_BAR;
        PG8_STAGE(PG8_SB(1, 0), cB + kstep, voffB); PG8_STAGE(PG8_SA(1, 0), cA + kstep, voffA); PG8_STAGE(PG8_SB(1, 1), cB + hstep + kstep, voffB);
        PG8_WAIT_V(6); PG8_BAR;
    } else {
        PG8_STAGE(PG8_SB(0, 0), cB, voffB); PG8_STAGE(PG8_SA(0, 0), cA, voffA); PG8_STAGE(PG8_SB(0, 1), cB + hstep, voffB); PG8_STAGE(PG8_SA(0, 1), cA + hstep, voffA);
        if (wr == 1) PG8_BAR;
        PG8_WAIT_V(4); PG8_BAR;
        PG8_STAGE(PG8_SB(1, 0), cB + kstep, voffB); PG8_STAGE(PG8_SA(1, 0), cA + kstep, voffA); PG8_STAGE(PG8_SB(1, 1), cB + hstep + kstep, voffB);
        PG8_WAIT_V(6); PG8_BAR;
    }
    for (;;) {
        const bool has_next = S.next(ui + 1, nxt);
        const char* nA = has_next ? (const char*)g.A + (size_t)nxt.pm * tstep : cA; const char* nB = has_next ? (const char*)g.Bt + (size_t)nxt.pn * tstep : cB;
        for (int t = 0; t < nt; t += 2) {
            const bool last = (t == nt - 2);
            const char* a1 = cA + (size_t)(t + 1) * kstep;
            const char* a2 = last ? nA : cA + (size_t)(t + 2) * kstep; const char* b2 = last ? nB : cB + (size_t)(t + 2) * kstep;
            const char* a3 = a2 + kstep; const char* b3 = b2 + kstep;
            if (last && has_next) { S.a_ready(nxt); PG8_SCALES(nxt, (ui + 1) & 1); }
            if constexpr (SP2) {
            PG8_LDB(B0, 0, 0); PG8_LDB(B1, 0, 1); PG8_SCHED; PG8_LDA(At, 0, 0); PG8_STAGE(PG8_SA(1, 1), a1 + hstep, voffA);
            PG8_WAIT_V(8); PG8_WAIT_L(0); PG8_BAR; PG8_MMA(0, 0, At, B0); PG8_MMA(0, 1, At, B1); PG8_BAR; PG8_SCHED;
            PG8_LDA(At, 0, 1); PG8_STAGE(PG8_SB(0, 0), b2, voffB); PG8_STAGE(PG8_SB(0, 1), b2 + hstep, voffB); PG8_STAGE(PG8_SA(0, 0), a2, voffA);
            PG8_WAIT_V(8); PG8_WAIT_L(0); PG8_BAR; PG8_MMA(1, 0, At, B0); PG8_MMA(1, 1, At, B1); PG8_BAR; PG8_SCHED;
            PG8_LDB(B0, 1, 0); PG8_LDB(B1, 1, 1); PG8_SCHED; PG8_LDA(At, 1, 0); PG8_STAGE(PG8_SA(0, 1), a2 + hstep, voffA);
            PG8_WAIT_V(8); PG8_WAIT_L(0); PG8_BAR; PG8_MMA(0, 0, At, B0); PG8_MMA(0, 1, At, B1); PG8_BAR; PG8_SCHED;
            PG8_LDA(At, 1, 1); PG8_STAGE(PG8_SB(1, 0), b3, voffB); PG8_STAGE(PG8_SB(1, 1), b3 + hstep, voffB); PG8_STAGE(PG8_SA(1, 0), a3, voffA);
            PG8_WAIT_V(8); PG8_WAIT_L(0); PG8_BAR; PG8_MMA(1, 0, At, B0); PG8_MMA(1, 1, At, B1); PG8_BAR; PG8_SCHED;
            } else {
            PG8_LDB(B0, 0, 0); PG8_SCHED; PG8_LDA(At, 0, 0); PG8_STAGE(PG8_SA(1, 1), a1 + hstep, voffA);
            PG8_WAIT_L(8); PG8_BAR; PG8_WAIT_L(0); PG8_MMA(0, 0, At, B0); PG8_BAR; PG8_SCHED;
            PG8_LDB(B1, 0, 1); PG8_STAGE(PG8_SB(0, 0), b2, voffB);
            PG8_BAR; PG8_WAIT_L(0); PG8_MMA(0, 1, At, B1); PG8_BAR;
            PG8_LDA(At, 0, 1); PG8_STAGE(PG8_SA(0, 0), a2, voffA);
            PG8_BAR; PG8_WAIT_L(0); PG8_MMA(1, 0, At, B0); PG8_BAR; PG8_SCHED;
            PG8_STAGE(PG8_SB(0, 1), b2 + hstep, voffB);
            PG8_WAIT_V(6); PG8_BAR; PG8_MMA(1, 1, At, B1); PG8_BAR;
            PG8_LDB(B0, 1, 0); PG8_SCHED; PG8_LDA(At, 1, 0); PG8_STAGE(PG8_SA(0, 1), a2 + hstep, voffA);
            PG8_WAIT_L(8); PG8_BAR; PG8_WAIT_L(0); PG8_MMA(0, 0, At, B0); PG8_BAR; PG8_SCHED;
            PG8_LDB(B1, 1, 1); PG8_STAGE(PG8_SB(1, 0), b3, voffB);
            PG8_BAR; PG8_WAIT_L(0); PG8_MMA(0, 1, At, B1); PG8_BAR;
            PG8_LDA(At, 1, 1); PG8_STAGE(PG8_SA(1, 0), a3, voffA);
            PG8_BAR; PG8_WAIT_L(0); PG8_MMA(1, 0, At, B0); PG8_BAR; PG8_SCHED;
            PG8_STAGE(PG8_SB(1, 1), b3 + hstep, voffB);
            PG8_WAIT_V(6); PG8_BAR; PG8_MMA(1, 1, At, B1); PG8_BAR;
            }
        }
        if constexpr (ALIGN_EPI) { if (wr == 0) PG8_BAR; }
        if constexpr (I8) {
#pragma unroll
            for (int a = 0; a < 2; ++a)
#pragma unroll
                for (int b = 0; b < 2; ++b)
#pragma unroll
                    for (int m = 0; m < 4; ++m)
#pragma unroll
                        for (int n = 0; n < 2; ++n) acc[a][b][m][n] = __builtin_convertvector(__builtin_bit_cast(i32x4, acc[a][b][m][n]), f32x4); }
        E(acc, cur, wr, wc, fr, fq, (const LAS float*)(lds + 8 * HTB + (ui & 1) * 3072)); S.done(cur);
        if (!has_next) break;
#pragma unroll
        for (int a = 0; a < 2; ++a)
#pragma unroll
            for (int b = 0; b < 2; ++b)
#pragma unroll
                for (int m = 0; m < 4; ++m)
#pragma unroll
                    for (int n = 0; n < 2; ++n) acc[a][b][m][n] = (f32x4){0.f, 0.f, 0.f, 0.f};
        cur = nxt; cA = nA; cB = nB; ++ui;
        if constexpr (ALIGN_EPI) { if (wr == 1) PG8_BAR; }
    }
    PG8_WAIT_V(0);
    if constexpr (!ALIGN_EPI) { if (wr == 0) PG8_BAR; }
    PG8_BAR;
#undef PG8_SCALES
#undef PG8_SA
#undef PG8_SB
#undef PG8_STAGE
#undef PG8_LDA
#undef PG8_LDB
#undef PG8_MMA
#undef PG8_WAIT_V
#undef PG8_WAIT_L
#undef PG8_BAR
#undef PG8_SCHED
}
}
#define PG8_SP2 true
#define PG8_ALIGN true

#define XB_TMO      128
#define XB_XCNT(j)  (256  + 64 * (j))
#define XB_XSUB(j)  (1280 + 64 * (j))
#define XB_XGEN(j)  (2304 + 64 * (j))
#define XB_TOP      3328
#define XB_TOPGEN   3392
#define XCD_BAR_WORDS 3456
#define XB_SPIN_CAP (1u << 18)
__device__ __forceinline__ unsigned xb_ld(unsigned* p)              { return __hip_atomic_load(p, __ATOMIC_RELAXED, __HIP_MEMORY_SCOPE_AGENT); }
__device__ __forceinline__ unsigned xb_add(unsigned* p, unsigned v) { return __hip_atomic_fetch_add(p, v, __ATOMIC_RELAXED, __HIP_MEMORY_SCOPE_AGENT); }
__device__ __forceinline__ unsigned xb_xcc_id() { return (unsigned)__builtin_amdgcn_s_getreg((3 << 11) | 20) & 0xFu; }
#define XB_SPIN(cond, bar) do { unsigned _sp = 0; while (cond) { __builtin_amdgcn_s_sleep(1); \
    if ((++_sp & 255u) == 0u) { if (xb_ld(&(bar)[XB_TMO])) break; if (_sp > XB_SPIN_CAP) { atomicAdd(&(bar)[XB_TMO], 1u); break; } } } } while (0)
struct XcdBarrier { unsigned* bar; unsigned x; volatile LAS unsigned* st; };
__device__ __forceinline__ XcdBarrier xcd_barrier_post(unsigned* bar, volatile LAS unsigned* st) {
    XcdBarrier b; b.bar = bar; b.x = xb_xcc_id(); b.st = st;
    if (threadIdx.x == 0) (void)xb_add(&bar[XB_XCNT(b.x)], 1u);
    return b;
}
__device__ __forceinline__ void xcd_barrier_complete(unsigned* bar, unsigned x, unsigned& nloc, unsigned& nx) {
    const unsigned G = gridDim.x * gridDim.y * gridDim.z;
    unsigned sum, cnt, mine, sp = 0u;
    for (;;) {
        sum = 0u; cnt = 0u; mine = 0u;
#pragma unroll
        for (unsigned j = 0; j < 16; ++j) { const unsigned c = xb_ld(&bar[XB_XCNT(j)]); sum += c; cnt += (c > 0u) ? 1u : 0u; mine = (j == x) ? c : mine; }
        if (sum == G) break;
        __builtin_amdgcn_s_sleep(1);
        if ((++sp & 255u) == 0u) { if (xb_ld(&bar[XB_TMO])) break; if (sp > XB_SPIN_CAP) { atomicAdd(&bar[XB_TMO], 1u); break; } }
    }
    nloc = mine > 0u ? mine : 1u; nx = cnt > 0u ? cnt : 1u;
}
__device__ __forceinline__ void xcd_barrier(const XcdBarrier& b) {
    asm volatile("s_waitcnt vmcnt(0)" ::: "memory");
    __syncthreads();
    if (threadIdx.x == 0) {
        unsigned* bar = b.bar;
        __builtin_amdgcn_s_waitcnt(0);
        unsigned nloc = b.st[0], nx = b.st[1];
        if (nloc == 0u) { xcd_barrier_complete(bar, b.x, nloc, nx); b.st[0] = nloc; b.st[1] = nx; }
        const unsigned old = xb_add(&bar[XB_XSUB(b.x)], 1u);
        const unsigned gen = old / nloc;
        if (old + 1u == (gen + 1u) * nloc) {
            __builtin_amdgcn_fence(__ATOMIC_RELEASE, "agent");
            asm volatile("s_waitcnt vmcnt(0)" ::: "memory");
            const unsigned og = xb_add(&bar[XB_TOP], 1u);
            const unsigned tg = og / nx;
            if (og + 1u == (tg + 1u) * nx) xb_add(&bar[XB_TOPGEN], 1u);
            else XB_SPIN(xb_ld(&bar[XB_TOPGEN]) == tg, bar);
            __builtin_amdgcn_fence(__ATOMIC_ACQUIRE, "agent");
            xb_add(&bar[XB_XGEN(b.x)], 1u);
            asm volatile("s_waitcnt vmcnt(0)" ::: "memory");
        } else {
            XB_SPIN(xb_ld(&bar[XB_XGEN(b.x)]) == gen, bar);
            __builtin_amdgcn_fence(__ATOMIC_ACQUIRE, "agent");
            asm volatile("s_waitcnt vmcnt(0)" ::: "memory");
        }
    }
    __syncthreads();
}

struct Args { const float* in[23]; float* out; unsigned char* ws; int layer_lo, layer_hi, ph_lo, ph_hi, single, pad; };
struct Frame {
    LAS unsigned char* lds;
    int tid, lane, wave, vcu, G, gw, NGW, bid;
    unsigned char* ws;
};
enum { PH_PRE = 0, PH_CONV, PH_INPROJ, PH_MIXA, PH_MIXB, PH_WOUT, PH_NORM1, PH_XQ, PH_XATT, PH_XWO, PH_NORM2, PH_FFN1, PH_FFN2, PH_NORM3, PH_COUNT };

__device__ __forceinline__ void transpose_item64(const float* W, int K, int N, bf16* WT, int drow0, int k0, int n0, LAS unsigned* scr, int lane, const float* gk) {
    const int m = lane & 15, kp = lane >> 4;
    f32x4 va[8], vb[8];
#pragma unroll
    for (int i = 0; i < 8; ++i) { const float* p = W + (size_t)(k0 + 8 * i + 2 * kp) * N + n0 + 4 * m; va[i] = __builtin_nontemporal_load((const f32x4*)p); vb[i] = __builtin_nontemporal_load((const f32x4*)(p + N)); }
    if (gk) {
#pragma unroll
        for (int i = 0; i < 8; ++i) { const f32x2 g2 = *(const f32x2*)(gk + k0 + 8 * i + 2 * kp); va[i] = va[i] * g2.x; vb[i] = vb[i] * g2.y; } }
#pragma unroll
    for (int i = 0; i < 8; ++i)
#pragma unroll
        for (int j = 0; j < 4; ++j) scr[(4 * m + j) * 33 + 4 * i + kp] = cvt_pk_bf16(va[i][j], vb[i][j]);
    LDS_WAIT(); asm volatile("" ::: "memory");
    const int c = lane & 7;
#pragma unroll
    for (int jj = 0; jj < 8; ++jj) { const int n = (lane >> 3) + 8 * jj; const LAS unsigned* sp = scr + n * 33 + 4 * c;
        u32x4 o; o.x = sp[0]; o.y = sp[1]; o.z = sp[2]; o.w = sp[3];
        __builtin_nontemporal_store(o, (u32x4*)(WT + (size_t)(drow0 + n) * K + k0 + 8 * c)); }
    LDS_WAIT(); asm volatile("" ::: "memory");
}
__device__ __forceinline__ void colmax_pass(Frame& F, const float* W, int K, int N, const float* gk, float* cmax) {
    const int nblk = N / 256, items = (K / 128) * nblk;
    for (int it = F.gw; it < items; it += F.NGW) { const int kb = it / nblk, nb = it - kb * nblk; const float* p = W + (size_t)(kb * 128) * N + nb * 256 + 4 * F.lane;
        f32x4 mx = (f32x4){0.f, 0.f, 0.f, 0.f};
#pragma unroll 8
        for (int kk = 0; kk < 128; ++kk) { const f32x4 w = __builtin_nontemporal_load((const f32x4*)(p + (size_t)kk * N)); const float g = gk[kb * 128 + kk];
            mx.x = fmaxf(mx.x, fabsf(w.x * g)); mx.y = fmaxf(mx.y, fabsf(w.y * g)); mx.z = fmaxf(mx.z, fabsf(w.z * g)); mx.w = fmaxf(mx.w, fabsf(w.w * g)); }
        unsigned* cm = (unsigned*)(cmax + nb * 256 + 4 * F.lane);
        atomicMax(cm + 0, __float_as_uint(mx.x)); atomicMax(cm + 1, __float_as_uint(mx.y)); atomicMax(cm + 2, __float_as_uint(mx.z)); atomicMax(cm + 3, __float_as_uint(mx.w)); }
}
__device__ __forceinline__ unsigned q8(float x) { int v = (int)__builtin_rintf(x); v = v < -127 ? -127 : (v > 127 ? 127 : v); return (unsigned)v & 0xffu; }
__device__ __forceinline__ void transpose_item64_q(const float* W, int K, int N, signed char* WT, int drow0, int k0, int n0, LAS unsigned* scr, int lane, const float* gk, const float* cmax) {
    const int m = lane & 15, kp = lane >> 4;
    f32x4 va[4][4];
#pragma unroll
    for (int i = 0; i < 4; ++i)
#pragma unroll
        for (int kk = 0; kk < 4; ++kk) va[i][kk] = __builtin_nontemporal_load((const f32x4*)(W + (size_t)(k0 + 16 * i + 4 * kp + kk) * N + n0 + 4 * m));
    const f32x4 cm = *(const f32x4*)(cmax + n0 + 4 * m);
    f32x4 inv; inv.x = cm.x > 0.f ? 127.0f / cm.x : 0.f; inv.y = cm.y > 0.f ? 127.0f / cm.y : 0.f; inv.z = cm.z > 0.f ? 127.0f / cm.z : 0.f; inv.w = cm.w > 0.f ? 127.0f / cm.w : 0.f;
#pragma unroll
    for (int i = 0; i < 4; ++i) { const f32x4 g4 = *(const f32x4*)(gk + k0 + 16 * i + 4 * kp);
#pragma unroll
        for (int j = 0; j < 4; ++j) { const float sj = inv[j];
            scr[(4 * m + j) * 17 + 4 * i + kp] = q8(va[i][0][j] * g4.x * sj) | (q8(va[i][1][j] * g4.y * sj) << 8) | (q8(va[i][2][j] * g4.z * sj) << 16) | (q8(va[i][3][j] * g4.w * sj) << 24); } }
    LDS_WAIT(); asm volatile("" ::: "memory");
    const int c = lane & 3;
#pragma unroll
    for (int jj = 0; jj < 4; ++jj) { const int n = (lane >> 2) + 16 * jj; const LAS unsigned* sp = scr + n * 17 + 4 * c;
        u32x4 o; o.x = sp[0]; o.y = sp[1]; o.z = sp[2]; o.w = sp[3];
        __builtin_nontemporal_store(o, (u32x4*)(WT + (size_t)(drow0 + n) * K + k0 + 16 * c)); }
    LDS_WAIT(); asm volatile("" ::: "memory");
}
__device__ __forceinline__ void convert_matrix(Frame& F, const float* W, int K, int N, bf16* WT, int row_off, int mode, LAS unsigned* scr, const float* gk, const float* cmq) {
    const int nblk = N / 64, items = (K / 64) * nblk;
    for (int it = F.gw; it < items; it += F.NGW) {
        const int kb = it / nblk, nb = it % nblk, n0 = 64 * nb;
        const int drow0 = mode == 0 ? row_off + n0 : ((n0 >> 7) * 256 + (mode == 2 ? 128 : 0) + (n0 & 127));
        if (cmq) transpose_item64_q(W, K, N, (signed char*)WT, drow0, 64 * kb, n0, scr, F.lane, gk, cmq);
        else transpose_item64(W, K, N, WT, drow0, 64 * kb, n0, scr, F.lane, gk);
    }
}

constexpr int CV1 = 64 * 64, CV2 = CV1 + 64 * 16, CV3 = CV2 + 64 * 16, CV4 = CV3 + 64 * 16, CV5 = CV4 + 16 * 64, CV6 = CV5 + 64 * 172, CV7 = CV6 + 64 * 172, CV8 = CV7 + 172 * 64;
constexpr int CV9 = CV8 + 64 * 224;
constexpr int CV_PER_ITEM = 32, CV_ITEMS = CV8 / CV_PER_ITEM, CV_ITEMS_ALL = CV9 / CV_PER_ITEM, CV_P_ITEMS = CV5 / CV_PER_ITEM;
static_assert(CV8 % CV_PER_ITEM == 0 && CV5 % CV_PER_ITEM == 0 && CV9 % CV_PER_ITEM == 0, "conversion tiles per item");
struct ConvDst { bf16 *W_out, *W_q, *W_kv, *W_o, *W_gu, *W_dn, *W_in; const float* cmax; const float* cmin; };
__device__ __forceinline__ void convert_tile(const float* const* in_, int layer, int tt, const ConvDst& cd, LAS unsigned* scr, int lane) {
    struct { const float* const* p; __device__ __forceinline__ const float* operator[](int k) const { return (const float*)(GAS const float*)p[k]; } } in{in_};
    const float* W; const float* gk = nullptr; int K, N, row_off = 0, mode = 0, loc; bf16* WT;
    if (tt < CV1)      { W = in[10] + (size_t)layer * D * D;    K = D;   N = D;   WT = cd.W_out; loc = tt; }
    else if (tt < CV2) { W = in[13] + (size_t)layer * D * XW;   K = D;   N = XW;  WT = cd.W_q;  loc = tt - CV1; gk = in[12] + (size_t)layer * D; }
    else if (tt < CV3) { W = in[14] + (size_t)layer * D * XW;   K = D;   N = XW;  WT = cd.W_kv; loc = tt - CV2; }
    else if (tt < CV4) { W = in[15] + (size_t)layer * D * XW;   K = D;   N = XW;  WT = cd.W_kv; loc = tt - CV3; row_off = XW; }
    else if (tt < CV5) { W = in[16] + (size_t)layer * XW * D;   K = XW;  N = D;   WT = cd.W_o;  loc = tt - CV4; }
    else if (tt < CV6) { W = in[19] + (size_t)layer * D * FFH;  K = D;   N = FFH; WT = cd.W_gu; loc = tt - CV5; mode = 1; gk = in[18] + (size_t)layer * D; }
    else if (tt < CV7) { W = in[20] + (size_t)layer * D * FFH;  K = D;   N = FFH; WT = cd.W_gu; loc = tt - CV6; mode = 2; gk = in[18] + (size_t)layer * D; }
    else if (tt < CV8) { W = in[21] + (size_t)layer * FFH * D;  K = FFH; N = D;   WT = cd.W_dn; loc = tt - CV7; }
    else               { W = in[4] + (size_t)(layer + 1) * D * NPROJ; K = D; N = NPROJ; WT = cd.W_in; loc = tt - CV8; gk = in[3] + (size_t)(layer + 1) * D; }
    const int nblk = N / 64, kb = loc / nblk, nb = loc - kb * nblk, n0 = 64 * nb;
    const int drow0 = mode == 0 ? row_off + n0 : ((n0 >> 7) * 256 + (mode == 2 ? 128 : 0) + (n0 & 127));
    if (tt >= CV8) transpose_item64_q(W, K, N, (signed char*)WT, drow0, 64 * kb, n0, scr, lane, gk, cd.cmin + (size_t)(layer + 1) * NPROJ);
    else if (mode != 0) transpose_item64_q(W, K, N, (signed char*)WT, drow0, 64 * kb, n0, scr, lane, gk, cd.cmax + (size_t)layer * 2 * FFH + (mode == 2 ? FFH : 0));
    else transpose_item64(W, K, N, WT, drow0, 64 * kb, n0, scr, lane, gk);
}
__device__ __forceinline__ unsigned conv_next(unsigned* q, unsigned limit, unsigned* stopw, unsigned stopv) {
    if (stopw && __hip_atomic_load(stopw, __ATOMIC_RELAXED, __HIP_MEMORY_SCOPE_AGENT) >= stopv) return 0xffffffffu;
    if (__hip_atomic_load(q, __ATOMIC_RELAXED, __HIP_MEMORY_SCOPE_AGENT) >= limit) return 0xffffffffu;
    return __hip_atomic_fetch_add(q, 1u, __ATOMIC_RELAXED, __HIP_MEMORY_SCOPE_AGENT);
}
__device__ __forceinline__ void conv_pull(Frame& F, const float* const* in, int layer, unsigned* q, int limit, int count, const ConvDst& cd, volatile LAS unsigned* slot, unsigned* stopw, unsigned stopv) {
    LAS unsigned* scr = (LAS unsigned*)(F.lds + F.wave * 16384);
    __syncthreads();
    unsigned nxt = 0xffffffffu;
    if (F.tid == 0) {
        const unsigned sf_ = stopw ? __hip_atomic_load(stopw, __ATOMIC_RELAXED, __HIP_MEMORY_SCOPE_AGENT) : 0u;
        const unsigned qv_ = __hip_atomic_load(q, __ATOMIC_RELAXED, __HIP_MEMORY_SCOPE_AGENT);
        if (!(stopw && sf_ >= stopv) && qv_ < (unsigned)limit) nxt = __hip_atomic_fetch_add(q, 1u, __ATOMIC_RELAXED, __HIP_MEMORY_SCOPE_AGENT);
    }
    int par = 0;
    for (;;) {
        if (F.tid == 0) slot[par] = nxt;
        __syncthreads();
        const unsigned cur = slot[par]; par ^= 1;
        if (cur >= (unsigned)count) break;
        if (F.tid == 0) {
            if (limit < count) nxt = conv_next(q, (unsigned)limit, stopw, stopv);
            else if (stopw && __hip_atomic_load(stopw, __ATOMIC_RELAXED, __HIP_MEMORY_SCOPE_AGENT) >= stopv) nxt = 0xffffffffu;
            else nxt = __hip_atomic_fetch_add(q, 1u, __ATOMIC_RELAXED, __HIP_MEMORY_SCOPE_AGENT);
        }
        const int t0 = (int)cur * CV_PER_ITEM + F.wave * (CV_PER_ITEM / NWAVES);
#pragma unroll 1
        for (int e = 0; e < CV_PER_ITEM / NWAVES; ++e) convert_tile(in, layer, t0 + e, cd, scr, F.lane);
    }
}

__device__ __forceinline__ void rms_row_to_bf16(const float* xrow, const float* g, bf16* orow, int lane) {
    const f32x4* xr = (const f32x4*)xrow + lane; const f32x4* gr = (const f32x4*)g + lane;
    f32x4 v[16]; float s = 0.f;
#pragma unroll
    for (int j = 0; j < 16; ++j) { v[j] = xr[64 * j]; s += (v[j].x * v[j].x + v[j].y * v[j].y) + (v[j].z * v[j].z + v[j].w * v[j].w); }
    const float r = 1.0f / sqrtf(wave_sum(s) * (1.0f / D) + RMS_EPS);
    u32x2* o8 = (u32x2*)orow + lane;
#pragma unroll
    for (int j = 0; j < 16; ++j) { const f32x4 gg = gr[64 * j]; u32x2 w; w.x = cvt_pk_bf16(v[j].x * r * gg.x, v[j].y * r * gg.y); w.y = cvt_pk_bf16(v[j].z * r * gg.z, v[j].w * r * gg.w); o8[64 * j] = w; }
}
__device__ __forceinline__ void norm_phase(Frame& F, const bf16* tmp, const float* hin32, bf16* hb, float* out32, const float* gpost, float* rs_out) {
    LAS float* gl = (LAS float*)F.lds;
    __syncthreads();
    for (int i = F.tid; i < D / 4; i += NWAVES * 64) ((LAS f32x4*)gl)[i] = ((const f32x4*)gpost)[i];
    __syncthreads();
    for (int row0 = F.gw; row0 < M; row0 += 2 * F.NGW) {
        f32x4 v[2][16]; float s[2] = {0.f, 0.f};
#pragma unroll
        for (int rr = 0; rr < 2; ++rr) { const int row = row0 + rr * F.NGW; const u32x4* tr = (const u32x4*)(tmp + (size_t)row * D) + F.lane;
#pragma unroll
            for (int j = 0; j < 8; ++j) { const u32x4 w = __builtin_nontemporal_load(tr + 64 * j);
                v[rr][2 * j] = (f32x4){bflo(w.x), bfhi(w.x), bflo(w.y), bfhi(w.y)}; v[rr][2 * j + 1] = (f32x4){bflo(w.z), bfhi(w.z), bflo(w.w), bfhi(w.w)}; }
        }
#pragma unroll
        for (int rr = 0; rr < 2; ++rr)
#pragma unroll
            for (int j = 0; j < 16; ++j) s[rr] += (v[rr][j].x * v[rr][j].x + v[rr][j].y * v[rr][j].y) + (v[rr][j].z * v[rr][j].z + v[rr][j].w * v[rr][j].w);
#pragma unroll
        for (int o = 1; o < 64; o <<= 1) { s[0] += __shfl_xor(s[0], o); s[1] += __shfl_xor(s[1], o); }
        float s2[2] = {0.f, 0.f};
#pragma unroll
        for (int rr = 0; rr < 2; ++rr) { const int row = row0 + rr * F.NGW; const float r = 1.0f / sqrtf(s[rr] * (1.0f / D) + RMS_EPS);
            u32x4* hbr = (u32x4*)(hb + (size_t)row * D) + F.lane;
            u32x4 hw[8];
            if (!hin32) {
#pragma unroll
                for (int j = 0; j < 8; ++j) hw[j] = __builtin_nontemporal_load(hbr + 64 * j); }
            asm volatile("" ::: "memory");
#pragma unroll
            for (int j = 0; j < 8; ++j) { const int off = 8 * F.lane + 512 * j;
                f32x4 h0, h1;
                if (hin32) { h0 = *(const f32x4*)(hin32 + (size_t)row * D + off); h1 = *(const f32x4*)(hin32 + (size_t)row * D + off + 4); }
                else { const u32x4 w = hw[j]; h0 = (f32x4){bflo(w.x), bfhi(w.x), bflo(w.y), bfhi(w.y)}; h1 = (f32x4){bflo(w.z), bfhi(w.z), bflo(w.w), bfhi(w.w)}; }
                const f32x4 g0 = *(const LAS f32x4*)(gl + off), g1 = *(const LAS f32x4*)(gl + off + 4);
                h0 = h0 + v[rr][2 * j] * r * g0; h1 = h1 + v[rr][2 * j + 1] * r * g1;
                s2[rr] += (h0.x * h0.x + h0.y * h0.y) + (h0.z * h0.z + h0.w * h0.w) + (h1.x * h1.x + h1.y * h1.y) + (h1.z * h1.z + h1.w * h1.w);
                if (out32) { *(f32x4*)(out32 + (size_t)row * D + off) = h0; *(f32x4*)(out32 + (size_t)row * D + off + 4) = h1; }
                else { u32x4 w; w.x = cvt_pk_bf16(h0.x, h0.y); w.y = cvt_pk_bf16(h0.z, h0.w); w.z = cvt_pk_bf16(h1.x, h1.y); w.w = cvt_pk_bf16(h1.z, h1.w); hbr[64 * j] = w; } } }
        if (rs_out) {
#pragma unroll
            for (int o = 1; o < 64; o <<= 1) { s2[0] += __shfl_xor(s2[0], o); s2[1] += __shfl_xor(s2[1], o); }
            if (F.lane == 0) { rs_out[row0] = 1.0f / sqrtf(s2[0] * (1.0f / D) + RMS_EPS); rs_out[row0 + F.NGW] = 1.0f / sqrtf(s2[1] * (1.0f / D) + RMS_EPS); }
        }
    }
}
__device__ __forceinline__ void norm_phase_q(Frame& F, const bf16* tmp, bf16* hb, const float* gpost, signed char* hq, float* rq, float* rs_out) {
    LAS float* gl = (LAS float*)F.lds;
    __syncthreads();
    for (int i = F.tid; i < D / 4; i += NWAVES * 64) ((LAS f32x4*)gl)[i] = ((const f32x4*)gpost)[i];
    __syncthreads();
    for (int row0 = F.gw; row0 < M; row0 += 2 * F.NGW) {
        f32x4 v[2][16]; float s[2] = {0.f, 0.f};
#pragma unroll
        for (int rr = 0; rr < 2; ++rr) { const int row = row0 + rr * F.NGW; const u32x4* tr = (const u32x4*)(tmp + (size_t)row * D) + F.lane;
#pragma unroll
            for (int j = 0; j < 8; ++j) { const u32x4 w = __builtin_nontemporal_load(tr + 64 * j);
                v[rr][2 * j] = (f32x4){bflo(w.x), bfhi(w.x), bflo(w.y), bfhi(w.y)}; v[rr][2 * j + 1] = (f32x4){bflo(w.z), bfhi(w.z), bflo(w.w), bfhi(w.w)}; }
        }
#pragma unroll
        for (int rr = 0; rr < 2; ++rr)
#pragma unroll
            for (int j = 0; j < 16; ++j) s[rr] += (v[rr][j].x * v[rr][j].x + v[rr][j].y * v[rr][j].y) + (v[rr][j].z * v[rr][j].z + v[rr][j].w * v[rr][j].w);
#pragma unroll
        for (int o = 1; o < 64; o <<= 1) { s[0] += __shfl_xor(s[0], o); s[1] += __shfl_xor(s[1], o); }
        float s2[2] = {0.f, 0.f}, am[2] = {0.f, 0.f};
#pragma unroll
        for (int rr = 0; rr < 2; ++rr) { const int row = row0 + rr * F.NGW; const float r = 1.0f / sqrtf(s[rr] * (1.0f / D) + RMS_EPS);
            u32x4* hbr = (u32x4*)(hb + (size_t)row * D) + F.lane;
            u32x4 hw[8];
#pragma unroll
            for (int j = 0; j < 8; ++j) hw[j] = __builtin_nontemporal_load(hbr + 64 * j);
            asm volatile("" ::: "memory");
#pragma unroll
            for (int j = 0; j < 8; ++j) { const int off = 8 * F.lane + 512 * j;
                const u32x4 w = hw[j]; f32x4 h0 = (f32x4){bflo(w.x), bfhi(w.x), bflo(w.y), bfhi(w.y)}, h1 = (f32x4){bflo(w.z), bfhi(w.z), bflo(w.w), bfhi(w.w)};
                const f32x4 g0 = *(const LAS f32x4*)(gl + off), g1 = *(const LAS f32x4*)(gl + off + 4);
                h0 = h0 + v[rr][2 * j] * r * g0; h1 = h1 + v[rr][2 * j + 1] * r * g1;
                s2[rr] += (h0.x * h0.x + h0.y * h0.y) + (h0.z * h0.z + h0.w * h0.w) + (h1.x * h1.x + h1.y * h1.y) + (h1.z * h1.z + h1.w * h1.w);
                am[rr] = fmaxf(am[rr], fmaxf(fmaxf(fmaxf(fabsf(h0.x), fabsf(h0.y)), fmaxf(fabsf(h0.z), fabsf(h0.w))), fmaxf(fmaxf(fabsf(h1.x), fabsf(h1.y)), fmaxf(fabsf(h1.z), fabsf(h1.w)))));
                v[rr][2 * j] = h0; v[rr][2 * j + 1] = h1;
                u32x4 wo; wo.x = cvt_pk_bf16(h0.x, h0.y); wo.y = cvt_pk_bf16(h0.z, h0.w); wo.z = cvt_pk_bf16(h1.x, h1.y); wo.w = cvt_pk_bf16(h1.z, h1.w); hbr[64 * j] = wo; } }
#pragma unroll
        for (int o = 1; o < 64; o <<= 1) { s2[0] += __shfl_xor(s2[0], o); s2[1] += __shfl_xor(s2[1], o); am[0] = fmaxf(am[0], __shfl_xor(am[0], o)); am[1] = fmaxf(am[1], __shfl_xor(am[1], o)); }
#pragma unroll
        for (int rr = 0; rr < 2; ++rr) { const int row = row0 + rr * F.NGW; const float inv = am[rr] > 0.f ? 127.0f / am[rr] : 0.f;
            u32x2* qo = (u32x2*)(hq + (size_t)row * D) + F.lane;
#pragma unroll
            for (int j = 0; j < 8; ++j) { const f32x4 a = v[rr][2 * j] * inv, bq = v[rr][2 * j + 1] * inv;
                u32x2 w; w.x = q8(a.x) | (q8(a.y) << 8) | (q8(a.z) << 16) | (q8(a.w) << 24); w.y = q8(bq.x) | (q8(bq.y) << 8) | (q8(bq.z) << 16) | (q8(bq.w) << 24); qo[64 * j] = w; }
            if (F.lane == 0) { const float rsn = 1.0f / sqrtf(s2[rr] * (1.0f / D) + RMS_EPS); rq[row] = rsn * am[rr] * (1.0f / 127.0f); if (rs_out) rs_out[row] = rsn; } }
    }
}
__device__ __forceinline__ void x_to_stream(Frame& F, const float* x, bf16* hb, float* rs_out) {
    for (int row = F.gw; row < M; row += F.NGW) {
        float s2 = 0.f;
#pragma unroll
        for (int j = 0; j < 8; ++j) { const int off = 8 * F.lane + 512 * j; const f32x4 h0 = *(const f32x4*)(x + (size_t)row * D + off), h1 = *(const f32x4*)(x + (size_t)row * D + off + 4);
            s2 += (h0.x * h0.x + h0.y * h0.y) + (h0.z * h0.z + h0.w * h0.w) + (h1.x * h1.x + h1.y * h1.y) + (h1.z * h1.z + h1.w * h1.w);
            u32x4 w; w.x = cvt_pk_bf16(h0.x, h0.y); w.y = cvt_pk_bf16(h0.z, h0.w); w.z = cvt_pk_bf16(h1.x, h1.y); w.w = cvt_pk_bf16(h1.z, h1.w); *((u32x4*)(hb + (size_t)row * D + off)) = w; }
        s2 = wave_sum(s2);
        if (F.lane == 0) rs_out[row] = 1.0f / sqrtf(s2 * (1.0f / D) + RMS_EPS);
    }
}

template <int MT, int NT, bool TR>
__device__ __forceinline__ void wave_mma(f32x4 (&acc)[MT][NT], const LAS bf16* A, int lda, const LAS bf16* Bm, int ldb, int K, int lane) {
    const int r = lane & 15, q = lane >> 4;
    for (int k0 = 0; k0 < K; k0 += 32) {
        bf16x8 a[MT], b[NT];
#pragma unroll
        for (int mt = 0; mt < MT; ++mt) a[mt] = *(const LAS bf16x8*)(A + (mt * 16 + r) * lda + k0 + 8 * q);
#pragma unroll
        for (int nt = 0; nt < NT; ++nt) b[nt] = *(const LAS bf16x8*)(Bm + (nt * 16 + r) * ldb + k0 + 8 * q);
#pragma unroll
        for (int mt = 0; mt < MT; ++mt)
#pragma unroll
            for (int nt = 0; nt < NT; ++nt)
                acc[mt][nt] = TR ? __builtin_amdgcn_mfma_f32_16x16x32_bf16(b[nt], a[mt], acc[mt][nt], 0, 0, 0) : __builtin_amdgcn_mfma_f32_16x16x32_bf16(a[mt], b[nt], acc[mt][nt], 0, 0, 0);
    }
}
__device__ __forceinline__ void stage_tile(LAS bf16* dst, int lld, const bf16* src, size_t gld, int rows, int cols, int tid) {
    const int cpr = cols >> 3, total = rows * cpr;
    for (int i = tid; i < total; i += NWAVES * 64) { const int r = i / cpr, c = i - r * cpr; *(LAS u32x4*)(dst + r * lld + c * 8) = *(const u32x4*)(src + (size_t)r * gld + c * 8); }
}
__device__ __forceinline__ void stage_tile_tr(LAS bf16* dst, int lld, const bf16* src, size_t gld, int rows, int cols, int tid) {
    const int cpr = cols >> 3, total = rows * cpr;
    for (int i = tid; i < total; i += NWAVES * 64) { const int c = i / rows, r = i - c * rows; const u32x4 v = *(const u32x4*)(src + (size_t)r * gld + c * 8);
        LAS bf16* d = dst + (c * 8) * lld + r;
        d[0] = (bf16)(v.x & 0xffff); d[lld] = (bf16)(v.x >> 16); d[2 * lld] = (bf16)(v.y & 0xffff); d[3 * lld] = (bf16)(v.y >> 16);
        d[4 * lld] = (bf16)(v.z & 0xffff); d[5 * lld] = (bf16)(v.z >> 16); d[6 * lld] = (bf16)(v.w & 0xffff); d[7 * lld] = (bf16)(v.w >> 16); }
}

struct NoScale { __device__ __forceinline__ float operator()(int) const { return 1.0f; } static constexpr bool ON = false; };
struct Exp2Scale { float a, b; static constexpr bool ON = true; __device__ __forceinline__ float operator()(int r) const { return exp2f(a + b * (float)r); } };
template <class RS>
__device__ __forceinline__ void stage_tile_tr2(LAS bf16* dst, int lld, const bf16* src, size_t gld, int rows, int cols, int tid, const RS& sc) {
    const int hp = rows >> 1, total = hp * (cols >> 3), ls = lld >> 1;
    for (int i = tid; i < total; i += NWAVES * 64) { const int rp = i % hp, c8 = i / hp;
        const u32x4 a = *(const u32x4*)(src + (size_t)(2 * rp) * gld + c8 * 8), b = *(const u32x4*)(src + (size_t)(2 * rp + 1) * gld + c8 * 8);
        LAS unsigned* d = (LAS unsigned*)(dst + (c8 * 8) * lld + 2 * rp);
        if (RS::ON) { const float s0 = sc(2 * rp), s1 = sc(2 * rp + 1);
            d[0 * ls] = cvt_pk_bf16(bflo(a.x) * s0, bflo(b.x) * s1); d[1 * ls] = cvt_pk_bf16(bfhi(a.x) * s0, bfhi(b.x) * s1);
            d[2 * ls] = cvt_pk_bf16(bflo(a.y) * s0, bflo(b.y) * s1); d[3 * ls] = cvt_pk_bf16(bfhi(a.y) * s0, bfhi(b.y) * s1);
            d[4 * ls] = cvt_pk_bf16(bflo(a.z) * s0, bflo(b.z) * s1); d[5 * ls] = cvt_pk_bf16(bfhi(a.z) * s0, bfhi(b.z) * s1);
            d[6 * ls] = cvt_pk_bf16(bflo(a.w) * s0, bflo(b.w) * s1); d[7 * ls] = cvt_pk_bf16(bfhi(a.w) * s0, bfhi(b.w) * s1);
        } else {
            d[0 * ls] = (a.x & 0xffffu) | (b.x << 16); d[1 * ls] = (a.x >> 16) | (b.x & 0xffff0000u);
            d[2 * ls] = (a.y & 0xffffu) | (b.y << 16); d[3 * ls] = (a.y >> 16) | (b.y & 0xffff0000u);
            d[4 * ls] = (a.z & 0xffffu) | (b.z << 16); d[5 * ls] = (a.z >> 16) | (b.z & 0xffff0000u);
            d[6 * ls] = (a.w & 0xffffu) | (b.w << 16); d[7 * ls] = (a.w >> 16) | (b.w & 0xffff0000u);
        } }
}

typedef short s16x4 __attribute__((ext_vector_type(4)));
__device__ __forceinline__ bf16x8 tr_frag(const LAS bf16* base, int pitch, int lane) {
    const int g = lane >> 4, q = (lane >> 2) & 3, p = lane & 3;
    const LAS bf16* a = base + (8 * g + q) * pitch + 4 * p;
    const s16x4 lo = __builtin_amdgcn_ds_read_tr16_b64_v4i16((LAS s16x4*)a);
    const s16x4 hi = __builtin_amdgcn_ds_read_tr16_b64_v4i16((LAS s16x4*)(a + 4 * pitch));
    return __builtin_shufflevector(lo, hi, 0, 1, 2, 3, 4, 5, 6, 7);
}
template <int MT, int NT, bool TR, bool AT, bool BT>
__device__ __forceinline__ void wave_mma_g(f32x4 (&acc)[MT][NT], const LAS bf16* A, int lda, const LAS bf16* Bm, int ldb, int K, int lane) {
    const int r = lane & 15, q = lane >> 4;
    for (int k0 = 0; k0 < K; k0 += 32) {
        bf16x8 a[MT], b[NT];
#pragma unroll
        for (int mt = 0; mt < MT; ++mt) { if (AT) a[mt] = tr_frag(A + k0 * lda + 16 * mt, lda, lane); else a[mt] = *(const LAS bf16x8*)(A + (mt * 16 + r) * lda + k0 + 8 * q); }
#pragma unroll
        for (int nt = 0; nt < NT; ++nt) { if (BT) b[nt] = tr_frag(Bm + k0 * ldb + 16 * nt, ldb, lane); else b[nt] = *(const LAS bf16x8*)(Bm + (nt * 16 + r) * ldb + k0 + 8 * q); }
#pragma unroll
        for (int mt = 0; mt < MT; ++mt)
#pragma unroll
            for (int nt = 0; nt < NT; ++nt)
                acc[mt][nt] = TR ? __builtin_amdgcn_mfma_f32_16x16x32_bf16(b[nt], a[mt], acc[mt][nt], 0, 0, 0) : __builtin_amdgcn_mfma_f32_16x16x32_bf16(a[mt], b[nt], acc[mt][nt], 0, 0, 0);
    }
}
template <int N> struct Pf { u32x4 r[N]; };
template <int N, int CPR> __device__ __forceinline__ void pf_load(Pf<N>& p, const bf16* src, size_t gld, int tid) {
#pragma unroll
    for (int it = 0; it < N; ++it) { const int i = tid + NWAVES * 64 * it; p.r[it] = *(const u32x4*)(src + (size_t)(i / CPR) * gld + (i % CPR) * 8); }
}
template <int N, int CPR> __device__ __forceinline__ void pf_store(LAS bf16* dst, int lld, int tid, const Pf<N>& p) {
#pragma unroll
    for (int it = 0; it < N; ++it) { const int i = tid + NWAVES * 64 * it; *(LAS u32x4*)(dst + (i / CPR) * lld + (i % CPR) * 8) = p.r[it]; }
}
__device__ __forceinline__ u32x4 scale_bf16x8(u32x4 v, float s) {
    u32x4 o; o.x = cvt_pk_bf16(bflo(v.x) * s, bfhi(v.x) * s); o.y = cvt_pk_bf16(bflo(v.y) * s, bfhi(v.y) * s); o.z = cvt_pk_bf16(bflo(v.z) * s, bfhi(v.z) * s); o.w = cvt_pk_bf16(bflo(v.w) * s, bfhi(v.w) * s); return o;
}

struct RsCtx { const bf16* proj; bf16* st; LAS bf16* kt; LAS bf16* vt; int b, h, bh, dir, e0; float l2g, gC; };
__device__ __forceinline__ void rs_load(Pf<8>& pk, Pf<2>& pv, const RsCtx& c, int ci, int tid) {
    const int ch = c.dir ? 31 - ci : ci; const bf16* rowp = c.proj + (size_t)(c.b * SEQ + ch * 128) * NPROJ;
    pf_load<8, 32>(pk, rowp + C_RK + c.h * RD, NPROJ, tid); pf_load<2, 8>(pv, rowp + C_RV + c.h * RD + c.e0, NPROJ, tid);
}
__device__ __forceinline__ void rs_step(Frame& F, f32x4 (&acc)[4][2], Pf<8>& pk, Pf<2>& pv, const RsCtx& c, int ci) {
    const int r = F.lane & 15, q = F.lane >> 4;
    const int ch = c.dir ? 31 - ci : ci;
    bf16* sp = c.st + ((((size_t)(c.bh * 2 + c.dir) * 32 + ch) * 256 + c.e0) * 256) + 32 * F.wave + 4 * q;
#pragma unroll
    for (int mt = 0; mt < 4; ++mt)
#pragma unroll
        for (int nt = 0; nt < 2; ++nt) { u32x2 w; w.x = cvt_pk_bf16(acc[mt][nt][0], acc[mt][nt][1]); w.y = cvt_pk_bf16(acc[mt][nt][2], acc[mt][nt][3]);
            *(u32x2*)(sp + (size_t)(16 * mt + r) * 256 + 16 * nt) = w; }
    __syncthreads();
    pf_store<8, 32>(c.kt, 272, F.tid, pk);
#pragma unroll
    for (int it = 0; it < 2; ++it) { const int i = F.tid + NWAVES * 64 * it, row = i >> 3;
        const float sc = exp2f(c.l2g * (float)(c.dir ? row : 127 - row)); *(LAS u32x4*)(c.vt + row * 80 + (i & 7) * 8) = scale_bf16x8(pv.r[it], sc); }
    __syncthreads();
    if (ci + 2 < 32) rs_load(pk, pv, c, ci + 2, F.tid);
#pragma unroll
    for (int mt = 0; mt < 4; ++mt)
#pragma unroll
        for (int nt = 0; nt < 2; ++nt) acc[mt][nt] = acc[mt][nt] * c.gC;
    wave_mma_g<4, 2, true, true, true>(acc, c.vt, 80, c.kt + 32 * F.wave, 272, 128, F.lane);
}
__device__ __forceinline__ void ret_state_pass(Frame& F, int first, int stride, const bf16* proj, bf16* st) {
    for (int item = first; item < 128; item += stride) {
        RsCtx c; c.proj = proj; c.st = st; c.kt = (LAS bf16*)F.lds; c.vt = c.kt + 128 * 272;
        const int es = item & 3; c.dir = (item >> 2) & 1; c.bh = item >> 3; c.b = c.bh >> 3; c.h = c.bh & 7; c.e0 = es * 64;
        const int hg = c.dir ? (7 - c.h) : c.h; const float gam = 1.0f - exp2f(-5.0f - (float)hg); c.l2g = log2f(gam); c.gC = exp2f(128.0f * c.l2g);
        f32x4 acc[4][2];
#pragma unroll
        for (int mt = 0; mt < 4; ++mt)
#pragma unroll
            for (int nt = 0; nt < 2; ++nt) acc[mt][nt] = (f32x4){0.f, 0.f, 0.f, 0.f};
        Pf<8> pkA, pkB; Pf<2> pvA, pvB;
        rs_load(pkA, pvA, c, 0, F.tid); rs_load(pkB, pvB, c, 1, F.tid);
        for (int ci = 0; ci < 32; ci += 2) { rs_step(F, acc, pkA, pvA, c, ci); rs_step(F, acc, pkB, pvB, c, ci + 1); }
    }
    __syncthreads();
}
struct RoCtx { const bf16* kbase; const bf16* vbase; const bf16* stf; const bf16* stb; };
template <int S> __device__ __forceinline__ void ro_issue(Pf<4>& pa, Pf<2>& pv, const RoCtx& c, int tid) {
    if constexpr (S < 2) pf_load<4, 32>(pa, c.kbase + (size_t)(64 * S) * NPROJ, NPROJ, tid);
    else if constexpr (S < 14) { constexpr int es = (S - 2) / 3, kind = (S - 2) % 3;
        if constexpr (kind == 0) pf_load<4, 32>(pa, c.stf + (size_t)(64 * es) * 256, 256, tid);
        else if constexpr (kind == 1) pf_load<4, 32>(pa, c.stb + (size_t)(64 * es) * 256, 256, tid);
        else pf_load<2, 8>(pv, c.vbase + 64 * es, NPROJ, tid); }
}
template <int S> __device__ __forceinline__ void ro_round(Frame& F, Pf<4>& pa, Pf<2>& pv, const RoCtx& c, LAS bf16* qs, LAS bf16* ps, LAS bf16* bs, f32x4 (&o)[4][1][4], int n, float l2f, float l2b, float qdf, float qdb) {
    const int q = F.lane >> 4;
    __syncthreads();
    if constexpr (S < 2 || (S - 2) % 3 != 2) pf_store<4, 32>(bs, 264, F.tid, pa); else pf_store<2, 8>(bs, 80, F.tid, pv);
    __syncthreads();
    ro_issue<S + 1>(pa, pv, c, F.tid);
    if constexpr (S < 2) {
        f32x4 s[1][4];
#pragma unroll
        for (int nt = 0; nt < 4; ++nt) s[0][nt] = (f32x4){0.f, 0.f, 0.f, 0.f};
        wave_mma<1, 4, true>(s, qs + F.wave * 16 * 264, 264, bs, 264, 256, F.lane);
#pragma unroll
        for (int nt = 0; nt < 4; ++nt) { float p[4];
#pragma unroll
            for (int j = 0; j < 4; ++j) { const int mkey = 64 * S + 16 * nt + 4 * q + j; const int dist = n - mkey;
                const float w = dist >= 0 ? exp2f((float)dist * l2f) : exp2f((float)(-dist) * l2b); p[j] = s[0][nt][j] * w; }
            u32x2 w2; w2.x = cvt_pk_bf16(p[0], p[1]); w2.y = cvt_pk_bf16(p[2], p[3]);
            *(LAS u32x2*)(ps + n * 136 + 64 * S + 16 * nt + 4 * q) = w2; }
    } else { constexpr int es = (S - 2) / 3, kind = (S - 2) % 3;
        if constexpr (kind < 2) {
            f32x4 t[1][4];
#pragma unroll
            for (int nt = 0; nt < 4; ++nt) t[0][nt] = (f32x4){0.f, 0.f, 0.f, 0.f};
            wave_mma<1, 4, true>(t, qs + F.wave * 16 * 264, 264, bs, 264, 256, F.lane);
#pragma unroll
            for (int nt = 0; nt < 4; ++nt) { if constexpr (kind == 0) o[es][0][nt] = t[0][nt] * qdf; else o[es][0][nt] = o[es][0][nt] + t[0][nt] * qdb; }
        } else {
            wave_mma_g<1, 4, true, false, true>(o[es], ps + F.wave * 16 * 136, 136, bs, 80, 128, F.lane);
        }
    }
}
__device__ __forceinline__ void ret_output_pass(Frame& F, int first, int stride, const bf16* proj, const bf16* st, const float* rng, bf16* mixin) {
    LAS bf16* qs = (LAS bf16*)F.lds;
    LAS bf16* ps = qs + 128 * 264;
    LAS bf16* bs = ps + 128 * 136;
    const int r = F.lane & 15, q = F.lane >> 4;
    for (int item = first; item < 512; item += stride) {
        const int ch = item & 31, bh = item >> 5, b = bh >> 3, h = bh & 7;
        const float l2f = log2f(1.0f - exp2f(-5.0f - (float)h)), l2b = log2f(1.0f - exp2f(-5.0f - (float)(7 - h)));
        const size_t row0 = (size_t)b * SEQ + ch * 128;
        const int n = 16 * F.wave + r;
        RoCtx c; c.kbase = proj + row0 * NPROJ + C_RK + h * RD; c.vbase = proj + row0 * NPROJ + C_RV + h * RD;
        c.stf = st + (((size_t)(bh * 2 + 0) * 32 + ch) * 256) * 256; c.stb = st + (((size_t)(bh * 2 + 1) * 32 + ch) * 256) * 256;
        Pf<4> pa; Pf<2> pv;
        ro_issue<0>(pa, pv, c, F.tid);
        __syncthreads();
        stage_tile(qs, 264, proj + row0 * NPROJ + C_RQ + h * RD, NPROJ, 128, 256, F.tid);
        const float qdf = exp2f((float)(n + 1) * l2f), qdb = exp2f((float)(128 - n) * l2b);
        f32x4 o[4][1][4];
        ro_round<0>(F, pa, pv, c, qs, ps, bs, o, n, l2f, l2b, qdf, qdb); ro_round<1>(F, pa, pv, c, qs, ps, bs, o, n, l2f, l2b, qdf, qdb);
        ro_round<2>(F, pa, pv, c, qs, ps, bs, o, n, l2f, l2b, qdf, qdb); ro_round<3>(F, pa, pv, c, qs, ps, bs, o, n, l2f, l2b, qdf, qdb); ro_round<4>(F, pa, pv, c, qs, ps, bs, o, n, l2f, l2b, qdf, qdb);
        ro_round<5>(F, pa, pv, c, qs, ps, bs, o, n, l2f, l2b, qdf, qdb); ro_round<6>(F, pa, pv, c, qs, ps, bs, o, n, l2f, l2b, qdf, qdb); ro_round<7>(F, pa, pv, c, qs, ps, bs, o, n, l2f, l2b, qdf, qdb);
        ro_round<8>(F, pa, pv, c, qs, ps, bs, o, n, l2f, l2b, qdf, qdb); ro_round<9>(F, pa, pv, c, qs, ps, bs, o, n, l2f, l2b, qdf, qdb); ro_round<10>(F, pa, pv, c, qs, ps, bs, o, n, l2f, l2b, qdf, qdb);
        ro_round<11>(F, pa, pv, c, qs, ps, bs, o, n, l2f, l2b, qdf, qdb); ro_round<12>(F, pa, pv, c, qs, ps, bs, o, n, l2f, l2b, qdf, qdb); ro_round<13>(F, pa, pv, c, qs, ps, bs, o, n, l2f, l2b, qdf, qdb);
        float sm = 0.f;
#pragma unroll
        for (int es = 0; es < 4; ++es)
#pragma unroll
            for (int nt = 0; nt < 4; ++nt) sm += (o[es][0][nt][0] + o[es][0][nt][1]) + (o[es][0][nt][2] + o[es][0][nt][3]);
        sm += __shfl_xor(sm, 16); sm += __shfl_xor(sm, 32);
        const float mu = sm * (1.0f / RD); float sv = 0.f;
#pragma unroll
        for (int es = 0; es < 4; ++es)
#pragma unroll
            for (int nt = 0; nt < 4; ++nt) { const f32x4 dvv = o[es][0][nt] - mu; o[es][0][nt] = dvv; sv += (dvv[0] * dvv[0] + dvv[1] * dvv[1]) + (dvv[2] * dvv[2] + dvv[3] * dvv[3]); }
        sv += __shfl_xor(sv, 16); sv += __shfl_xor(sv, 32);
        const float rs = 1.0f / sqrtf(sv * (1.0f / RD) + GN_EPS);
        const bf16* gp = proj + (row0 + n) * NPROJ + C_RG + h * RD + 4 * q; bf16* op = mixin + (row0 + n) * D + h * RD + 4 * q; const float* gg = rng + h * RD + 4 * q;
#pragma unroll
        for (int es = 0; es < 4; ++es)
#pragma unroll
            for (int nt = 0; nt < 4; ++nt) { const int e = 64 * es + 16 * nt; const u32x2 gt = *(const u32x2*)(gp + e); const f32x4 g4 = *(const f32x4*)(gg + e);
                const f32x4 v = o[es][0][nt] * rs * g4;
                u32x2 w; w.x = cvt_pk_bf16(v[0] * silu_f(bflo(gt.x)), v[1] * silu_f(bfhi(gt.x))); w.y = cvt_pk_bf16(v[2] * silu_f(bflo(gt.y)), v[3] * silu_f(bfhi(gt.y)));
                *(u32x2*)(op + e) = w; }
    }
    __syncthreads();
}

__device__ __forceinline__ float hgrn_lb(const float* lblog, int layer, int dir, int col) {
    if (layer == 0) return 0.f;
    float mx = -1e30f;
    for (int l = 0; l < NL; ++l) mx = fmaxf(mx, lblog[(l * 2 + dir) * HW + col]);
    float den = 0.f, num = 0.f;
    for (int l = 0; l < NL; ++l) { const float ev = __expf(lblog[(l * 2 + dir) * HW + col] - mx); den += ev; if (l >= 1 && l <= layer) num += ev; }
    return num / den;
}
constexpr int HSB = 4;
struct HsCtx { const bf16* proj; const float* gatez; bf16* hst; LAS bf16* kpt; LAS bf16* vt; LAS float* tot; LAS float* adec; int b, h, bh, dir, d0, d, sg; float lb; };
__device__ __forceinline__ void hs_load(float (&zr)[HSB][4], Pf<2> (&pv)[HSB], const HsCtx& c, int cg, int tid) {
#pragma unroll
    for (int cb = 0; cb < HSB; ++cb) { const int ci = cg * HSB + cb, ch = c.dir ? 63 - ci : ci; const size_t row0 = (size_t)c.b * SEQ + ch * 64;
        const bf16* zp = c.proj + (row0 + 4 * c.sg) * NPROJ + C_HFF + c.dir * HW + c.h * HD + c.d0 + c.d;
#pragma unroll
        for (int ii = 0; ii < 4; ++ii) zr[cb][ii] = bf2f(zp[(size_t)ii * NPROJ]);
        pf_load<2, 16>(pv[cb], c.proj + row0 * NPROJ + C_HI + c.h * HD, NPROJ, tid); }
}
__device__ __forceinline__ void hs_step(Frame& F, f32x4 (&acc)[1][2], float (&zr)[HSB][4], Pf<2> (&pv)[HSB], const HsCtx& c, int cg) {
    const int r = F.lane & 15, q = F.lane >> 4, d = c.d, sg = c.sg, dir = c.dir;
    float lf[HSB][4], kk[HSB][4], mytot[HSB];
#pragma unroll
    for (int cb = 0; cb < HSB; ++cb) {
#pragma unroll
        for (int ii = 0; ii < 4; ++ii) { const float f = c.lb + (1.0f - c.lb) * fast_sigmoid(zr[cb][ii]); lf[cb][ii] = __logf(f); kk[cb][ii] = 1.0f - f; }
        if (dir == 0) { lf[cb][1] += lf[cb][0]; lf[cb][2] += lf[cb][1]; lf[cb][3] += lf[cb][2]; } else { lf[cb][2] += lf[cb][3]; lf[cb][1] += lf[cb][2]; lf[cb][0] += lf[cb][1]; }
        mytot[cb] = dir == 0 ? lf[cb][3] : lf[cb][0]; }
    __syncthreads();
#pragma unroll
    for (int cb = 0; cb < HSB; ++cb) { c.tot[cb * 512 + sg * 32 + d] = mytot[cb]; pf_store<2, 16>(c.vt + cb * 64 * 144, 144, F.tid, pv[cb]); }
    __syncthreads();
    if (cg + 2 < 64 / HSB) hs_load(zr, pv, c, cg + 2, F.tid);
#pragma unroll
    for (int cb = 0; cb < HSB; ++cb) {
        float other = 0.f, all = 0.f;
#pragma unroll
        for (int g = 0; g < 16; ++g) { const float tv = c.tot[cb * 512 + g * 32 + d]; all += tv; if (dir == 0 ? (g < sg) : (g > sg)) other += tv; }
        float kv[4];
#pragma unroll
        for (int ii = 0; ii < 4; ++ii) kv[ii] = kk[cb][ii] * __expf(all - (lf[cb][ii] + other));
        { u32x2 w; w.x = cvt_pk_bf16(kv[0], kv[1]); w.y = cvt_pk_bf16(kv[2], kv[3]); *(LAS u32x2*)(c.kpt + cb * 32 * 72 + d * 72 + 4 * sg) = w; }
        if (sg == 0) c.adec[cb * 32 + d] = __expf(all); }
    __syncthreads();
#pragma unroll
    for (int cb = 0; cb < HSB; ++cb) { const int ci = cg * HSB + cb, ch = dir ? 63 - ci : ci;
#pragma unroll
        for (int nt = 0; nt < 2; ++nt) { u32x2 w; w.x = cvt_pk_bf16(acc[0][nt][0], acc[0][nt][1]); w.y = cvt_pk_bf16(acc[0][nt][2], acc[0][nt][3]);
            *(u32x2*)(c.hst + ((((size_t)(c.bh * 2 + dir) * 64 + ch) * 128 + 16 * F.wave + r) * 128) + c.d0 + 16 * nt + 4 * q) = w; }
#pragma unroll
        for (int nt = 0; nt < 2; ++nt) { const f32x4 a4 = *(const LAS f32x4*)(c.adec + cb * 32 + 16 * nt + 4 * q); acc[0][nt] = acc[0][nt] * a4; }
        wave_mma_g<1, 2, true, true, false>(acc, c.vt + cb * 64 * 144 + 16 * F.wave, 144, c.kpt + cb * 32 * 72, 72, 64, F.lane); }
}
__device__ __forceinline__ void hgrn_state_pass(Frame& F, int first, int stride, const bf16* proj, const float* gatez, const float* lblog, int layer, bf16* hst) {
    for (int item = first; item < 128; item += stride) {
        HsCtx c; c.proj = proj; c.gatez = gatez; c.hst = hst;
        c.kpt = (LAS bf16*)F.lds; c.vt = c.kpt + HSB * 32 * 72; c.tot = (LAS float*)(c.vt + HSB * 64 * 144); c.adec = c.tot + HSB * 512;
        const int ds = item & 3; c.dir = (item >> 2) & 1; c.bh = item >> 3; c.b = c.bh >> 3; c.h = c.bh & 7; c.d0 = ds * 32; c.d = F.tid & 31; c.sg = F.tid >> 5;
        c.lb = hgrn_lb(lblog, layer, c.dir, c.h * HD + c.d0 + c.d);
        f32x4 acc[1][2]; acc[0][0] = (f32x4){0.f, 0.f, 0.f, 0.f}; acc[0][1] = (f32x4){0.f, 0.f, 0.f, 0.f};
        float zA[HSB][4], zB[HSB][4]; Pf<2> pvA[HSB], pvB[HSB];
        hs_load(zA, pvA, c, 0, F.tid); hs_load(zB, pvB, c, 1, F.tid);
        for (int cg = 0; cg < 64 / HSB; cg += 2) { hs_step(F, acc, zA, pvA, c, cg); hs_step(F, acc, zB, pvB, c, cg + 1); }
    }
    __syncthreads();
}
__device__ __forceinline__ void hgrn_output_pass(Frame& F, int first, int stride, int last, const bf16* proj, const float* gatez, const float* lblog, int layer, const bf16* hst, const float* hng, bf16* mixin) {
    LAS bf16* qd = (LAS bf16*)F.lds;
    LAS bf16* kd = qd + 64 * 136;
    LAS bf16* qx = kd + 64 * 136;
    LAS bf16* ps = qx + 64 * 136;
    LAS bf16* vt = ps + 64 * 72;
    LAS bf16* sT = vt + 64 * 144;
    LAS float* tot = (LAS float*)(sT + 128 * 136);
    LAS float* rsq = tot + 512;
    const int r = F.lane & 15, q = F.lane >> 4, rg = F.wave & 3, eh = F.wave >> 2;
    const int d = F.tid & 127, sq = F.tid >> 7;
    const int nitems = first < last ? (last - first + stride - 1) / stride : 0, nunits = 2 * nitems;
    if (nunits == 0) return;
    float zr[16]; unsigned short qr[16]; Pf<4> pst; Pf<2> pvv;
#define HO_ISSUE(u_) do { const int it_ = first + ((u_) >> 1) * stride, dr_ = (u_) & 1; const int ch_ = it_ & 63, bh_ = it_ >> 6, b_ = bh_ >> 3, h_ = bh_ & 7; const size_t r0_ = (size_t)b_ * SEQ + ch_ * 64; \
        const bf16* zp_ = proj + (r0_ + 16 * sq) * NPROJ + C_HFF + dr_ * HW + h_ * HD + d; const bf16* qp_ = proj + (r0_ + 16 * sq) * NPROJ + C_HQ + h_ * HD + d; \
        _Pragma("unroll") for (int ii = 0; ii < 16; ++ii) { zr[ii] = bf2f(zp_[(size_t)ii * NPROJ]); qr[ii] = qp_[(size_t)ii * NPROJ]; } \
        pf_load<4, 16>(pst, hst + (((size_t)(bh_ * 2 + dr_) * 64 + ch_) * 128) * 128, 128, F.tid); \
        if (dr_ == 0) pf_load<2, 16>(pvv, proj + r0_ * NPROJ + C_HI + h_ * HD, NPROJ, F.tid); } while (0)
    HO_ISSUE(0);
    f32x4 o[1][4];
    for (int u = 0; u < nunits; ++u) {
        const int item = first + (u >> 1) * stride, dir = u & 1;
        const int ch = item & 63, bh = item >> 6, b = bh >> 3, h = bh & 7; const size_t row0 = (size_t)b * SEQ + ch * 64;
        if (dir == 0) {
#pragma unroll
            for (int nt = 0; nt < 4; ++nt) o[0][nt] = (f32x4){0.f, 0.f, 0.f, 0.f};
        }
        const float lb = hgrn_lb(lblog, layer, dir, h * HD + d);
        float lf[16], kk[16], qv[16];
#pragma unroll
        for (int ii = 0; ii < 16; ++ii) { const float f = lb + (1.0f - lb) * fast_sigmoid(zr[ii]); lf[ii] = __logf(f); kk[ii] = 1.0f - f; qv[ii] = bf2f(qr[ii]) * 0.08838834764831845f; }
        if (dir == 0) {
#pragma unroll
            for (int ii = 1; ii < 16; ++ii) lf[ii] += lf[ii - 1];
        } else {
#pragma unroll
            for (int ii = 14; ii >= 0; --ii) lf[ii] += lf[ii + 1];
        }
        const float mytot = dir == 0 ? lf[15] : lf[0];
        __syncthreads();
        tot[sq * 128 + d] = mytot;
        if (dir == 0) pf_store<2, 16>(vt, 144, F.tid, pvv);
        pf_store<4, 16>(sT, 136, F.tid, pst);
        __syncthreads();
        if (u + 1 < nunits) HO_ISSUE(u + 1);
        const float t0 = tot[d], t1 = tot[128 + d], t2 = tot[256 + d], t3 = tot[384 + d];
        float other, R;
        if (dir == 0) { other = sq == 0 ? 0.f : (sq == 1 ? t0 : (sq == 2 ? t0 + t1 : t0 + t1 + t2)); R = t0 + t1; }
        else { other = sq == 3 ? 0.f : (sq == 2 ? t3 : (sq == 1 ? t3 + t2 : t3 + t2 + t1)); R = t3 + t2; }
#pragma unroll
        for (int ii = 0; ii < 16; ++ii) { const float cum = lf[ii] + other; const int t = 16 * sq + ii;
            const float ea = __expf(cum - R), eb = __expf(R - cum), ec = __expf(cum);
            qd[t * 136 + d] = (bf16)(cvt_pk_bf16(qv[ii] * ea, 0.f) & 0xffffu); kd[t * 136 + d] = (bf16)(cvt_pk_bf16(kk[ii] * eb, 0.f) & 0xffffu); qx[t * 136 + d] = (bf16)(cvt_pk_bf16(qv[ii] * ec, 0.f) & 0xffffu); }
        __syncthreads();
        { f32x4 s[1][2]; s[0][0] = (f32x4){0.f, 0.f, 0.f, 0.f}; s[0][1] = (f32x4){0.f, 0.f, 0.f, 0.f};
          wave_mma<1, 2, true>(s, qd + rg * 16 * 136, 136, kd + eh * 32 * 136, 136, 128, F.lane);
          const int t = 16 * rg + r;
#pragma unroll
          for (int nt = 0; nt < 2; ++nt) { float p[4];
#pragma unroll
              for (int j = 0; j < 4; ++j) { const int sk = 32 * eh + 16 * nt + 4 * q + j; const bool keep = dir == 0 ? (sk <= t) : (sk >= t); p[j] = keep ? s[0][nt][j] : 0.f; }
              u32x2 w; w.x = cvt_pk_bf16(p[0], p[1]); w.y = cvt_pk_bf16(p[2], p[3]);
              *(LAS u32x2*)(ps + t * 72 + 32 * eh + 16 * nt + 4 * q) = w; } }
        __syncthreads();
        wave_mma_g<1, 4, true, false, true>(o, ps + rg * 16 * 72, 72, vt + eh * 64, 144, 64, F.lane);
        wave_mma<1, 4, true>(o, qx + rg * 16 * 136, 136, sT + eh * 64 * 136, 136, 128, F.lane);
        if (dir == 1) {
            float ss = 0.f;
#pragma unroll
            for (int nt = 0; nt < 4; ++nt) ss += (o[0][nt][0] * o[0][nt][0] + o[0][nt][1] * o[0][nt][1]) + (o[0][nt][2] * o[0][nt][2] + o[0][nt][3] * o[0][nt][3]);
            ss += __shfl_xor(ss, 16); ss += __shfl_xor(ss, 32);
            const int t = 16 * rg + r;
            if (q == 0) rsq[t * 2 + eh] = ss;
            __syncthreads();
            const float rs = 1.0f / sqrtf((rsq[t * 2] + rsq[t * 2 + 1]) * (1.0f / HD) + RMS_EPS);
            const bf16* gp = proj + (row0 + t) * NPROJ + C_HG + h * HD + 64 * eh + 4 * q; bf16* op = mixin + (row0 + t) * D + RW + h * HD + 64 * eh + 4 * q; const float* gg = hng + h * HD + 64 * eh + 4 * q;
#pragma unroll
            for (int nt = 0; nt < 4; ++nt) { const u32x2 gt = *(const u32x2*)(gp + 16 * nt); const f32x4 g4 = *(const f32x4*)(gg + 16 * nt); const f32x4 v = o[0][nt] * rs * g4;
                u32x2 w; w.x = cvt_pk_bf16(v[0] * silu_f(bflo(gt.x)), v[1] * silu_f(bfhi(gt.x))); w.y = cvt_pk_bf16(v[2] * silu_f(bflo(gt.y)), v[3] * silu_f(bfhi(gt.y)));
                *(u32x2*)(op + 16 * nt) = w; }
        }
    }
#undef HO_ISSUE
    __syncthreads();
}

__device__ __forceinline__ void fourier_ut2(Frame& F, int bid, const bf16* proj, const bf16* fwt, bf16* ut2, float* nyq) {
    LAS bf16* zc = (LAS bf16*)F.lds;
    LAS bf16* zs = zc + 128 * 136;
    LAS bf16* ws = zs + 128 * 136;
    const int g = bid & 7, nb = (bid >> 3) & 15, b = bid >> 7;
    const bf16* zb = proj + (size_t)(b * SEQ) * NPROJ + C_FZ + g * FD;
    u32x4 ra[4], rb[4];
#pragma unroll
    for (int it = 0; it < 4; ++it) { const int i = F.tid + NWAVES * 64 * it, row = i >> 4, ch = i & 15, n = nb * 128 + row; const int mrow = (SEQ - n) & (SEQ - 1);
        ra[it] = *(const u32x4*)(zb + (size_t)n * NPROJ + ch * 8); rb[it] = *(const u32x4*)(zb + (size_t)mrow * NPROJ + ch * 8); }
    __syncthreads();
    stage_tile(ws, 136, fwt + (size_t)g * 256 * 128, 128, 256, 128, F.tid);
#pragma unroll
    for (int it = 0; it < 4; ++it) { const int i = F.tid + NWAVES * 64 * it, row = i >> 4, ch = i & 15, n = nb * 128 + row; const float k0 = n == 0 ? 0.f : 1.f;
        const u32x4 a = ra[it], m = rb[it]; u32x4 sc, sd;
        sc.x = cvt_pk_bf16(bflo(a.x) + k0 * bflo(m.x), bfhi(a.x) + k0 * bfhi(m.x)); sd.x = cvt_pk_bf16(k0 * (bflo(a.x) - bflo(m.x)), k0 * (bfhi(a.x) - bfhi(m.x)));
        sc.y = cvt_pk_bf16(bflo(a.y) + k0 * bflo(m.y), bfhi(a.y) + k0 * bfhi(m.y)); sd.y = cvt_pk_bf16(k0 * (bflo(a.y) - bflo(m.y)), k0 * (bfhi(a.y) - bfhi(m.y)));
        sc.z = cvt_pk_bf16(bflo(a.z) + k0 * bflo(m.z), bfhi(a.z) + k0 * bfhi(m.z)); sd.z = cvt_pk_bf16(k0 * (bflo(a.z) - bflo(m.z)), k0 * (bfhi(a.z) - bfhi(m.z)));
        sc.w = cvt_pk_bf16(bflo(a.w) + k0 * bflo(m.w), bfhi(a.w) + k0 * bfhi(m.w)); sd.w = cvt_pk_bf16(k0 * (bflo(a.w) - bflo(m.w)), k0 * (bfhi(a.w) - bfhi(m.w)));
        *(LAS u32x4*)(zc + row * 136 + ch * 8) = sc; *(LAS u32x4*)(zs + row * 136 + ch * 8) = sd; }
    __syncthreads();
    const int r = F.lane & 15, q = F.lane >> 4; const int n = nb * 128 + F.wave * 16 + 4 * q;
#pragma unroll
    for (int part = 0; part < 2; ++part) {
        f32x4 acc[1][8];
#pragma unroll
        for (int nt = 0; nt < 8; ++nt) acc[0][nt] = (f32x4){0.f, 0.f, 0.f, 0.f};
        wave_mma<1, 8, false>(acc, (part ? zs : zc) + F.wave * 16 * 136, 136, ws + part * 128 * 136, 136, 128, F.lane);
#pragma unroll
        for (int nt = 0; nt < 8; ++nt) { const int d = nt * 16 + r;
            u32x2 w; w.x = cvt_pk_bf16(acc[0][nt][0], acc[0][nt][1]); w.y = cvt_pk_bf16(acc[0][nt][2], acc[0][nt][3]);
            *(u32x2*)(ut2 + (size_t)(part * 2048 + b * FW + g * FD + d) * 2048 + n) = w; }
    }
    if (nb == 0 && F.tid < 128) {
        const int d = F.tid; const bf16* zr = zb + (size_t)2048 * NPROJ; float acc = 0.f;
        for (int c8 = 0; c8 < 16; ++c8) { const u32x4 zv = *(const u32x4*)(zr + c8 * 8); const u32x4 wv = *(const LAS u32x4*)(ws + d * 136 + c8 * 8);
            acc += bflo(zv.x) * bflo(wv.x) + bfhi(zv.x) * bfhi(wv.x) + bflo(zv.y) * bflo(wv.y) + bfhi(zv.y) * bfhi(wv.y) + bflo(zv.z) * bflo(wv.z) + bfhi(zv.z) * bfhi(wv.z) + bflo(zv.w) * bflo(wv.w) + bfhi(zv.w) * bfhi(wv.w); }
        nyq[b * FW + g * FD + d] = acc;
    }
    __syncthreads();
}
__device__ __forceinline__ void fourier_mid_row(Frame& F, int first_wave, int nwaves, const bf16* ut2, const float* nyq, const float* bias, bf16* mixin) {
    for (int c = first_wave; c < NB * FW; c += nwaves) {
        const u32x4* rowp = (const u32x4*)(ut2 + (size_t)c * 2048) + F.lane; float sacc = 0.f;
#pragma unroll
        for (int j = 0; j < 4; ++j) { const u32x4 v = rowp[64 * j]; sacc += (bflo(v.x) - bfhi(v.x)) + (bflo(v.y) - bfhi(v.y)) + (bflo(v.z) - bfhi(v.z)) + (bflo(v.w) - bfhi(v.w)); }
        sacc = wave_sum(sacc);
        if (F.lane == 0) { const int b = c >> 10, colm = c & 1023; const float y = sacc + nyq[c] + bias[colm];
            mixin[(size_t)(b * SEQ + 2048) * D + 3072 + colm] = (bf16)(cvt_pk_bf16(y, 0.f) & 0xffffu); }
    }
}

__device__ __forceinline__ void xattn_phase(Frame& F, const bf16* xq, const bf16* kvmem, bf16* xo) {
    LAS bf16* ra = (LAS bf16*)F.lds;
    LAS bf16* rb = ra + 128 * 264;
    for (int item = F.vcu; item < NB * XH * 32; item += F.G) {
        const int qb = item & 31, hd = (item >> 5) & 3, b = item >> 7;
        __syncthreads();
        stage_tile(ra, 264, xq + (size_t)(b * SEQ + qb * 128) * XW + hd * XD, XW, 128, 256, F.tid);
        f32x4 s[2][8];
#pragma unroll
        for (int hf = 0; hf < 2; ++hf) {
            if (hf) __syncthreads();
            stage_tile(rb, 264, kvmem + (size_t)(b * MEMT + hf * 128) * 2048 + hd * XD, 2048, 128, 256, F.tid);
            __syncthreads();
            f32x4 acc[1][8];
#pragma unroll
            for (int nt = 0; nt < 8; ++nt) acc[0][nt] = (f32x4){0.f, 0.f, 0.f, 0.f};
            wave_mma<1, 8, true>(acc, ra + F.wave * 16 * 264, 264, rb, 264, 256, F.lane);
#pragma unroll
            for (int nt = 0; nt < 8; ++nt) s[hf][nt] = acc[0][nt];
        }
        float mx = -1e30f;
#pragma unroll
        for (int hf = 0; hf < 2; ++hf)
#pragma unroll
            for (int nt = 0; nt < 8; ++nt)
#pragma unroll
                for (int j = 0; j < 4; ++j) mx = fmaxf(mx, s[hf][nt][j]);
        mx = fmaxf(mx, __shfl_xor(mx, 16)); mx = fmaxf(mx, __shfl_xor(mx, 32));
        float sum = 0.f;
#pragma unroll
        for (int hf = 0; hf < 2; ++hf)
#pragma unroll
            for (int nt = 0; nt < 8; ++nt)
#pragma unroll
                for (int j = 0; j < 4; ++j) { const float p = __expf(s[hf][nt][j] - mx); s[hf][nt][j] = p; sum += p; }
        sum += __shfl_xor(sum, 16); sum += __shfl_xor(sum, 32);
        const float inv = 1.0f / sum;
        __syncthreads();
        { const int r = F.lane & 15, q = F.lane >> 4; LAS bf16* prow = ra + (F.wave * 16 + r) * 264;
#pragma unroll
          for (int hf = 0; hf < 2; ++hf)
#pragma unroll
              for (int nt = 0; nt < 8; ++nt) { u32x2 w; w.x = cvt_pk_bf16(s[hf][nt][0], s[hf][nt][1]); w.y = cvt_pk_bf16(s[hf][nt][2], s[hf][nt][3]);
                  *(LAS u32x2*)(prow + hf * 128 + nt * 16 + 4 * q) = w; } }
        f32x4 o[1][16];
#pragma unroll
        for (int nt = 0; nt < 16; ++nt) o[0][nt] = (f32x4){0.f, 0.f, 0.f, 0.f};
#pragma unroll
        for (int hf = 0; hf < 2; ++hf) {
            if (hf) __syncthreads();
            stage_tile(rb, 272, kvmem + (size_t)(b * MEMT + hf * 128) * 2048 + 1024 + hd * XD, 2048, 128, 256, F.tid);
            __syncthreads();
            wave_mma_g<1, 16, true, false, true>(o, ra + F.wave * 16 * 264 + hf * 128, 264, rb, 272, 128, F.lane);
        }
        { const int r = F.lane & 15, q = F.lane >> 4; bf16* orow = xo + (size_t)(b * SEQ + qb * 128 + F.wave * 16 + r) * XW + hd * XD + 4 * q;
#pragma unroll
          for (int nt = 0; nt < 16; ++nt) { u32x2 w; w.x = cvt_pk_bf16(o[0][nt][0] * inv, o[0][nt][1] * inv); w.y = cvt_pk_bf16(o[0][nt][2] * inv, o[0][nt][3] * inv); *(u32x2*)(orow + nt * 16) = w; } }
    }
    __syncthreads();
}

#define AIN(k) ((const float*)(GAS const float*)args.in[k])
#define x_in (AIN(0))
#define mem (AIN(1))
#define mem_g (AIN(2))
#define W_in ((bf16*)(wsp + WS_WIN))
#define W_out ((bf16*)(wsp + WS_WOUT))
#define W_q ((bf16*)(wsp + WS_WQ))
#define W_kv ((bf16*)(wsp + WS_WKV))
#define W_o ((bf16*)(wsp + WS_WO))
#define W_gu ((bf16*)(wsp + WS_WGU))
#define W_dn ((bf16*)(wsp + WS_WDN))
#define anorm ((bf16*)(wsp + WS_ANORM))
#define proj ((bf16*)(wsp + WS_PROJ))
#define hid ((bf16*)(wsp + WS_PROJ))
#define gatez ((float*)(wsp + WS_GATEZ))
#define mixin ((bf16*)(wsp + WS_MIXIN))
#define tmpb ((bf16*)(wsp + WS_TMP))
#define rst ((bf16*)(wsp + WS_SCR))
#define hst ((bf16*)(wsp + WS_SCR + 128 * MiB))
#define dft ((bf16*)(wsp + WS_DFT))
#define ut ((bf16*)(wsp + WS_UT))
#define xq ((bf16*)(wsp + WS_XQ))
#define xo ((bf16*)(wsp + WS_XO))
#define kvmem ((bf16*)(wsp + WS_KVMEM))
#define memn ((bf16*)(wsp + WS_MEMN))
#define ropec ((float*)(wsp + WS_ROPE))
#define ropes ((float*)(wsp + WS_ROPE) + SEQ * 128)
#define fwt ((bf16*)(wsp + (layer == 0 ? WS_FWT : WS_FWT1)))
#define nyq ((float*)(wsp + WS_FWT + 640 * 1024))
#define rsv ((float*)(wsp + WS_FWT + 768 * 1024))
#define rqv ((float*)(wsp + WS_FWT + 832 * 1024))
#define hq ((signed char*)(wsp + WS_GATEZ))
#define cmaxf ((float*)(wsp + WS_CTL + 256 * 1024))
#define cminf ((float*)(wsp + WS_CTL + 448 * 1024))
#define hout ((float*)(GAS float*)args.out)
#define cq ((unsigned*)(wsp + WS_CTL) + CW_CONVQ)
#define cd (ConvDst{W_out, W_q, W_kv, W_o, W_gu, W_dn, W_in, cmaxf, cminf})
__global__ void __launch_bounds__(NWAVES * 64, 2) fwd_kernel(Args args) {
    extern __shared__ __attribute__((aligned(16))) unsigned char lds[];
    Frame F;
    F.lds = (LAS unsigned char*)lds;
    F.tid = threadIdx.x; F.lane = F.tid & 63; F.wave = __builtin_amdgcn_readfirstlane(F.tid >> 6);
    F.bid = blockIdx.x; F.G = gridDim.x; { const int bx = blockIdx.x; F.vcu = (F.G % 8 == 0) ? (bx % 8) * (F.G / 8) + bx / 8 : bx; }
    F.gw = F.vcu * NWAVES + F.wave; F.NGW = F.G * NWAVES;
    unsigned char* ws = (unsigned char*)(GAS unsigned char*)args.ws; F.ws = ws;
    volatile LAS unsigned* MISC = (volatile LAS unsigned*)(F.lds + MISC_OFF);
    for (int u = F.tid; u < (LDS_BYTES - LDSCTL_OFF) / 4; u += NWAVES * 64) ((LAS unsigned*)(F.lds + LDSCTL_OFF))[u] = 0u;
    __syncthreads();
    XcdBarrier bar; bar.bar = (unsigned*)(ws + WS_CTL) + CW_BAR; bar.x = 0; bar.st = nullptr;
    if (args.single) bar = xcd_barrier_post((unsigned*)(ws + WS_CTL) + CW_BAR, MISC + 8);
#define GRID_BAR() do { if (args.single) xcd_barrier(bar); } while (0)
#define RELAUNDER() do { { int b_ = blockIdx.x; asm volatile("" : "+s"(b_)); F.bid = b_; } wsp = (GAS unsigned char*)args.ws; asm volatile("" : "+s"(wsp)); int t_ = threadIdx.x; asm volatile("" : "+v"(t_)); F.tid = t_; F.lane = t_ & 63; F.wave = __builtin_amdgcn_readfirstlane(t_ >> 6); F.gw = F.vcu * NWAVES + F.wave; } while (0)

    GAS unsigned char* wsp = (GAS unsigned char*)args.ws;
    const int lo = args.ph_lo, hi = args.ph_hi;
#ifndef PHASE_MASK
#define PHASE_MASK 0xffffffffu
#endif
#define IN(k) (((PHASE_MASK >> (k)) & 1u) && lo <= (k) && (k) < hi)

    for (int layer = args.layer_lo; layer < args.layer_hi; ++layer) {
        const int cv_total = layer + 1 < NL ? CV_ITEMS_ALL : CV_ITEMS;
        if (IN(PH_PRE) && layer == 0) {
            RELAUNDER();
            const int gt = F.vcu * (NWAVES * 64) + F.tid, NT = F.G * NWAVES * 64;
            for (int i = gt; i < SEQ * 128; i += NT) { const int pos = i >> 7, j = i & 127;
                const float inv = exp2f(-(float)j * (13.287712379549449f / 128.0f)); const float ang = (float)pos * inv;
                const double rev = (double)ang * 0.15915494309189535; const float fr = (float)(rev - __builtin_rint(rev));
                ropec[i] = __builtin_amdgcn_cosf(fr); ropes[i] = __builtin_amdgcn_sinf(fr); }
            for (int i = gt; i < SEQ * 2048 / 8; i += NT) { const int k = i >> 8, c8 = (i & 255) * 8; const int sn = k >> 11, kk = k & 2047;
                float v[8];
#pragma unroll
                for (int j = 0; j < 8; ++j) { const int mm = (kk * (c8 + j)) & 4095; const float fr = (float)mm * (1.0f / 4096.0f); v[j] = sn ? __builtin_amdgcn_sinf(fr) : __builtin_amdgcn_cosf(fr); }
                u32x4 w; w.x = cvt_pk_bf16(v[0], v[1]); w.y = cvt_pk_bf16(v[2], v[3]); w.z = cvt_pk_bf16(v[4], v[5]); w.w = cvt_pk_bf16(v[6], v[7]);
                *(u32x4*)(dft + (size_t)k * 2048 + c8) = w; }
            for (int row = F.gw; row < NB * MEMT; row += F.NGW) rms_row_to_bf16(mem + (size_t)row * D, mem_g, memn + (size_t)row * D, F.lane);
            for (int l = 0; l < NL; ++l) { colmax_pass(F, AIN(19) + (size_t)l * D * FFH, D, FFH, AIN(18) + (size_t)l * D, cmaxf + (size_t)l * 2 * FFH);
                colmax_pass(F, AIN(20) + (size_t)l * D * FFH, D, FFH, AIN(18) + (size_t)l * D, cmaxf + (size_t)l * 2 * FFH + FFH);
                if (l >= 1) colmax_pass(F, AIN(4) + (size_t)l * D * NPROJ, D, NPROJ, AIN(3) + (size_t)l * D, cminf + (size_t)l * NPROJ); }
            { const int gt2 = F.vcu * (NWAVES * 64) + F.tid; if (gt2 < NPROJ) cminf[gt2] = 127.0f; }
        }
        if (IN(PH_CONV) && layer == 0) {
            RELAUNDER();
            LAS unsigned* scr = (LAS unsigned*)(F.lds + F.wave * 16384);
            convert_matrix(F, AIN(4), D, NPROJ, W_in, 0, 0, scr, AIN(3), nullptr);
            { const int gt = F.vcu * (NWAVES * 64) + F.tid, NT = F.G * NWAVES * 64;
              for (int i = gt; i < NL * FG * 32 * 128; i += NT) { const int c = i & 127, d4 = (i >> 7) & 31, g = (i >> 12) & (FG - 1), l = i >> 15;
                  const float* fw = AIN(8) + (size_t)l * FG * FD * FD + (size_t)g * FD * FD + 4 * d4;
                  f32x4 ac = (f32x4){0.f, 0.f, 0.f, 0.f}, as = ac;
#pragma unroll 16
                  for (int cp = 0; cp < 128; ++cp) { const float fr = (float)((c * cp) & 127) * (1.0f / 128.0f); const f32x4 w = *(const f32x4*)(fw + cp * FD); ac = ac + w * __builtin_amdgcn_cosf(fr); as = as - w * __builtin_amdgcn_sinf(fr); }
                  bf16* fo = (bf16*)(wsp + (l == 0 ? WS_FWT : WS_FWT1)) + ((size_t)g * 256 + 4 * d4) * 128 + c;
#pragma unroll
                  for (int jd = 0; jd < 4; ++jd) { fo[jd * 128] = (bf16)(cvt_pk_bf16(ac[jd] * 0.0013810679320049757f, 0.f) & 0xffff); fo[128 * 128 + jd * 128] = (bf16)(cvt_pk_bf16(as[jd] * 0.0013810679320049757f, 0.f) & 0xffff); } } }
            x_to_stream(F, x_in, anorm, rsv);
            __syncthreads();
            GRID_BAR();
        }
        if (IN(PH_INPROJ)) {
            RELAUNDER();
            if (layer == 0) { pg8::Gemm g{anorm, W_in, M, NPROJ, D}; pg8::StaticOrder S; S.init(M, NPROJ, F.G, F.bid);
              pg8::EpiInProj E{proj, ropec, ropes, rsv, cminf};
              pg8::gemm_phase<pg8::EpiInProj, pg8::StaticOrder, PG8_ALIGN, PG8_SP2, false>(F.lds, g, S, E); }
            else { pg8::Gemm g{(const bf16*)hq, W_in, M, NPROJ, D}; pg8::StaticOrder S; S.init(M, NPROJ, F.G, F.bid);
              pg8::EpiInProj E{proj, ropec, ropes, rqv, cminf + (size_t)layer * NPROJ};
              pg8::gemm_phase<pg8::EpiInProj, pg8::StaticOrder, PG8_ALIGN, PG8_SP2, true>(F.lds, g, S, E); }
            GRID_BAR();
        }
        if (IN(PH_MIXA)) {
            RELAUNDER();
            const int bid = F.bid;
            unsigned* donew = cq + 64 * (layer * 2 + 1);
            if (bid < 128) ret_state_pass(F, bid, 128, proj, rst);
            else hgrn_state_pass(F, bid - 128, 128, proj, gatez, AIN(6), layer, hst);
            RELAUNDER();
            fourier_ut2(F, bid, proj, fwt, ut, nyq);
            { VM_WAIT(); __syncthreads(); if (F.tid == 0) __hip_atomic_fetch_add(donew, 1u, __ATOMIC_RELAXED, __HIP_MEMORY_SCOPE_AGENT); }
            conv_pull(F, args.in, layer, cq + 64 * (layer * 2 + 0), cv_total, cv_total, cd, MISC + 16, donew, 256u);
            GRID_BAR();
        }
        if (IN(PH_MIXB)) {
            RELAUNDER();
            const int bid = F.bid; const float* hng = AIN(7) + (size_t)layer * HW; const float* fbias = AIN(9) + (size_t)layer * FW;
            if (bid < 64) {
                pg8::Gemm g{dft, ut, SEQ, SEQ, 2048};
                { pg8::OneUnit S{bid >> 3, bid & 7}; pg8::EpiF32 E{(float*)(ws + WS_TMP), 2048};
                  pg8::gemm_phase<pg8::EpiF32, pg8::OneUnit, PG8_ALIGN, PG8_SP2>(F.lds, g, S, E); }
                RELAUNDER();
                { pg8::OneUnit S{8 + (bid >> 3), 8 + (bid & 7)}; pg8::EpiFourier2 E{mixin, fbias, nyq, (const float*)(ws + WS_TMP)};
                  pg8::gemm_phase<pg8::EpiFourier2, pg8::OneUnit, PG8_ALIGN, PG8_SP2>(F.lds, g, S, E); }
                RELAUNDER();
                hgrn_output_pass(F, 832 + bid, 64, 1024, proj, gatez, AIN(6), layer, hst, hng, mixin);
            } else {
                const int idx = bid - 64;
                if (idx < 64) fourier_mid_row(F, idx * NWAVES + F.wave, 64 * NWAVES, ut, nyq, fbias, mixin);
                ret_output_pass(F, idx, 192, proj, rst, AIN(5) + (size_t)layer * RW, mixin);
                if (idx < 128) hgrn_output_pass(F, idx, 128, 384, proj, gatez, AIN(6), layer, hst, hng, mixin);
                else hgrn_output_pass(F, 384 + (idx - 128), 64, 832, proj, gatez, AIN(6), layer, hst, hng, mixin);
            }
            conv_pull(F, args.in, layer, cq + 64 * (layer * 2 + 0), CV_P_ITEMS, cv_total, cd, MISC + 16, nullptr, 0u);
            GRID_BAR();
        }
        if (IN(PH_WOUT)) {
            RELAUNDER();
            pg8::Gemm g{mixin, W_out, M, D, D}; pg8::StaticOrder S; S.init(M, D, F.G, F.bid);
            pg8::EpiBf16 E{tmpb, D, 1.0f, nullptr};
            pg8::gemm_phase<pg8::EpiBf16, pg8::StaticOrder, PG8_ALIGN, PG8_SP2>(F.lds, g, S, E);
            GRID_BAR();
        }
        if (IN(PH_NORM1)) {
            RELAUNDER();
            norm_phase(F, tmpb, layer == 0 ? x_in : nullptr, anorm, nullptr, AIN(11) + (size_t)layer * D, rsv);
            GRID_BAR();
        }
        if (IN(PH_XQ)) {
            RELAUNDER();
            { pg8::Gemm g{anorm, W_q, M, XW, D}; pg8::StaticOrder S; S.init(M, XW, F.G, F.bid);
              pg8::EpiBf16 E{xq, XW, 0.0625f, rsv};
              pg8::gemm_phase<pg8::EpiBf16, pg8::StaticOrder, PG8_ALIGN, PG8_SP2>(F.lds, g, S, E); }
            { pg8::Gemm g{memn, W_kv, NB * MEMT, 2 * XW, D}; pg8::StaticOrder S; S.init(NB * MEMT, 2 * XW, F.G, F.bid - 128);
              pg8::EpiBf16 E{kvmem, 2 * XW, 1.0f, nullptr};
              pg8::gemm_phase<pg8::EpiBf16, pg8::StaticOrder, PG8_ALIGN, PG8_SP2>(F.lds, g, S, E); }
            { unsigned* donex = cq + 64 * (4 + layer);
              if (F.bid < 144) { VM_WAIT(); __syncthreads(); if (F.tid == 0) __hip_atomic_fetch_add(donex, 1u, __ATOMIC_RELAXED, __HIP_MEMORY_SCOPE_AGENT); }
              conv_pull(F, args.in, layer, cq + 64 * (layer * 2 + 0), cv_total, cv_total, cd, MISC + 16, donex, 144u); }
            GRID_BAR();
        }
        if (IN(PH_XATT)) {
            RELAUNDER();
            xattn_phase(F, xq, kvmem, xo);
            GRID_BAR();
        }
        if (IN(PH_XWO)) {
            RELAUNDER();
            pg8::Gemm g{xo, W_o, M, D, XW}; pg8::StaticOrder S; S.init(M, D, F.G, F.bid);
            pg8::EpiBf16 E{tmpb, D, 1.0f, nullptr};
            pg8::gemm_phase<pg8::EpiBf16, pg8::StaticOrder, PG8_ALIGN, PG8_SP2>(F.lds, g, S, E);
            GRID_BAR();
        }
        if (IN(PH_NORM2)) {
            RELAUNDER();
            norm_phase_q(F, tmpb, anorm, AIN(17) + (size_t)layer * D, hq, rqv, nullptr);
            conv_pull(F, args.in, layer, cq + 64 * (layer * 2 + 0), CV_ITEMS, cv_total, cd, MISC + 16, nullptr, 0u);
            GRID_BAR();
        }
        if (IN(PH_FFN1)) {
            RELAUNDER();
            pg8::Gemm g{(const bf16*)hq, W_gu, M, 2 * FFH, D}; pg8::StaticOrder S; S.init(M, 2 * FFH, F.G, F.bid);
            pg8::EpiSwiGluQ E{hid, FFH, rqv, cmaxf + (size_t)layer * 2 * FFH, cmaxf + (size_t)layer * 2 * FFH + FFH};
            pg8::gemm_phase<pg8::EpiSwiGluQ, pg8::StaticOrder, PG8_ALIGN, PG8_SP2, true>(F.lds, g, S, E);
            if (layer + 1 < NL) {
                unsigned* donef = cq + 64 * (8 + layer);
                VM_WAIT(); __syncthreads(); if (F.tid == 0) __hip_atomic_fetch_add(donef, 1u, __ATOMIC_RELAXED, __HIP_MEMORY_SCOPE_AGENT);
                conv_pull(F, args.in, layer, cq + 64 * (layer * 2 + 0), cv_total, cv_total, cd, MISC + 16, donef, (unsigned)F.G);
            }
            GRID_BAR();
        }
        if (IN(PH_FFN2)) {
            RELAUNDER();
            pg8::Gemm g{hid, W_dn, M, D, FFH}; pg8::StaticOrder S; S.init(M, D, F.G, F.bid);
            pg8::EpiBf16 E{tmpb, D, 1.0f, nullptr};
            pg8::gemm_phase<pg8::EpiBf16, pg8::StaticOrder, PG8_ALIGN, PG8_SP2>(F.lds, g, S, E);
            GRID_BAR();
        }
        if (IN(PH_NORM3)) {
            RELAUNDER();
            const bool more = layer + 1 < NL;
            if (more) norm_phase_q(F, tmpb, anorm, AIN(22) + (size_t)layer * D, hq, rqv, rsv);
            else norm_phase(F, tmpb, nullptr, anorm, hout, AIN(22) + (size_t)layer * D, nullptr);
            if (more) conv_pull(F, args.in, layer, cq + 64 * (layer * 2 + 0), cv_total, cv_total, cd, MISC + 16, nullptr, 0u);
            if (more) GRID_BAR();
        }
    }
#undef IN
#undef GRID_BAR
}

#undef x_in
#undef mem
#undef mem_g
#undef W_in
#undef W_out
#undef W_q
#undef W_kv
#undef W_o
#undef W_gu
#undef W_dn
#undef anorm
#undef proj
#undef hid
#undef gatez
#undef mixin
#undef tmpb
#undef rst
#undef hst
#undef dft
#undef ut
#undef xq
#undef xo
#undef kvmem
#undef memn
#undef ropec
#undef ropes
#undef fwt
#undef nyq
#undef rsv
#undef rqv
#undef hq
#undef cmaxf
#undef cminf
#undef hout
#undef cq
#undef cd
extern "C" void kernel_launch(void* const* d_in, const int* in_sizes, int n_in, void* d_out, int out_size, void* d_ws, size_t ws_size, hipStream_t stream) {
    static int grid = 0;
    if (grid == 0) {
        if (n_in != 23 || out_size != M * D || ws_size < WS_END) { fprintf(stderr, "kernel_launch: unexpected shapes (n_in %d, out %d, ws %zu < %zu)\n", n_in, out_size, ws_size, (size_t)WS_END); grid = -1; return; }
        int dev = 0, cus = 0, per_cu = 0;
        if (hipGetDevice(&dev) != hipSuccess || hipDeviceGetAttribute(&cus, hipDeviceAttributeMultiprocessorCount, dev) != hipSuccess) { grid = -1; return; }
        if (hipFuncSetAttribute((const void*)fwd_kernel, hipFuncAttributeMaxDynamicSharedMemorySize, LDS_BYTES) != hipSuccess) { fprintf(stderr, "kernel_launch: hipFuncSetAttribute failed\n"); grid = -1; return; }
        if (hipOccupancyMaxActiveBlocksPerMultiprocessor(&per_cu, (const void*)fwd_kernel, NWAVES * 64, LDS_BYTES) != hipSuccess || per_cu < 1) fprintf(stderr, "kernel_launch: occupancy query reports %d\n", per_cu);
        (void)hipGetLastError();
        grid = cus;
    }
    if (grid < 0) return;
    (void)in_sizes;
    if (hipMemsetAsync((char*)d_ws + WS_CTL, 0, CTL_ZERO_BYTES, stream) != hipSuccess) return;
    Args a{};
    for (int i = 0; i < 23; ++i) a.in[i] = (const float*)d_in[i];
    a.out = (float*)d_out; a.ws = (unsigned char*)d_ws; a.pad = 0;
#if ONE_LAUNCH
    a.layer_lo = 0; a.layer_hi = NL; a.ph_lo = 0; a.ph_hi = PH_COUNT; a.single = 1;
    hipLaunchKernelGGL(fwd_kernel, dim3(grid), dim3(NWAVES * 64), LDS_BYTES, stream, a);
#else
    a.single = 0;
    for (int layer = 0; layer < NL; ++layer)
        for (int ph = (layer == 0 ? PH_PRE : PH_CONV); ph < PH_COUNT; ++ph) {
            a.layer_lo = layer; a.layer_hi = layer + 1; a.ph_lo = ph; a.ph_hi = ph + 1;
            hipLaunchKernelGGL(fwd_kernel, dim3(grid), dim3(NWAVES * 64), LDS_BYTES, stream, a);
        }
#endif
}
```
